# Optimizing an MI355X kernel written in HIP

```python
import jax, jax.numpy as jnp
from jax import lax
import numpy as np

D_MODEL = 1024
BATCH = 4
SEQ = 8192
DEPTH = 1

HEAD_DIM = 64
N_HEADS = D_MODEL // HEAD_DIM
N_FOX_HEADS = N_HEADS // 2
N_SB_HEADS = N_HEADS - N_FOX_HEADS
FOX_WIDTH = N_FOX_HEADS * HEAD_DIM
SB_WIDTH = N_SB_HEADS * HEAD_DIM
MIX_WIDTH = FOX_WIDTH + SB_WIDTH
IN_COLS = 3 * FOX_WIDTH + N_FOX_HEADS + 3 * SB_WIDTH
D_FF = ((8 * D_MODEL // 3 + 127) // 128) * 128
CONV_WIDTH = 3
BLOCK_Q = 128
EPS = 1e-6

kernel_name = "hybrid_fox_stickbreaking_convffn"


def rmsnorm(x, g):
    xf = x.astype(jnp.float32)
    y = xf * lax.rsqrt(jnp.mean(xf * xf, axis=-1, keepdims=True) + EPS)
    return (y * g.astype(jnp.float32)).astype(x.dtype)


def split_heads(t, n_heads):
    b, s, _ = t.shape
    return t.reshape(b, s, n_heads, HEAD_DIM).transpose(0, 2, 1, 3)


def merge_heads(t):
    b, h, s, d = t.shape
    return t.transpose(0, 2, 1, 3).reshape(b, s, h * d)


def to_blocks(t):
    b, h, s = t.shape[:3]
    t = t.reshape(b, h, s // BLOCK_Q, BLOCK_Q, *t.shape[3:])
    return jnp.moveaxis(t, 2, 0)


def from_blocks(t):
    nb, b, h, bq, d = t.shape
    return jnp.moveaxis(t, 0, 2).reshape(b, h, nb * bq, d)


def fox_attention(q, k, v, log_f):
    s_len = q.shape[2]
    scale = HEAD_DIM ** -0.5
    kf = k.astype(jnp.float32)
    vf = v.astype(jnp.float32)
    F = jnp.cumsum(log_f, axis=-1)
    kpos = jnp.arange(s_len)

    def block(args):
        i, qi, Fi = args
        qpos = i * BLOCK_Q + jnp.arange(BLOCK_Q)
        logits = (jnp.einsum('bhqd,bhkd->bhqk', qi.astype(jnp.float32), kf) * scale
                  + Fi[..., :, None] - F[:, :, None, :])
        logits = jnp.where(kpos[None, :] <= qpos[:, None], logits, -jnp.inf)
        p = jax.nn.softmax(logits, axis=-1)
        return jnp.einsum('bhqk,bhkd->bhqd', p, vf)

    out = lax.map(block, (jnp.arange(s_len // BLOCK_Q), to_blocks(q), to_blocks(F)))
    return from_blocks(out).astype(v.dtype)


def stick_breaking_attention(q, k, v):
    s_len = q.shape[2]
    scale = HEAD_DIM ** -0.5
    kf = k.astype(jnp.float32)
    vf = v.astype(jnp.float32)
    kpos = jnp.arange(s_len)

    def block(args):
        i, qi = args
        qpos = i * BLOCK_Q + jnp.arange(BLOCK_Q)
        mask = kpos[None, :] < qpos[:, None]
        z = jnp.einsum('bhqd,bhkd->bhqk', qi.astype(jnp.float32), kf) * scale
        log_beta = jax.nn.log_sigmoid(z)
        log_one_minus = jnp.where(mask, jax.nn.log_sigmoid(-z), 0.0)
        after = lax.cumsum(log_one_minus, axis=3, reverse=True) - log_one_minus
        weights = jnp.where(mask, jnp.exp(log_beta + after), 0.0)
        return jnp.einsum('bhqk,bhkd->bhqd', weights, vf)

    out = lax.map(block, (jnp.arange(s_len // BLOCK_Q), to_blocks(q)))
    return from_blocks(out).astype(v.dtype)


def causal_dwconv(u, w, b):
    s_len = u.shape[1]
    up = jnp.pad(u, ((0, 0), (CONV_WIDTH - 1, 0), (0, 0)))
    out = b + w[0] * up[:, 0:s_len]
    for kk in range(1, CONV_WIDTH):
        out = out + w[kk] * up[:, kk:kk + s_len]
    return out


def setup_inputs(seed: int = 0) -> dict:
    key = jax.random.key(seed)
    ks = jax.random.split(key, 13)
    f32 = jnp.float32
    x = jax.random.normal(ks[0], (BATCH, SEQ, D_MODEL), f32)
    attn_norm_g = 1.0 + 0.05 * jax.random.normal(ks[1], (DEPTH, D_MODEL), f32)
    w_in = jax.random.normal(ks[2], (DEPTH, D_MODEL, IN_COLS), f32) * D_MODEL ** -0.5
    forget_bias = (jnp.linspace(1.0, 6.0, N_FOX_HEADS, dtype=f32)[None, :]
                   + 0.1 * jax.random.normal(ks[3], (DEPTH, N_FOX_HEADS), f32))
    fox_out_g = 1.0 + 0.05 * jax.random.normal(ks[4], (DEPTH, FOX_WIDTH), f32)
    sb_out_g = 1.0 + 0.05 * jax.random.normal(ks[5], (DEPTH, SB_WIDTH), f32)
    w_out = jax.random.normal(ks[6], (DEPTH, MIX_WIDTH, D_MODEL), f32) * MIX_WIDTH ** -0.5
    ffn_norm_g = 1.0 + 0.05 * jax.random.normal(ks[7], (DEPTH, D_MODEL), f32)
    w_up = jax.random.normal(ks[8], (DEPTH, D_MODEL, 2 * D_FF), f32) * D_MODEL ** -0.5
    conv_w = jax.random.normal(ks[9], (DEPTH, CONV_WIDTH, 2 * D_FF), f32) * CONV_WIDTH ** -0.5
    conv_b = 0.02 * jax.random.normal(ks[10], (DEPTH, 2 * D_FF), f32)
    w_down = jax.random.normal(ks[11], (DEPTH, D_FF, D_MODEL), f32) * D_FF ** -0.5
    final_norm_g = 1.0 + 0.05 * jax.random.normal(ks[12], (D_MODEL,), f32)
    return {"x": x, "attn_norm_g": attn_norm_g, "w_in": w_in, "forget_bias": forget_bias,
            "fox_out_g": fox_out_g, "sb_out_g": sb_out_g, "w_out": w_out,
            "ffn_norm_g": ffn_norm_g, "w_up": w_up, "conv_w": conv_w, "conv_b": conv_b,
            "w_down": w_down, "final_norm_g": final_norm_g}


def reference(x, attn_norm_g, w_in, forget_bias, fox_out_g, sb_out_g, w_out,
              ffn_norm_g, w_up, conv_w, conv_b, w_down, final_norm_g):
    b, s_len, _ = x.shape
    splits = [FOX_WIDTH, 2 * FOX_WIDTH, 3 * FOX_WIDTH, 3 * FOX_WIDTH + N_FOX_HEADS,
              3 * FOX_WIDTH + N_FOX_HEADS + SB_WIDTH,
              3 * FOX_WIDTH + N_FOX_HEADS + 2 * SB_WIDTH]
    for l in range(DEPTH):
        h = rmsnorm(x, attn_norm_g[l])
        proj = h @ w_in[l]
        fq, fk, fv, f_logit, sq, sk, sv = jnp.split(proj, splits, axis=-1)
        log_f = jax.nn.log_sigmoid(
            (f_logit + forget_bias[l]).astype(jnp.float32)).transpose(0, 2, 1)
        o_fox = fox_attention(split_heads(fq, N_FOX_HEADS), split_heads(fk, N_FOX_HEADS),
                              split_heads(fv, N_FOX_HEADS), log_f)
        o_sb = stick_breaking_attention(split_heads(sq, N_SB_HEADS), split_heads(sk, N_SB_HEADS),
                                        split_heads(sv, N_SB_HEADS))
        o = jnp.concatenate([rmsnorm(merge_heads(o_fox), fox_out_g[l]),
                             rmsnorm(merge_heads(o_sb), sb_out_g[l])], axis=-1)
        x = x + o @ w_out[l]
        h = rmsnorm(x, ffn_norm_g[l])
        u = causal_dwconv(h @ w_up[l], conv_w[l], conv_b[l])
        gate, val = jnp.split(u, 2, axis=-1)
        x = x + (jax.nn.silu(gate) * val) @ w_down[l]
    return rmsnorm(x, final_norm_g)
```

```cpp
#include <hip/hip_runtime.h>
#include <hip/hip_cooperative_groups.h>
#include <cstdio>
#include <cstdint>
#include <cmath>
namespace cg = cooperative_groups;
namespace pg8 {
#define PG8_LAS __attribute__((address_space(3)))
typedef unsigned short bf16_t;
typedef short bf16x8 __attribute__((ext_vector_type(8)));
typedef float f32x4 __attribute__((ext_vector_type(4)));
typedef unsigned u32x4 __attribute__((ext_vector_type(4)));
constexpr int BM = 256, BK = 64, HALF = 128, HTB = HALF * BK * 2  , STAGE_BYTES = 8 * HTB, NXCD = 8, WGM = 8;

__host__ __device__ __forceinline__ int lds_byte(int r, int c) { const int st = (r >> 4) * 2 + (c >> 5), rr = r & 15, cc = c & 31, ob = rr * 64 + cc * 2; return st * 1024 + (ob ^ (((ob >> 9) & 1) << 5)); }
__host__ __device__ __forceinline__ void stage_rc(int b, int& R, int& C) { const int st = b / 1024, sb = b % 1024, swz = sb ^ (((sb >> 9) & 1) << 5); R = (st >> 1) * 16 + swz / 64; C = (st & 1) * 32 + (swz % 64) / 2; }
__host__ __device__ __forceinline__ int perm32(int rho) { const int n = rho >> 4, i = rho & 15; return 8 * (i >> 2) + 4 * n + (i & 3); }

struct Unit { int pm, pn, idx; };
struct Gemm { const bf16_t* A; const bf16_t* Bt; int M, N, K, lda; };

struct StaticOrder {
    int nM, nN, nwg, G, c;
    __host__ __device__ void init(int M, int N, int G_, int c_) { nM = M / BM; nN = N / BM; nwg = nM * nN; G = G_; c = c_; }
    __host__ __device__ bool next(int i, Unit& u) const {
        const long L = (long)i * G + c; if (L >= nwg) return false;
        int wgid = (int)L; { const int q = nwg / NXCD, r = nwg % NXCD, xcd = wgid % NXCD, off = wgid / NXCD; wgid = (xcd < r ? xcd * (q + 1) : r * (q + 1) + (xcd - r) * q) + off; }
        const int nig = WGM * nN, gid = wgid / nig, fm = gid * WGM, gsz = (nM - fm) < WGM ? (nM - fm) : WGM;
        u.pm = fm + ((wgid % nig) % gsz); u.pn = (wgid % nig) / gsz; u.idx = i; return true;
    }
    __device__ __forceinline__ void a_ready(const Unit&) const {}
    __device__ __forceinline__ void done(const Unit&) const {}
};

__device__ __forceinline__ unsigned cvt_pk_bf16(float lo, float hi) { unsigned r; asm volatile("v_cvt_pk_bf16_f32 %0, %1, %2" : "=v"(r) : "v"(lo), "v"(hi)); return r; }
typedef float f32x2 __attribute__((ext_vector_type(2)));

typedef unsigned u32x2 __attribute__((ext_vector_type(2)));
constexpr float RMS_EPS = 1e-6f;
__device__ __forceinline__ float sum16(const float* p) {
    const f32x4 a = *(const f32x4*)p, b = *(const f32x4*)(p + 4), c = *(const f32x4*)(p + 8), d = *(const f32x4*)(p + 12);
    return ((a[0] + a[1]) + (a[2] + a[3])) + ((b[0] + b[1]) + (b[2] + b[3])) + ((c[0] + c[1]) + (c[2] + c[3])) + ((d[0] + d[1]) + (d[2] + d[3]));
}

struct EpiQKV {
    static constexpr bool PERM = true, AFTER_DRAIN = false, HAS_MID = false;
    bf16_t* O; int ldc; int split_cols; size_t split_stride; float scale0; unsigned* kmax;
    __device__ __forceinline__ void operator()(f32x4 (&acc)[2][2][4][2], const Unit& u, int wr, int wc, int fr, int fq) const {
        const int row0 = u.pm * BM + wr * 64 + fr; int colt = u.pn * BM; bf16_t* base = O;
        float sc = 1.f; const int t = colt / split_cols; { base += (size_t)t * split_stride; colt -= t * split_cols; if (t == 0) sc = scale0; }
        const int col0 = colt + wc * 32 + 8 * fq;
        const bool knorm = (t == 1) && (colt < 512);
        float hm[2] = {0.f, 0.f};
#pragma unroll
        for (int ai = 0; ai < 2; ++ai)
#pragma unroll
            for (int m = 0; m < 4; ++m) { bf16_t* rowp = base + (size_t)(row0 + ai * HALF + m * 16) * ldc + col0;
#pragma unroll
                for (int bj = 0; bj < 2; ++bj) { f32x4 v0 = acc[ai][bj][m][0] * sc, v1 = acc[ai][bj][m][1] * sc;
                    u32x4 w; w.x = cvt_pk_bf16(v0[0], v0[1]); w.y = cvt_pk_bf16(v0[2], v0[3]); w.z = cvt_pk_bf16(v1[0], v1[1]); w.w = cvt_pk_bf16(v1[2], v1[3]);
                    *(u32x4*)(rowp + bj * HALF) = w;
                    if (knorm) { float s = ((v0[0] * v0[0] + v0[1] * v0[1]) + (v0[2] * v0[2] + v0[3] * v0[3])) + ((v1[0] * v1[0] + v1[1] * v1[1]) + (v1[2] * v1[2] + v1[3] * v1[3]));
                        s += __shfl_xor(s, 16); s += __shfl_xor(s, 32); hm[bj] = fmaxf(hm[bj], s); } } }
        if (knorm) {
#pragma unroll
            for (int o = 1; o < 16; o <<= 1) { hm[0] = fmaxf(hm[0], __shfl_xor(hm[0], o)); hm[1] = fmaxf(hm[1], __shfl_xor(hm[1], o)); }
            if (fr == 0 && fq == 0) { const int b = (u.pm * BM) >> 13;
                atomicMax(kmax + b * 8 + ((colt + wc * 32) >> 6), __float_as_uint(hm[0])); atomicMax(kmax + b * 8 + ((colt + 128 + wc * 32) >> 6), __float_as_uint(hm[1])); } }
    }
};

#define PG8_DPP(v, ctrl) __builtin_bit_cast(float, __builtin_amdgcn_update_dpp(0, __builtin_bit_cast(int, (v)), (ctrl), 0xf, 0xf, true))
struct EpiUpConv {
    static constexpr bool PERM = true, AFTER_DRAIN = false, HAS_MID = false;
    bf16_t* G; const float* PS  ; float* HALO4; const float* cw; const float* cb; PG8_LAS float* hal;
    __device__ __forceinline__ void operator()(f32x4 (&acc)[2][2][4][2], const Unit& u, int wr, int wc, int fr_, int fq_) const {
        int fr = fr_, fq = fq_; asm volatile("" : "+v"(fr), "+v"(fq));
        const int row0 = u.pm * BM + wr * 64 + fr; const int colw = wc * 32 + 8 * fq; const int c0 = u.pn * 128;
#pragma unroll
        for (int ai = 0; ai < 2; ++ai)
#pragma unroll
            for (int m = 0; m < 4; ++m) { const int r = row0 + ai * HALF + m * 16; const float rs = *(const float*)((const char*)PS + (unsigned)r * 4u);
#pragma unroll
                for (int bj = 0; bj < 2; ++bj)
#pragma unroll
                    for (int n = 0; n < 2; ++n) acc[ai][bj][m][n] = acc[ai][bj][m][n] * rs;
                asm volatile("" ::: "memory"); __builtin_amdgcn_sched_barrier(0); }
        if (fr >= 14) {
#pragma unroll
            for (int ai = 0; ai < 2; ++ai)
#pragma unroll
                for (int bj = 0; bj < 2; ++bj)
#pragma unroll
                    for (int n = 0; n < 2; ++n) *(PG8_LAS f32x4*)(hal + (((ai * 2 + wr) * 2 + (fr - 14)) * 256 + bj * 128 + colw + 4 * n)) = acc[ai][bj][3][n];
            if (wr == 1) {
#pragma unroll
                for (int bj = 0; bj < 2; ++bj)
#pragma unroll
                    for (int n = 0; n < 2; ++n) *(f32x4*)(HALO4 + (size_t)(u.pm * 4 + 2 + (fr - 14)) * 5632 + bj * 2816 + c0 + colw + 4 * n) = acc[1][bj][3][n]; }
        }
        if (wr == 0 && fr < 2) {
#pragma unroll
            for (int bj = 0; bj < 2; ++bj)
#pragma unroll
                for (int n = 0; n < 2; ++n) *(f32x4*)(HALO4 + (size_t)(u.pm * 4 + fr) * 5632 + bj * 2816 + c0 + colw + 4 * n) = acc[0][bj][0][n]; }
        asm volatile("s_waitcnt lgkmcnt(0)\n\ts_barrier" ::: "memory");
        const int hrow = (fr == 15) ? 1 : 0;
#pragma unroll
        for (int n = 0; n < 2; ++n) {
#pragma unroll
            for (int bj = 0; bj < 2; ++bj) {
                const int chan = bj * 2816 + c0 + colw + 4 * n;
                const f32x4 w0 = *(const f32x4*)((const char*)cw + (unsigned)chan * 4u), w1 = *(const f32x4*)((const char*)cw + (unsigned)(5632 + chan) * 4u), w2 = *(const f32x4*)((const char*)cw + (unsigned)(2 * 5632 + chan) * 4u), bb = *(const f32x4*)((const char*)cb + (unsigned)chan * 4u);
#pragma unroll
                for (int ai = 0; ai < 2; ++ai) {
                    f32x4 prev;
                    if (ai == 0 && wr == 0) prev = (f32x4){0.f, 0.f, 0.f, 0.f};
                    else prev = *(const PG8_LAS f32x4*)(hal + (((ai * 2 + wr - 1) * 2 + hrow) * 256 + bj * 128 + colw + 4 * n));
#pragma unroll
                    for (int m = 0; m < 4; ++m) { const f32x4 cur = acc[ai][bj][m][n]; f32x4 o;
#pragma unroll
                        for (int i = 0; i < 4; ++i) {
                            float s1, s2;
                            asm volatile("s_nop 1\n\tv_mov_b32_dpp %0, %2 row_ror:1 row_mask:0xf bank_mask:0xf\n\tv_mov_b32_dpp %1, %2 row_ror:2 row_mask:0xf bank_mask:0xf\n\t"
                                         "v_mov_b32_dpp %0, %3 row_shr:1 row_mask:0xf bank_mask:0xf\n\tv_mov_b32_dpp %1, %3 row_shr:2 row_mask:0xf bank_mask:0xf"
                                         : "=&v"(s1), "=&v"(s2) : "v"(prev[i]), "v"(cur[i]), "v"(w1[i]), "v"(w0[i]));
                            float t = bb[i] + w2[i] * cur[i] + w1[i] * s1 + w0[i] * s2; asm volatile("" : "+v"(t)); o[i] = t; }
                        acc[ai][bj][m][n] = o; prev = cur; __builtin_amdgcn_sched_barrier(0); }
                }
                asm volatile("" ::: "memory"); __builtin_amdgcn_sched_barrier(0);
            }
#pragma unroll
            for (int ai = 0; ai < 2; ++ai)
#pragma unroll
                for (int m = 0; m < 4; ++m) { int rowb = row0; asm volatile("" : "+v"(rowb)); const f32x4 cg = acc[ai][0][m][n], cv = acc[ai][1][m][n]; float res[4];
#pragma unroll
                    for (int i = 0; i < 4; ++i) { const float g = cg[i]; res[i] = g * __builtin_amdgcn_rcpf(1.0f + __builtin_amdgcn_exp2f(-1.4426950408889634f * g)) * cv[i]; }
                    u32x2 w; w.x = cvt_pk_bf16(res[0], res[1]); w.y = cvt_pk_bf16(res[2], res[3]);
                    const bool skip = (ai == 0) && (m == 0) && (wr == 0) && (fr < 2);
                    if (!skip) *(u32x2*)((char*)G + ((unsigned)(rowb + ai * HALF + m * 16) * 2816u + (unsigned)(c0 + colw + 4 * n)) * 2u) = w; __builtin_amdgcn_sched_barrier(0); }
            asm volatile("" ::: "memory");
        }
    }
};

struct EpiOut {
    static constexpr bool PERM = false, AFTER_DRAIN = false, HAS_MID = true;
    const float* X; float* X1; bf16_t* XB; const PG8_LAS float* tab; float* PS;
    __device__ __forceinline__ void mid(f32x4 (&acc)[2][2][4][2], const Unit& u, int wr, int wc, int fr, int fq) const {
        const PG8_LAS float* t = tab + (u.idx * 256 + wr * 64 + fr) * 2;
#pragma unroll
        for (int ai = 0; ai < 2; ++ai)
#pragma unroll
            for (int m = 0; m < 4; ++m) { const float ratio = t[(ai * HALF + m * 16) * 2];
#pragma unroll
                for (int bj = 0; bj < 2; ++bj)
#pragma unroll
                    for (int n = 0; n < 2; ++n) acc[ai][bj][m][n] = acc[ai][bj][m][n] * ratio; }
    }
    __device__ __forceinline__ void operator()(f32x4 (&acc)[2][2][4][2], const Unit& u, int wr, int wc, int fr, int fq) const {
        const int row0 = u.pm * BM + wr * 64 + fr; const int col0 = u.pn * BM + wc * 32 + 4 * fq;
        const PG8_LAS float* t = tab + (u.idx * 256 + wr * 64 + fr) * 2 + 1;
#pragma unroll
        for (int ai = 0; ai < 2; ++ai)
#pragma unroll
            for (int m = 0; m < 4; ++m) { const int r = row0 + ai * HALF + m * 16; const float rs = t[(ai * HALF + m * 16) * 2]; const size_t off = (size_t)r * 1024 + col0; float sq = 0.f;
#pragma unroll
                for (int bj = 0; bj < 2; ++bj)
#pragma unroll
                    for (int n = 0; n < 2; ++n) { const size_t o2 = off + bj * HALF + n * 16; const f32x4 xv = *(const f32x4*)(X + o2); const f32x4 o = xv + acc[ai][bj][m][n] * rs;
                        *(f32x4*)(X1 + o2) = o; u32x2 w; w.x = cvt_pk_bf16(o[0], o[1]); w.y = cvt_pk_bf16(o[2], o[3]); *(u32x2*)(XB + o2) = w;
                        sq += (o[0] * o[0] + o[1] * o[1]) + (o[2] * o[2] + o[3] * o[3]); }
                sq += __shfl_xor(sq, 16); sq += __shfl_xor(sq, 32);
                if (fq == 0) PS[(size_t)r * 16 + u.pn * 4 + wc] = sq;
                asm volatile("" ::: "memory"); }
    }
};

struct EpiDown {
    static constexpr bool PERM = false, AFTER_DRAIN = false, HAS_MID = false;
    const float* X1; float* OUT; float* PS;
    __device__ __forceinline__ void operator()(f32x4 (&acc)[2][2][4][2], const Unit& u, int wr, int wc, int fr, int fq) const {
        const int row0 = u.pm * BM + wr * 64 + fr; const int col0 = u.pn * BM + wc * 32 + 4 * fq;
#pragma unroll
        for (int ai = 0; ai < 2; ++ai)
#pragma unroll
            for (int m = 0; m < 4; ++m) { const int r = row0 + ai * HALF + m * 16; const size_t off = (size_t)r * 1024 + col0; float sq = 0.f;
#pragma unroll
                for (int bj = 0; bj < 2; ++bj)
#pragma unroll
                    for (int n = 0; n < 2; ++n) { const size_t o2 = off + bj * HALF + n * 16; const f32x4 xv = *(const f32x4*)(X1 + o2); const f32x4 o = xv + acc[ai][bj][m][n];
                        *(f32x4*)(OUT + o2) = o; sq += (o[0] * o[0] + o[1] * o[1]) + (o[2] * o[2] + o[3] * o[3]); }
                sq += __shfl_xor(sq, 16); sq += __shfl_xor(sq, 32);
                if (fq == 0) PS[(size_t)r * 16 + u.pn * 4 + wc] = sq;
                asm volatile("" ::: "memory"); }
    }
};
template <class Epi, class Sched, bool ALIGN_EPI = false, bool SP2 = false>
__device__ __forceinline__ void gemm_phase(PG8_LAS unsigned char* lds, const Gemm g, const Sched& S, const Epi& E) {
    int tid_ = threadIdx.x; asm volatile("" : "+v"(tid_));
    const int tid = tid_, wid = __builtin_amdgcn_readfirstlane(tid >> 6), lane = tid & 63, wr = wid >> 2, wc = wid & 3, fr = lane & 15, fq = lane >> 4;
    const int K = g.K, nt = K / BK;
    unsigned voffA[2], voffB[2];
#pragma unroll
    for (int i = 0; i < 2; ++i) { int R, C; stage_rc(tid * 16 + i * 8192, R, C); const int Rb = Epi::PERM ? ((R & ~31) + perm32(R & 31)) : R;
        voffA[i] = (unsigned)(R * g.lda + C) * 2u; voffB[i] = (unsigned)(Rb * K + C) * 2u; }
    const size_t kstep = (size_t)(BK * 2);
    const size_t hstepA = (size_t)HALF * g.lda * 2, hstepB = (size_t)HALF * K * 2;
    const size_t tstepA = 2 * hstepA, tstepB = 2 * hstepB;
    const unsigned ldsw = (unsigned)wid * 1024u;
    const int aoff = lds_byte(wr * 64 + fr, fq * 8), boff = lds_byte(wc * 32 + fr, fq * 8);
#define PG8_SA(b, h) (((b) * 2 + (h)) * HTB)
#define PG8_SB(b, h) ((4 + (b) * 2 + (h)) * HTB)
#define PG8_STAGE(bufoff, gbase, voff) do { _Pragma("unroll") for (int _i = 0; _i < 2; ++_i) \
        __builtin_amdgcn_global_load_lds((const unsigned*)((const char*)(gbase) + (voff)[_i]), (PG8_LAS unsigned*)(lds + (bufoff) + ldsw + _i * 8192), 16, 0, 0); } while (0)
#define PG8_LDA(dst, b, h) do { _Pragma("unroll") for (int m = 0; m < 4; ++m) _Pragma("unroll") for (int k = 0; k < 2; ++k) dst[m][k] = *(const PG8_LAS bf16x8*)(lds + PG8_SA(b, h) + aoff + m * 2048 + k * 1024); } while (0)
#define PG8_LDB(dst, b, h) do { _Pragma("unroll") for (int n = 0; n < 2; ++n) _Pragma("unroll") for (int k = 0; k < 2; ++k) dst[n][k] = *(const PG8_LAS bf16x8*)(lds + PG8_SB(b, h) + boff + n * 2048 + k * 1024); } while (0)
#define PG8_MMA(ai, bj, At, Bt) do { __builtin_amdgcn_s_setprio(1); _Pragma("unroll") for (int m = 0; m < 4; ++m) _Pragma("unroll") for (int n = 0; n < 2; ++n) _Pragma("unroll") for (int k = 0; k < 2; ++k) \
        acc[ai][bj][m][n] = __builtin_amdgcn_mfma_f32_16x16x32_bf16(Bt[n][k], At[m][k], acc[ai][bj][m][n], 0, 0, 0); __builtin_amdgcn_s_setprio(0); } while (0)
#define PG8_WAIT_V(n) asm volatile("s_waitcnt vmcnt(" #n ")" ::: "memory")
#define PG8_WAIT_L(n) asm volatile("s_waitcnt lgkmcnt(" #n ")" ::: "memory")
#define PG8_BAR __builtin_amdgcn_s_barrier()
#define PG8_SCHED __builtin_amdgcn_sched_barrier(0)
    Unit cur, nxt; int ui = 0;
    if (!S.next(0, cur)) return;
    f32x4 acc[2][2][4][2];
#pragma unroll
    for (int a = 0; a < 2; ++a)
#pragma unroll
        for (int b = 0; b < 2; ++b)
#pragma unroll
            for (int m = 0; m < 4; ++m)
#pragma unroll
                for (int n = 0; n < 2; ++n) acc[a][b][m][n] = (f32x4){0.f, 0.f, 0.f, 0.f};
    bf16x8 At[4][2], B0[2][2], B1[2][2];
    const char* cA = (const char*)g.A + (size_t)cur.pm * tstepA; const char* cB = (const char*)g.Bt + (size_t)cur.pn * tstepB;
    S.a_ready(cur);
    if constexpr (SP2) {
        PG8_STAGE(PG8_SB(0, 0), cB, voffB); PG8_STAGE(PG8_SB(0, 1), cB + hstepB, voffB); PG8_STAGE(PG8_SA(0, 0), cA, voffA); PG8_STAGE(PG8_SA(0, 1), cA + hstepA, voffA);
        if (wr == 1) PG8_BAR;
        PG8_WAIT_V(2); PG8_BAR;
        PG8_STAGE(PG8_SB(1, 0), cB + kstep, voffB); PG8_STAGE(PG8_SA(1, 0), cA + kstep, voffA); PG8_STAGE(PG8_SB(1, 1), cB + hstepB + kstep, voffB);
        PG8_WAIT_V(6); PG8_BAR;
    } else {
        PG8_STAGE(PG8_SB(0, 0), cB, voffB); PG8_STAGE(PG8_SA(0, 0), cA, voffA); PG8_STAGE(PG8_SB(0, 1), cB + hstepB, voffB); PG8_STAGE(PG8_SA(0, 1), cA + hstepA, voffA);
        if (wr == 1) PG8_BAR;
        PG8_WAIT_V(4); PG8_BAR;
        PG8_STAGE(PG8_SB(1, 0), cB + kstep, voffB); PG8_STAGE(PG8_SA(1, 0), cA + kstep, voffA); PG8_STAGE(PG8_SB(1, 1), cB + hstepB + kstep, voffB);
        PG8_WAIT_V(6); PG8_BAR;
    }
    for (;;) {
        const bool has_next = S.next(ui + 1, nxt);
        const char* nA = has_next ? (const char*)g.A + (size_t)nxt.pm * tstepA : cA; const char* nB = has_next ? (const char*)g.Bt + (size_t)nxt.pn * tstepB : cB;
        for (int t = 0; t < nt; t += 2) {
            if constexpr (Epi::HAS_MID) { if (t == (nt >> 1)) E.mid(acc, cur, wr, wc, fr, fq); }
            const bool last = (t == nt - 2);
            const char* a1 = cA + (size_t)(t + 1) * kstep;
            const char* a2 = last ? nA : cA + (size_t)(t + 2) * kstep; const char* b2 = last ? nB : cB + (size_t)(t + 2) * kstep;
            const char* a3 = a2 + kstep; const char* b3 = b2 + kstep;
            if (last && has_next) S.a_ready(nxt);
            if constexpr (SP2) {
            PG8_LDB(B0, 0, 0); PG8_LDB(B1, 0, 1); PG8_SCHED; PG8_LDA(At, 0, 0); PG8_STAGE(PG8_SA(1, 1), a1 + hstepA, voffA);
            PG8_WAIT_V(8); PG8_WAIT_L(0); PG8_BAR; PG8_MMA(0, 0, At, B0); PG8_MMA(0, 1, At, B1); PG8_BAR; PG8_SCHED;
            PG8_LDA(At, 0, 1); PG8_STAGE(PG8_SB(0, 0), b2, voffB); PG8_STAGE(PG8_SB(0, 1), b2 + hstepB, voffB); PG8_STAGE(PG8_SA(0, 0), a2, voffA);
            PG8_WAIT_V(8); PG8_WAIT_L(0); PG8_BAR; PG8_MMA(1, 0, At, B0); PG8_MMA(1, 1, At, B1); PG8_BAR; PG8_SCHED;
            PG8_LDB(B0, 1, 0); PG8_LDB(B1, 1, 1); PG8_SCHED; PG8_LDA(At, 1, 0); PG8_STAGE(PG8_SA(0, 1), a2 + hstepA, voffA);
            PG8_WAIT_V(8); PG8_WAIT_L(0); PG8_BAR; PG8_MMA(0, 0, At, B0); PG8_MMA(0, 1, At, B1); PG8_BAR; PG8_SCHED;
            PG8_LDA(At, 1, 1); PG8_STAGE(PG8_SB(1, 0), b3, voffB); PG8_STAGE(PG8_SB(1, 1), b3 + hstepB, voffB); PG8_STAGE(PG8_SA(1, 0), a3, voffA);
            PG8_WAIT_V(8); PG8_WAIT_L(0); PG8_BAR; PG8_MMA(1, 0, At, B0); PG8_MMA(1, 1, At, B1); PG8_BAR; PG8_SCHED;
            } else {
            PG8_LDB(B0, 0, 0); PG8_SCHED; PG8_LDA(At, 0, 0); PG8_STAGE(PG8_SA(1, 1), a1 + hstepA, voffA);
            PG8_WAIT_L(8); PG8_BAR; PG8_WAIT_L(0); PG8_MMA(0, 0, At, B0); PG8_BAR; PG8_SCHED;
            PG8_LDB(B1, 0, 1); PG8_STAGE(PG8_SB(0, 0), b2, voffB);
            PG8_BAR; PG8_WAIT_L(0); PG8_MMA(0, 1, At, B1); PG8_BAR;
            PG8_LDA(At, 0, 1); PG8_STAGE(PG8_SA(0, 0), a2, voffA);
            PG8_BAR; PG8_WAIT_L(0); PG8_MMA(1, 0, At, B0); PG8_BAR; PG8_SCHED;
            PG8_STAGE(PG8_SB(0, 1), b2 + hstepB, voffB);
            PG8_WAIT_V(6); PG8_BAR; PG8_MMA(1, 1, At, B1); PG8_BAR;
            PG8_LDB(B0, 1, 0); PG8_SCHED; PG8_LDA(At, 1, 0); PG8_STAGE(PG8_SA(0, 1), a2 + hstepA, voffA);
            PG8_WAIT_L(8); PG8_BAR; PG8_WAIT_L(0); PG8_MMA(0, 0, At, B0); PG8_BAR; PG8_SCHED;
            PG8_LDB(B1, 1, 1); PG8_STAGE(PG8_SB(1, 0), b3, voffB);
            PG8_BAR; PG8_WAIT_L(0); PG8_MMA(0, 1, At, B1); PG8_BAR;
            PG8_LDA(At, 1, 1); PG8_STAGE(PG8_SA(1, 0), a3, voffA);
            PG8_BAR; PG8_WAIT_L(0); PG8_MMA(1, 0, At, B0); PG8_BAR; PG8_SCHED;
            PG8_STAGE(PG8_SB(1, 1), b3 + hstepB, voffB);
            PG8_WAIT_V(6); PG8_BAR; PG8_MMA(1, 1, At, B1); PG8_BAR;
            }
        }
        if constexpr (ALIGN_EPI) { if (wr == 0) PG8_BAR; }
        if constexpr (!Epi::AFTER_DRAIN) { E(acc, cur, wr, wc, fr, fq); S.done(cur); }
        if (!has_next) break;
#pragma unroll
        for (int a = 0; a < 2; ++a)
#pragma unroll
            for (int b = 0; b < 2; ++b)
#pragma unroll
                for (int m = 0; m < 4; ++m)
#pragma unroll
                    for (int n = 0; n < 2; ++n) acc[a][b][m][n] = (f32x4){0.f, 0.f, 0.f, 0.f};
        cur = nxt; cA = nA; cB = nB; ++ui;
        if constexpr (ALIGN_EPI) { if (wr == 1) PG8_BAR; }
    }
    PG8_WAIT_V(0);
    if constexpr (!ALIGN_EPI) { if (wr == 0) PG8_BAR; }
    PG8_BAR;
    if constexpr (Epi::AFTER_DRAIN) { E.fused(acc, cur, wr, wc, fr, fq, lds, wid, lane); S.done(cur); }
#undef PG8_SA
#undef PG8_SB
#undef PG8_STAGE
#undef PG8_LDA
#undef PG8_LDB
#undef PG8_MMA
#undef PG8_WAIT_V
#undef PG8_WAIT_L
#undef PG8_BAR
#undef PG8_SCHED
}
}

namespace att {
#define LAS3 __attribute__((address_space(3)))
typedef unsigned short bf16_t;
using bf16x8 = __attribute__((ext_vector_type(8))) short;
using s16x4 = __attribute__((ext_vector_type(4))) short;
using f32x16 = __attribute__((ext_vector_type(16))) float;
using f32x4 = __attribute__((ext_vector_type(4))) float;
using u32x4 = __attribute__((ext_vector_type(4))) unsigned;
using u32x2 = __attribute__((ext_vector_type(2))) unsigned;
constexpr int SEQ = 8192, DM = 1024, KVB = 64, SLOTB = 8192;
constexpr int NS = 4;
constexpr int L_K = 0, L_V = NS * SLOTB, L_F = 2 * NS * SLOTB, L_FB = L_F + NS * 1024, L_OST = L_FB + 1024, OSTW = 4608, L_FLAG = 126976, L_END = L_FLAG + 128;
constexpr float C2 = 0.125f * 1.4426950408889634f;

__device__ __forceinline__ void glds16(const void* gsrc, unsigned lds_dst) { unsigned keep;
    asm volatile("s_mov_b32 %0, m0\n\ts_mov_b32 m0, %2\n\ts_nop 0\n\tglobal_load_lds_dwordx4 %1, off\n\ts_mov_b32 m0, %0" : "=&s"(keep) : "v"(gsrc), "s"(lds_dst) : "memory"); }
typedef float f32x2_t __attribute__((ext_vector_type(2))); typedef __bf16 bf16x2_t __attribute__((ext_vector_type(2)));
__device__ __forceinline__ unsigned cvtpk(float lo, float hi) { f32x2_t v = {lo, hi}; bf16x2_t b = __builtin_convertvector(v, bf16x2_t); return __builtin_bit_cast(unsigned, b); }
#define ATT_WAIT_BAR() asm volatile("s_waitcnt vmcnt(0) lgkmcnt(0)\n\ts_barrier" ::: "memory")
#define ATT_WAIT_N(n) asm volatile("s_waitcnt vmcnt(" #n ") lgkmcnt(0)\n\ts_barrier" ::: "memory")
#define ATT_TILE_WAIT(jt, W0) do { if ((jt) >= 2) { if (W0) ATT_WAIT_N(6); else ATT_WAIT_N(4); } else if ((jt) == 1) { if (W0) ATT_WAIT_N(3); else ATT_WAIT_N(2); } else ATT_WAIT_N(0); } while (0)
typedef short v4i16_t __attribute__((ext_vector_type(4)));
__device__ __forceinline__ s16x4 vtr(const LAS3 unsigned char* p) { return __builtin_bit_cast(s16x4, __builtin_amdgcn_ds_read_tr16_b64_v4i16((LAS3 v4i16_t*)p)); }
__device__ __forceinline__ float other_half(float v) {
    auto rr = __builtin_amdgcn_permlane32_swap(__float_as_uint(v), __float_as_uint(v), false, false);
    const unsigned a = rr[0], b = rr[1];
    return __uint_as_float(a == __float_as_uint(v) ? b : a);
}

template <bool SB>
__device__ __forceinline__ void attn_unit(int b, int hh, int qb, const bf16_t* Q, const bf16_t* __restrict__ K, const bf16_t* __restrict__ V, bf16_t* O,
                                          const float* __restrict__ F2, float* SS, LAS3 unsigned char* shm) {
    const int tid = threadIdx.x, lane = tid & 63, r32 = lane & 31, hi = lane >> 5; const int wid = __builtin_amdgcn_readfirstlane(tid >> 6);
    const long rowbase = (long)b * SEQ; const int q0 = qb * 256, qw0 = q0 + wid * 32;
    const bf16_t* Qw = Q + (rowbase + qw0) * DM + hh * 64;
    const bf16_t* Kh = K + rowbase * DM + hh * 64; const bf16_t* Vh = V + rowbase * DM + hh * 64;
    const unsigned lds0 = (unsigned)(uintptr_t)shm;
    const bf16_t* ksrc = Kh + (long)lane * DM + wid * 8;
    const bf16_t* vsrc = Vh + (long)(16 * (wid & 3) + (lane >> 2)) * DM + (wid >> 2) * 32 + (lane & 3) * 8;
    const unsigned kdst = lds0 + L_K + wid * 1024, vdst = lds0 + L_V + wid * 1024;
#define ATT_DMA(t, slotoff) do { glds16(ksrc + (long)(t) * KVB * DM, (unsigned)__builtin_amdgcn_readfirstlane(kdst + (slotoff))); \
                                 glds16(vsrc + (long)(t) * KVB * DM, (unsigned)__builtin_amdgcn_readfirstlane(vdst + (slotoff))); } while (0)
    const int NT = 4 * qb + 4;
    ATT_DMA(NT - 1, ((NT - 1) & 3) * SLOTB); ATT_DMA(NT - 2, ((NT - 2) & 3) * SLOTB); ATT_DMA(NT - 3, ((NT - 3) & 3) * SLOTB);
    bf16x8 qr[4];
#pragma unroll
    for (int d0 = 0; d0 < 4; ++d0) qr[d0] = *reinterpret_cast<const bf16x8*>(Qw + (long)r32 * DM + d0 * 16 + hi * 8);
    LAS3 float* F2s = (LAS3 float*)(shm + L_F);
    float ft2 = 0.f;
    if (!SB) { const float* Frow = F2 + (long)(b * 8 + hh) * SEQ;
        for (int i = tid; i < (q0 + 256) / 4; i += 512) ((LAS3 f32x4*)F2s)[i] = ((const f32x4*)Frow)[i];
        ft2 = Frow[qw0 + r32]; }
    f32x16 o0, o1;
#pragma unroll
    for (int r = 0; r < 16; ++r) { o0[r] = 0.f; o1[r] = 0.f; }
    float mrun = -INFINITY, lrun = 0.f, carry = 1.f;
    volatile LAS3 unsigned* flags = (volatile LAS3 unsigned*)(shm + L_FLAG);
    const LAS3 unsigned char* kp0 = shm + L_K + hi * 1024 + r32 * 16;
    const LAS3 unsigned char* vp0 = shm + L_V + ((lane >> 4) & 1) * 32 + (lane & 3) * 8 + (4 * hi + ((lane & 15) >> 2)) * 64;
    asm volatile("" :: "v"(qr[0]), "v"(qr[1]), "v"(qr[2]), "v"(qr[3]));
    for (int jt = NT - 1; jt >= 0; --jt) {
        const int slot = jt & 3;
        ATT_TILE_WAIT(jt, false);
        if (SB && jt < NT - 1) { unsigned a = 0;
#pragma unroll
            for (int w = 0; w < 8; ++w) a |= flags[((jt + 1) & 1) * 8 + w];
            if (__builtin_amdgcn_readfirstlane(a) == 0u) break; }
        if (jt >= 3) ATT_DMA(jt - 3, ((jt - 3) & 3) * SLOTB);
        if (64 * jt <= qw0 + 31) {
            const LAS3 unsigned char* kp = kp0 + slot * SLOTB;
            f32x16 p0, p1;
#pragma unroll
            for (int r = 0; r < 16; ++r) { p0[r] = 0.f; p1[r] = 0.f; }
#pragma unroll
            for (int d0 = 0; d0 < 4; ++d0) {
                const bf16x8 k0 = *(const LAS3 bf16x8*)(kp + d0 * 2048), k1 = *(const LAS3 bf16x8*)(kp + d0 * 2048 + 512);
                p0 = __builtin_amdgcn_mfma_f32_32x32x16_bf16(k0, qr[d0], p0, 0, 0, 0);
                p1 = __builtin_amdgcn_mfma_f32_32x32x16_bf16(k1, qr[d0], p1, 0, 0, 0);
            }
            const bool diag = (64 * jt + 63 > qw0 - (SB ? 1 : 0));
            const int kb_ = 64 * jt + 4 * hi - (qw0 + r32);
            if (!SB) {
                const LAS3 float* fsp = F2s + 64 * jt + 4 * hi;
#pragma unroll
                for (int g = 0; g < 4; ++g) { const f32x4 fa = *(const LAS3 f32x4*)(fsp + 8 * g), fb = *(const LAS3 f32x4*)(fsp + 32 + 8 * g);
#pragma unroll
                    for (int i = 0; i < 4; ++i) { p0[4 * g + i] += (ft2 - fa[i]); p1[4 * g + i] += (ft2 - fb[i]); } }
                if (diag) {
#pragma unroll
                    for (int r = 0; r < 16; ++r) { const int cr = (r & 3) + 8 * (r >> 2); if (kb_ + cr > 0) p0[r] = -INFINITY; if (kb_ + cr + 32 > 0) p1[r] = -INFINITY; } }
                float mx = fmaxf(p0[0], p1[0]);
#pragma unroll
                for (int r = 1; r < 16; ++r) mx = fmaxf(mx, fmaxf(p0[r], p1[r]));
                mx = fmaxf(mx, other_half(mx));
                const float mnew = fmaxf(mrun, mx);
                if (__any(mnew > mrun)) { const float alpha = __builtin_amdgcn_exp2f(mrun - mnew); lrun *= alpha;
#pragma unroll
                    for (int r = 0; r < 16; ++r) { o0[r] *= alpha; o1[r] *= alpha; }
                    mrun = mnew; }
                float ls = 0.f;
#pragma unroll
                for (int r = 0; r < 16; ++r) { p0[r] = __builtin_amdgcn_exp2f(p0[r] - mrun); p1[r] = __builtin_amdgcn_exp2f(p1[r] - mrun); ls += p0[r] + p1[r]; }
                lrun += ls;
            } else {
#pragma unroll
                for (int r = 0; r < 16; ++r) { p0[r] = __builtin_amdgcn_rcpf(1.0f + __builtin_amdgcn_exp2f(p0[r])); p1[r] = __builtin_amdgcn_rcpf(1.0f + __builtin_amdgcn_exp2f(p1[r])); }
                if (diag) {
#pragma unroll
                    for (int r = 0; r < 16; ++r) { const int cr = (r & 3) + 8 * (r >> 2); if (kb_ + cr >= 0) p0[r] = 1.0f; if (kb_ + cr + 32 >= 0) p1[r] = 1.0f; } }
                float PP0[4], PP1[4], H0[4], H1[4];
#pragma unroll
                for (int g = 0; g < 4; ++g) { const float g0 = (p0[4 * g] * p0[4 * g + 1]) * (p0[4 * g + 2] * p0[4 * g + 3]), g1 = (p1[4 * g] * p1[4 * g + 1]) * (p1[4 * g + 2] * p1[4 * g + 3]);
                    const float t0 = other_half(g0), t1 = other_half(g1); PP0[g] = g0 * t0; PP1[g] = g1 * t1; H0[g] = hi ? 1.0f : t0; H1[g] = hi ? 1.0f : t1; }
                float T0[4], T1[4];
                T1[3] = carry; T1[2] = T1[3] * PP1[3]; T1[1] = T1[2] * PP1[2]; T1[0] = T1[1] * PP1[1]; const float tot1 = T1[0] * PP1[0];
                T0[3] = tot1; T0[2] = T0[3] * PP0[3]; T0[1] = T0[2] * PP0[2]; T0[0] = T0[1] * PP0[1]; carry = T0[0] * PP0[0];
#pragma unroll
                for (int g = 0; g < 4; ++g) {
                    { const float x3 = T0[g] * H0[g], x2 = x3 * p0[4 * g + 3], x1 = x2 * p0[4 * g + 2], x0 = x1 * p0[4 * g + 1];
                      p0[4 * g + 3] = fmaf(-p0[4 * g + 3], x3, x3); p0[4 * g + 2] = fmaf(-p0[4 * g + 2], x2, x2); p0[4 * g + 1] = fmaf(-p0[4 * g + 1], x1, x1); p0[4 * g] = fmaf(-p0[4 * g], x0, x0); }
                    { const float x3 = T1[g] * H1[g], x2 = x3 * p1[4 * g + 3], x1 = x2 * p1[4 * g + 2], x0 = x1 * p1[4 * g + 1];
                      p1[4 * g + 3] = fmaf(-p1[4 * g + 3], x3, x3); p1[4 * g + 2] = fmaf(-p1[4 * g + 2], x2, x2); p1[4 * g + 1] = fmaf(-p1[4 * g + 1], x1, x1); p1[4 * g] = fmaf(-p1[4 * g], x0, x0); }
                }
            }
            u32x4 pw[4];
#pragma unroll
            for (int i = 0; i < 4; ++i) { pw[0][i] = cvtpk(p0[2 * i], p0[2 * i + 1]); pw[1][i] = cvtpk(p0[8 + 2 * i], p0[8 + 2 * i + 1]); pw[2][i] = cvtpk(p1[2 * i], p1[2 * i + 1]); pw[3][i] = cvtpk(p1[8 + 2 * i], p1[8 + 2 * i + 1]); }
            const LAS3 unsigned char* vp = vp0 + slot * SLOTB;
#pragma unroll
            for (int ks = 0; ks < 4; ++ks) {
                const s16x4 l0 = vtr(vp + ks * 1024), h0 = vtr(vp + ks * 1024 + 512), l1 = vtr(vp + 4096 + ks * 1024), h1 = vtr(vp + 4096 + ks * 1024 + 512);
                const bf16x8 v0 = (bf16x8){l0[0], l0[1], l0[2], l0[3], h0[0], h0[1], h0[2], h0[3]}, v1 = (bf16x8){l1[0], l1[1], l1[2], l1[3], h1[0], h1[1], h1[2], h1[3]};
                const bf16x8 pf = __builtin_bit_cast(bf16x8, pw[ks]);
                o0 = __builtin_amdgcn_mfma_f32_32x32x16_bf16(v0, pf, o0, 0, 0, 0);
                o1 = __builtin_amdgcn_mfma_f32_32x32x16_bf16(v1, pf, o1, 0, 0, 0);
            }
        }
        if (SB) { const bool alive = __any(carry != 0.f) != 0; if (lane == 0) flags[(jt & 1) * 8 + wid] = alive ? 1u : 0u; }
    }
    if (!SB) { lrun += other_half(lrun); const float inv = 1.0f / lrun;
#pragma unroll
        for (int r = 0; r < 16; ++r) { o0[r] *= inv; o1[r] *= inv; } }
    float sq = 0.f;
#pragma unroll
    for (int r = 0; r < 16; ++r) sq += o0[r] * o0[r] + o1[r] * o1[r];
    sq += other_half(sq);
    if (hi == 0) SS[(size_t)(rowbase + qw0 + r32) * 16 + hh] = sq;
    LAS3 unsigned char* stg = shm + L_OST + wid * OSTW;
#pragma unroll
    for (int g = 0; g < 4; ++g) {
        u32x2 w0; w0.x = cvtpk(o0[4 * g], o0[4 * g + 1]); w0.y = cvtpk(o0[4 * g + 2], o0[4 * g + 3]);
        u32x2 w1; w1.x = cvtpk(o1[4 * g], o1[4 * g + 1]); w1.y = cvtpk(o1[4 * g + 2], o1[4 * g + 3]);
        *(LAS3 u32x2*)(stg + r32 * 144 + g * 16 + hi * 8) = w0;
        *(LAS3 u32x2*)(stg + r32 * 144 + 64 + g * 16 + hi * 8) = w1;
    }
    asm volatile("s_waitcnt lgkmcnt(0)" ::: "memory");
    bf16_t* Ow = O + (rowbase + qw0) * DM + hh * 64;
#pragma unroll
    for (int i = 0; i < 4; ++i) { const int row = i * 8 + (lane >> 3), ch = lane & 7; const u32x4 v = *(const LAS3 u32x4*)(stg + row * 144 + ch * 16); *(u32x4*)(Ow + (long)row * DM + ch * 8) = v; }
    ATT_WAIT_BAR();
#undef ATT_DMA
}
__device__ __forceinline__ float max3f(float a, float b, float c) { float r; asm("v_max3_f32 %0, %1, %2, %3" : "=v"(r) : "v"(a), "v"(b), "v"(c)); return r; }
__device__ __forceinline__ void fox_unit(int b, int hh, int qb, const bf16_t* Q, const bf16_t* __restrict__ K, const bf16_t* __restrict__ V, bf16_t* O,
                                         const float* __restrict__ F2, const bf16_t* __restrict__ FS3, const unsigned* __restrict__ KMAX, float* SS, LAS3 unsigned char* shm) {
    constexpr float THR = 8.0f;
    const int tid = threadIdx.x, lane = tid & 63, r32 = lane & 31, hi = lane >> 5; const int wid = __builtin_amdgcn_readfirstlane(tid >> 6);
    const long rowbase = (long)b * SEQ; const int q0 = qb * 256, qw0 = q0 + wid * 32;
    const bf16_t* Qw = Q + (rowbase + qw0) * DM + hh * 64;
    const bf16_t* Kh = K + rowbase * DM + hh * 64; const bf16_t* Vh = V + rowbase * DM + hh * 64;
    const unsigned lds0 = (unsigned)(uintptr_t)shm;
    const bf16_t* ksrc = Kh + (long)lane * DM + wid * 8;
    const bf16_t* vsrc = Vh + (long)(16 * (wid & 3) + (lane >> 2)) * DM + (wid >> 2) * 32 + (lane & 3) * 8;
    const bf16_t* fsrc = FS3 + ((long)(b * 8 + hh) * SEQ + lane) * 8;
    const float* Frow = F2 + (long)(b * 8 + hh) * SEQ;
    const unsigned kdst = lds0 + L_K + wid * 1024, vdst = lds0 + L_V + wid * 1024, fdst = lds0 + L_F;
#define FOX_DMA(t, s_) do { glds16(ksrc + (long)(t) * KVB * DM, (unsigned)__builtin_amdgcn_readfirstlane(kdst + (s_) * SLOTB)); \
                            glds16(vsrc + (long)(t) * KVB * DM, (unsigned)__builtin_amdgcn_readfirstlane(vdst + (s_) * SLOTB)); \
                            if (wid == 0) glds16(fsrc + (long)(t) * KVB * 8, (unsigned)__builtin_amdgcn_readfirstlane(fdst + (s_) * 1024)); } while (0)
    const int NT = 4 * qb + 4;
    FOX_DMA(NT - 1, (NT - 1) & 3); FOX_DMA(NT - 2, (NT - 2) & 3);
    LAS3 float* F2b = (LAS3 float*)(shm + L_FB);
    for (int i = 1 + tid; i < NT; i += 512) F2b[i] = F2[(long)(b * 8 + hh) * SEQ + 64 * i - 1];
    bf16x8 qr[4]; float qn2 = 0.f;
#pragma unroll
    for (int d0 = 0; d0 < 4; ++d0) { qr[d0] = *reinterpret_cast<const bf16x8*>(Qw + (long)r32 * DM + d0 * 16 + hi * 8);
#pragma unroll
        for (int j = 0; j < 8; ++j) { const float f = __builtin_bit_cast(float, (unsigned)(unsigned short)qr[d0][j] << 16); qn2 += f * f; } }
    qn2 += other_half(qn2);
    const float kn = sqrtf(2.0f * __uint_as_float(KMAX[b * 8 + hh])) * 1.01f;
    const float zq = sqrtf(qn2) * kn * 1.01f + 1.0f;
    const float ft2 = Frow[qw0 + r32];
    const short one = (short)0x3F80;
    const bf16x8 onesA = (bf16x8){one, one, one, one, one, one, one, one};
    const bf16x8 qones = hi ? (bf16x8){0, 0, 0, 0, 0, 0, 0, 0} : (bf16x8){one, one, one, 0, 0, 0, 0, 0};
    f32x16 o0, o1, lacc, cinit;
#pragma unroll
    for (int r = 0; r < 16; ++r) { o0[r] = 0.f; o1[r] = 0.f; lacc[r] = 0.f; cinit[r] = ft2 - fminf(zq, 60.0f); }
    const float mref = fminf(zq, 60.0f);
    volatile LAS3 unsigned* flags = (volatile LAS3 unsigned*)(shm + L_FLAG);
    const LAS3 unsigned char* kp0 = shm + L_K + hi * 1024 + r32 * 16;
    const LAS3 unsigned char* vp0 = shm + L_V + ((lane >> 4) & 1) * 32 + (lane & 3) * 8 + (4 * hi + ((lane & 15) >> 2)) * 64;
    const LAS3 unsigned char* fp0 = shm + L_F + r32 * 16;
    bool walive = true;
    for (int jp = NT / 2 - 1; jp >= 0; --jp) {
        ATT_WAIT_BAR();
        if (jp < NT / 2 - 1) { unsigned a = 0;
#pragma unroll
            for (int w = 0; w < 8; ++w) a |= flags[((jp + 1) & 1) * 8 + w];
            if (__builtin_amdgcn_readfirstlane(a) == 0u) break; }
        if (jp >= 1) { FOX_DMA(2 * jp - 1, (2 * jp - 1) & 3); FOX_DMA(2 * jp - 2, (2 * jp - 2) & 3); }
#pragma unroll
      for (int sub = 1; sub >= 0; --sub) { const int jt = 2 * jp + sub; const int slot = jt & 3;
        if (64 * jt <= qw0 + 31 && walive) {
            const LAS3 unsigned char* kp = kp0 + slot * SLOTB; const LAS3 unsigned char* fp = fp0 + slot * 1024;
            asm volatile("" : "+v"(cinit));
            f32x16 p0 = __builtin_amdgcn_mfma_f32_32x32x16_bf16(*(const LAS3 bf16x8*)(fp), qones, cinit, 0, 0, 0);
            f32x16 p1 = __builtin_amdgcn_mfma_f32_32x32x16_bf16(*(const LAS3 bf16x8*)(fp + 512), qones, cinit, 0, 0, 0);
#pragma unroll
            for (int d0 = 0; d0 < 4; ++d0) {
                const bf16x8 k0 = *(const LAS3 bf16x8*)(kp + d0 * 2048), k1 = *(const LAS3 bf16x8*)(kp + d0 * 2048 + 512);
                p0 = __builtin_amdgcn_mfma_f32_32x32x16_bf16(k0, qr[d0], p0, 0, 0, 0);
                p1 = __builtin_amdgcn_mfma_f32_32x32x16_bf16(k1, qr[d0], p1, 0, 0, 0);
            }
            if (64 * jt + 63 > qw0) { const int kb_ = 64 * jt + 4 * hi - (qw0 + r32);
#pragma unroll
                for (int r = 0; r < 16; ++r) { const int cr = (r & 3) + 8 * (r >> 2); if (kb_ + cr > 0) p0[r] = -INFINITY; if (kb_ + cr + 32 > 0) p1[r] = -INFINITY; } }
#pragma unroll
            for (int r = 0; r < 16; ++r) { p0[r] = __builtin_amdgcn_exp2f(p0[r]); p1[r] = __builtin_amdgcn_exp2f(p1[r]); }
            u32x4 pw[4];
#pragma unroll
            for (int i = 0; i < 4; ++i) { pw[0][i] = cvtpk(p0[2 * i], p0[2 * i + 1]); pw[1][i] = cvtpk(p0[8 + 2 * i], p0[8 + 2 * i + 1]); pw[2][i] = cvtpk(p1[2 * i], p1[2 * i + 1]); pw[3][i] = cvtpk(p1[8 + 2 * i], p1[8 + 2 * i + 1]); }
            const LAS3 unsigned char* vp = vp0 + slot * SLOTB;
#pragma unroll
            for (int ks = 0; ks < 4; ++ks) {
                const s16x4 l0 = vtr(vp + ks * 1024), h0 = vtr(vp + ks * 1024 + 512), l1 = vtr(vp + 4096 + ks * 1024), h1 = vtr(vp + 4096 + ks * 1024 + 512);
                const bf16x8 v0 = (bf16x8){l0[0], l0[1], l0[2], l0[3], h0[0], h0[1], h0[2], h0[3]}, v1 = (bf16x8){l1[0], l1[1], l1[2], l1[3], h1[0], h1[1], h1[2], h1[3]};
                const bf16x8 pf = __builtin_bit_cast(bf16x8, pw[ks]);
                o0 = __builtin_amdgcn_mfma_f32_32x32x16_bf16(v0, pf, o0, 0, 0, 0);
                o1 = __builtin_amdgcn_mfma_f32_32x32x16_bf16(v1, pf, o1, 0, 0, 0);
                lacc = __builtin_amdgcn_mfma_f32_32x32x16_bf16(onesA, pf, lacc, 0, 0, 0);
            }
        }
        {
            bool dead = false;
            if (jt > 0) { const float fn = F2b[jt]; dead = (zq + (ft2 - fn) - mref) < -160.0f; }
            walive = __any(!dead) != 0; }
      }
        if (lane == 0) flags[(jp & 1) * 8 + wid] = walive ? 1u : 0u;
    }
    { const float inv = 1.0f / lacc[0];
#pragma unroll
        for (int r = 0; r < 16; ++r) { o0[r] *= inv; o1[r] *= inv; } }
    float sq = 0.f;
#pragma unroll
    for (int r = 0; r < 16; ++r) sq += o0[r] * o0[r] + o1[r] * o1[r];
    sq += other_half(sq);
    if (hi == 0) SS[(size_t)(rowbase + qw0 + r32) * 16 + hh] = sq;
    LAS3 unsigned char* stg = shm + L_OST + wid * OSTW;
#pragma unroll
    for (int g = 0; g < 4; ++g) {
        u32x2 w0; w0.x = cvtpk(o0[4 * g], o0[4 * g + 1]); w0.y = cvtpk(o0[4 * g + 2], o0[4 * g + 3]);
        u32x2 w1; w1.x = cvtpk(o1[4 * g], o1[4 * g + 1]); w1.y = cvtpk(o1[4 * g + 2], o1[4 * g + 3]);
        *(LAS3 u32x2*)(stg + r32 * 144 + g * 16 + hi * 8) = w0;
        *(LAS3 u32x2*)(stg + r32 * 144 + 64 + g * 16 + hi * 8) = w1;
    }
    asm volatile("s_waitcnt lgkmcnt(0)" ::: "memory");
    bf16_t* Ow = O + (rowbase + qw0) * DM + hh * 64;
#pragma unroll
    for (int i = 0; i < 4; ++i) { const int row = i * 8 + (lane >> 3), ch = lane & 7; const u32x4 v = *(const LAS3 u32x4*)(stg + row * 144 + ch * 16); *(u32x4*)(Ow + (long)row * DM + ch * 8) = v; }
    ATT_WAIT_BAR();
#undef FOX_DMA
}

__device__ __forceinline__ void sb_tile(const LAS3 unsigned char* kp, const LAS3 unsigned char* vp, int jt, int qw0, int r32, int hi, const bf16x8 (&qr)[4], float& carry, f32x16& o0, f32x16& o1) {
    f32x16 p0, p1;
#pragma unroll
    for (int r = 0; r < 16; ++r) { p0[r] = 0.f; p1[r] = 0.f; }
#pragma unroll
    for (int d0 = 0; d0 < 4; ++d0) {
        const bf16x8 k0 = *(const LAS3 bf16x8*)(kp + d0 * 2048), k1 = *(const LAS3 bf16x8*)(kp + d0 * 2048 + 512);
        p0 = __builtin_amdgcn_mfma_f32_32x32x16_bf16(k0, qr[d0], p0, 0, 0, 0);
        p1 = __builtin_amdgcn_mfma_f32_32x32x16_bf16(k1, qr[d0], p1, 0, 0, 0);
    }
#pragma unroll
    for (int r = 0; r < 16; ++r) { p0[r] = __builtin_amdgcn_rcpf(1.0f + __builtin_amdgcn_exp2f(p0[r])); p1[r] = __builtin_amdgcn_rcpf(1.0f + __builtin_amdgcn_exp2f(p1[r])); }
    if (64 * jt + 63 > qw0 - 1) { const int kb_ = 64 * jt + 4 * hi - (qw0 + r32);
#pragma unroll
        for (int r = 0; r < 16; ++r) { const int cr = (r & 3) + 8 * (r >> 2); if (kb_ + cr >= 0) p0[r] = 1.0f; if (kb_ + cr + 32 >= 0) p1[r] = 1.0f; } }
    float PP0[4], PP1[4], H0[4], H1[4];
#pragma unroll
    for (int g = 0; g < 4; ++g) { const float g0 = (p0[4 * g] * p0[4 * g + 1]) * (p0[4 * g + 2] * p0[4 * g + 3]), g1 = (p1[4 * g] * p1[4 * g + 1]) * (p1[4 * g + 2] * p1[4 * g + 3]);
        const float t0 = other_half(g0), t1 = other_half(g1); PP0[g] = g0 * t0; PP1[g] = g1 * t1; H0[g] = hi ? 1.0f : t0; H1[g] = hi ? 1.0f : t1; }
    float T0[4], T1[4];
    T1[3] = carry; T1[2] = T1[3] * PP1[3]; T1[1] = T1[2] * PP1[2]; T1[0] = T1[1] * PP1[1]; const float tot1 = T1[0] * PP1[0];
    T0[3] = tot1; T0[2] = T0[3] * PP0[3]; T0[1] = T0[2] * PP0[2]; T0[0] = T0[1] * PP0[1]; carry = T0[0] * PP0[0];
#pragma unroll
    for (int g = 0; g < 4; ++g) {
        { const float x3 = T0[g] * H0[g], x2 = x3 * p0[4 * g + 3], x1 = x2 * p0[4 * g + 2], x0 = x1 * p0[4 * g + 1];
          p0[4 * g + 3] = fmaf(-p0[4 * g + 3], x3, x3); p0[4 * g + 2] = fmaf(-p0[4 * g + 2], x2, x2); p0[4 * g + 1] = fmaf(-p0[4 * g + 1], x1, x1); p0[4 * g] = fmaf(-p0[4 * g], x0, x0); }
        { const float x3 = T1[g] * H1[g], x2 = x3 * p1[4 * g + 3], x1 = x2 * p1[4 * g + 2], x0 = x1 * p1[4 * g + 1];
          p1[4 * g + 3] = fmaf(-p1[4 * g + 3], x3, x3); p1[4 * g + 2] = fmaf(-p1[4 * g + 2], x2, x2); p1[4 * g + 1] = fmaf(-p1[4 * g + 1], x1, x1); p1[4 * g] = fmaf(-p1[4 * g], x0, x0); }
    }
    u32x4 pw[4];
#pragma unroll
    for (int i = 0; i < 4; ++i) { pw[0][i] = cvtpk(p0[2 * i], p0[2 * i + 1]); pw[1][i] = cvtpk(p0[8 + 2 * i], p0[8 + 2 * i + 1]); pw[2][i] = cvtpk(p1[2 * i], p1[2 * i + 1]); pw[3][i] = cvtpk(p1[8 + 2 * i], p1[8 + 2 * i + 1]); }
#pragma unroll
    for (int ks = 0; ks < 4; ++ks) {
        const s16x4 l0 = vtr(vp + ks * 1024), h0 = vtr(vp + ks * 1024 + 512), l1 = vtr(vp + 4096 + ks * 1024), h1 = vtr(vp + 4096 + ks * 1024 + 512);
        const bf16x8 v0 = (bf16x8){l0[0], l0[1], l0[2], l0[3], h0[0], h0[1], h0[2], h0[3]}, v1 = (bf16x8){l1[0], l1[1], l1[2], l1[3], h1[0], h1[1], h1[2], h1[3]};
        const bf16x8 pf = __builtin_bit_cast(bf16x8, pw[ks]);
        o0 = __builtin_amdgcn_mfma_f32_32x32x16_bf16(v0, pf, o0, 0, 0, 0);
        o1 = __builtin_amdgcn_mfma_f32_32x32x16_bf16(v1, pf, o1, 0, 0, 0);
    }
}
__device__ __forceinline__ void sb_unit(int b, int hh, int qb, const bf16_t* Q, const bf16_t* __restrict__ K, const bf16_t* __restrict__ V, bf16_t* O, float* SS, LAS3 unsigned char* shm) {
    constexpr int WV = 7 * SLOTB;
    const int tid = threadIdx.x, lane = tid & 63, r32 = lane & 31, hi = lane >> 5; const int wid = __builtin_amdgcn_readfirstlane(tid >> 6);
    const long rowbase = (long)b * SEQ; const int q0 = qb * 256, qw0 = q0 + wid * 32;
    const bf16_t* Qw = Q + (rowbase + qw0) * DM + hh * 64;
    const bf16_t* Kh = K + rowbase * DM + hh * 64; const bf16_t* Vh = V + rowbase * DM + hh * 64;
    const unsigned lds0 = (unsigned)(uintptr_t)shm;
    const bf16_t* ksrc = Kh + (long)lane * DM + wid * 8;
    const bf16_t* vsrc = Vh + (long)(16 * (wid & 3) + (lane >> 2)) * DM + (wid >> 2) * 32 + (lane & 3) * 8;
    const int T_hi = 4 * qb + 3, T_lo = (4 * qb - 3 > 0) ? 4 * qb - 3 : 0;
    for (int t = T_hi; t >= T_lo; --t) { glds16(ksrc + (long)t * KVB * DM, (unsigned)__builtin_amdgcn_readfirstlane(lds0 + (t - T_lo) * SLOTB + wid * 1024));
                                         glds16(vsrc + (long)t * KVB * DM, (unsigned)__builtin_amdgcn_readfirstlane(lds0 + WV + (t - T_lo) * SLOTB + wid * 1024)); }
    bf16x8 qr[4];
#pragma unroll
    for (int d0 = 0; d0 < 4; ++d0) qr[d0] = *reinterpret_cast<const bf16x8*>(Qw + (long)r32 * DM + d0 * 16 + hi * 8);
    f32x16 o0, o1;
#pragma unroll
    for (int r = 0; r < 16; ++r) { o0[r] = 0.f; o1[r] = 0.f; }
    float carry = 1.f;
    const int kl = hi * 1024 + r32 * 16, vl = ((lane >> 4) & 1) * 32 + (lane & 3) * 8 + (4 * hi + ((lane & 15) >> 2)) * 64;
    volatile LAS3 unsigned char* fbytes = (volatile LAS3 unsigned char*)(shm + L_FLAG);
    asm volatile("" :: "v"(qr[0]), "v"(qr[1]), "v"(qr[2]), "v"(qr[3]));
    ATT_WAIT_BAR();
    for (int jt = (qw0 + 31) >> 6; jt >= T_lo; --jt) {
        sb_tile(shm + (jt - T_lo) * SLOTB + kl, shm + WV + (jt - T_lo) * SLOTB + vl, jt, qw0, r32, hi, qr, carry, o0, o1);
        if (!__any(carry != 0.f)) break;
    }
    bool more = false;
    if (T_lo > 0) {
        const bool alive = __any(carry != 0.f) != 0; if (lane == 0) fbytes[16 + wid] = alive ? (unsigned char)1 : (unsigned char)0;
        ATT_WAIT_BAR();
        const unsigned long long a8 = *(volatile LAS3 unsigned long long*)(shm + L_FLAG + 16);
        more = __builtin_amdgcn_readfirstlane((unsigned)a8 | (unsigned)(a8 >> 32)) != 0u;
    }
    if (more) {
        const unsigned kdst = lds0 + L_K + wid * 1024, vdst = lds0 + L_V + wid * 1024;
#define SB_DMA(t) do { glds16(ksrc + (long)(t) * KVB * DM, (unsigned)__builtin_amdgcn_readfirstlane(kdst + ((t) & 3) * SLOTB)); \
                       glds16(vsrc + (long)(t) * KVB * DM, (unsigned)__builtin_amdgcn_readfirstlane(vdst + ((t) & 3) * SLOTB)); } while (0)
        SB_DMA(T_lo - 1); if (T_lo >= 2) SB_DMA(T_lo - 2); if (T_lo >= 3) SB_DMA(T_lo - 3);
        bool walive = true;
        for (int jt = T_lo - 1; jt >= 0; --jt) {
            ATT_TILE_WAIT(jt, false);
            if (jt < T_lo - 1) { const unsigned long long a8 = *(volatile LAS3 unsigned long long*)(shm + L_FLAG + ((jt + 1) & 1) * 8);
                if (__builtin_amdgcn_readfirstlane((unsigned)a8 | (unsigned)(a8 >> 32)) == 0u) break; }
            if (jt >= 3) SB_DMA(jt - 3);
            if (walive) sb_tile(shm + L_K + (jt & 3) * SLOTB + kl, shm + L_V + (jt & 3) * SLOTB + vl, jt, qw0, r32, hi, qr, carry, o0, o1);
            walive = __any(carry != 0.f) != 0; if (lane == 0) fbytes[(jt & 1) * 8 + wid] = walive ? (unsigned char)1 : (unsigned char)0;
        }
#undef SB_DMA
    }
    ATT_WAIT_BAR();
    float sq = 0.f;
#pragma unroll
    for (int r = 0; r < 16; ++r) sq += o0[r] * o0[r] + o1[r] * o1[r];
    sq += other_half(sq);
    if (hi == 0) SS[(size_t)(rowbase + qw0 + r32) * 16 + hh] = sq;
    LAS3 unsigned char* stg = shm + L_OST + wid * OSTW;
#pragma unroll
    for (int g = 0; g < 4; ++g) {
        u32x2 w0; w0.x = cvtpk(o0[4 * g], o0[4 * g + 1]); w0.y = cvtpk(o0[4 * g + 2], o0[4 * g + 3]);
        u32x2 w1; w1.x = cvtpk(o1[4 * g], o1[4 * g + 1]); w1.y = cvtpk(o1[4 * g + 2], o1[4 * g + 3]);
        *(LAS3 u32x2*)(stg + r32 * 144 + g * 16 + hi * 8) = w0;
        *(LAS3 u32x2*)(stg + r32 * 144 + 64 + g * 16 + hi * 8) = w1;
    }
    asm volatile("s_waitcnt lgkmcnt(0)" ::: "memory");
    bf16_t* Ow = O + (rowbase + qw0) * DM + hh * 64;
#pragma unroll
    for (int i = 0; i < 4; ++i) { const int row = i * 8 + (lane >> 3), ch = lane & 7; const u32x4 v = *(const LAS3 u32x4*)(stg + row * 144 + ch * 16); *(u32x4*)(Ow + (long)row * DM + ch * 8) = v; }
    ATT_WAIT_BAR();
}
}

constexpr int NWAVES = 8;
constexpr int BATCH = 4, SEQ = 8192, DMODEL = 1024, MROWS = BATCH * SEQ, DFF = 2816, NUP = 2 * DFF, INC = 3080;
constexpr float RMS_EPS = 1e-6f, LOG2E = 1.4426950408889634f;
constexpr size_t MiB = 1u << 20;
constexpr size_t WS_WIN = 1 * MiB, WS_WOUT = 7 * MiB, WS_WUP = 9 * MiB, WS_WDN = 20 * MiB;
constexpr size_t WS_LF = 26 * MiB, WS_F2 = 27 * MiB, WS_SS = 28 * MiB, WS_PS = 30 * MiB, WS_PS2 = 32 * MiB, WS_HALO = 34 * MiB;
constexpr size_t WS_XN = 48 * MiB;
constexpr size_t WS_Q = 112 * MiB, WS_K = 176 * MiB, WS_V = 240 * MiB, WS_O = 304 * MiB;
constexpr size_t WS_U = 112 * MiB;
constexpr size_t WS_FS3 = 464 * MiB;
constexpr size_t WS_CTL = 0;
constexpr size_t WS_END = 468 * MiB;
constexpr int RING_BYTES = 131072, LDS_BYTES = 147456;
static_assert(att::L_END <= RING_BYTES && att::L_OST + 8 * att::OSTW <= att::L_FLAG && 14 * att::SLOTB <= att::L_FLAG, "attention LDS map");

#define LAS __attribute__((address_space(3)))
typedef unsigned short bf16;
typedef unsigned v4u __attribute__((ext_vector_type(4)));
typedef float f32x4 __attribute__((ext_vector_type(4)));
__device__ __forceinline__ unsigned f2bf(float f) { unsigned u = __builtin_bit_cast(unsigned, f); return (u + 0x7fffu + ((u >> 16) & 1u)) >> 16; }
__device__ __forceinline__ unsigned pk2(float lo, float hi) { return f2bf(lo) | (f2bf(hi) << 16); }
__device__ __forceinline__ float bf2f(unsigned short h) { return __builtin_bit_cast(float, (unsigned)h << 16); }
__device__ __forceinline__ float wave_sum(float v) {
#pragma unroll
    for (int o = 1; o < 64; o <<= 1) v += __shfl_xor(v, o);
    return v;
}
#define LDS_WAIT() asm volatile("s_waitcnt lgkmcnt(0)" ::: "memory")

#define XB_TMO      128
#define XB_XCNT(j)  (256  + 64 * (j))
#define XB_XSUB(j)  (1280 + 64 * (j))
#define XB_XGEN(j)  (2304 + 64 * (j))
#define XB_TOP      3328
#define XB_TOPGEN   3392
#define XCD_BAR_WORDS 3456
#define XB_SPIN_CAP (1u << 18)

__device__ __forceinline__ unsigned xb_ld(unsigned* p)              { return __hip_atomic_load(p, __ATOMIC_RELAXED, __HIP_MEMORY_SCOPE_AGENT); }
__device__ __forceinline__ unsigned xb_add(unsigned* p, unsigned v) { return __hip_atomic_fetch_add(p, v, __ATOMIC_RELAXED, __HIP_MEMORY_SCOPE_AGENT); }
__device__ __forceinline__ unsigned xb_xcc_id() { return (unsigned)__builtin_amdgcn_s_getreg((3 << 11) | 20) & 0xFu; }
#define XB_SPIN(cond, bar) do { unsigned _sp = 0; while (cond) { __builtin_amdgcn_s_sleep(1); \
    if ((++_sp & 255u) == 0u) { if (xb_ld(&(bar)[XB_TMO])) break; if (_sp > XB_SPIN_CAP) { atomicAdd(&(bar)[XB_TMO], 1u); break; } } } } while (0)

struct XcdBarrier {
    unsigned* bar; unsigned x;
    volatile LAS unsigned* st;
};

__device__ __forceinline__ XcdBarrier xcd_barrier_post(unsigned* bar, volatile LAS unsigned* st) {
    XcdBarrier b; b.bar = bar; b.x = xb_xcc_id(); b.st = st;
    if (threadIdx.x == 0) (void)xb_add(&bar[XB_XCNT(b.x)], 1u);
    return b;
}
__device__ __forceinline__ void xcd_barrier_complete(unsigned* bar, unsigned x, unsigned& nloc, unsigned& nx) {
    const unsigned G = gridDim.x * gridDim.y * gridDim.z;
    unsigned sum, cnt, mine, sp = 0u;
    for (;;) {
        sum = 0u; cnt = 0u; mine = 0u;
#pragma unroll
        for (unsigned j = 0; j < 16; ++j) { const unsigned c = xb_ld(&bar[XB_XCNT(j)]); sum += c; cnt += (c > 0u) ? 1u : 0u; mine = (j == x) ? c : mine; }
        if (sum == G) break;
        __builtin_amdgcn_s_sleep(1);
        if ((++sp & 255u) == 0u) { if (xb_ld(&bar[XB_TMO])) break; if (sp > XB_SPIN_CAP) { atomicAdd(&bar[XB_TMO], 1u); break; } }
    }
    nloc = mine > 0u ? mine : 1u; nx = cnt > 0u ? cnt : 1u;
}

__device__ __forceinline__ void xcd_barrier(const XcdBarrier& b) {
    asm volatile("s_waitcnt vmcnt(0)" ::: "memory");
    __syncthreads();
    if (threadIdx.x == 0) {
        unsigned* bar = b.bar;
        __builtin_amdgcn_s_waitcnt(0);
        unsigned nloc = b.st[0], nx = b.st[1];
        if (nloc == 0u) { xcd_barrier_complete(bar, b.x, nloc, nx); b.st[0] = nloc; b.st[1] = nx; }
        const unsigned old = xb_add(&bar[XB_XSUB(b.x)], 1u);
        const unsigned gen = old / nloc;
        if (old + 1u == (gen + 1u) * nloc) {
            __builtin_amdgcn_fence(__ATOMIC_RELEASE, "agent");
            asm volatile("s_waitcnt vmcnt(0)" ::: "memory");
            const unsigned og = xb_add(&bar[XB_TOP], 1u);
            const unsigned tg = og / nx;
            if (og + 1u == (tg + 1u) * nx) xb_add(&bar[XB_TOPGEN], 1u);
            else XB_SPIN(xb_ld(&bar[XB_TOPGEN]) == tg, bar);
            __builtin_amdgcn_fence(__ATOMIC_ACQUIRE, "agent");
            xb_add(&bar[XB_XGEN(b.x)], 1u);
            asm volatile("s_waitcnt vmcnt(0)" ::: "memory");
        } else {
            XB_SPIN(xb_ld(&bar[XB_XGEN(b.x)]) == gen, bar);
            __builtin_amdgcn_fence(__ATOMIC_ACQUIRE, "agent");
            asm volatile("s_waitcnt vmcnt(0)" ::: "memory");
        }
    }
    __syncthreads();
}

struct Args { const float* in[13]; float* out; unsigned char* ws; int coop_sync; int pad; };

__device__ __forceinline__ void transpose_item(const float* W, int ldw, int K, int srccol0, bf16* WT, int dstrow0, const float* gain, LAS float* scr, int kb, int nb, int lane) {
    const int k0 = 64 * kb, n0 = 32 * nb;
#pragma unroll
    for (int i = 0; i < 32; ++i) { const int kk = 2 * i + (lane >> 5); float w = W[(size_t)(k0 + kk) * ldw + srccol0 + n0 + (lane & 31)]; if (gain) w *= gain[k0 + kk]; scr[kk * 33 + (lane & 31)] = w; }
    LDS_WAIT(); asm volatile("" ::: "memory");
    const int c = lane & 7;
#pragma unroll
    for (int j = 0; j < 4; ++j) { const int n = (lane >> 3) + 8 * j; const LAS float* s = scr + (8 * c) * 33 + n;
        v4u o; o.x = pk2(s[0 * 33], s[1 * 33]); o.y = pk2(s[2 * 33], s[3 * 33]); o.z = pk2(s[4 * 33], s[5 * 33]); o.w = pk2(s[6 * 33], s[7 * 33]);
        *(v4u*)(WT + (size_t)(dstrow0 + n0 + n) * K + k0 + 8 * c) = o; }
    LDS_WAIT(); asm volatile("" ::: "memory");
}

__device__ __forceinline__ float log_sigmoid(float y) { return fminf(y, 0.f) - log1pf(expf(-fabsf(y))); }

__global__ void __launch_bounds__(NWAVES * 64, 2) fwd_megakernel(Args args) {
    extern __shared__ __attribute__((aligned(16))) unsigned char lds_raw[];
    LAS unsigned char* lds = (LAS unsigned char*)lds_raw;
    const int tid = threadIdx.x, lane = tid & 63, wave = __builtin_amdgcn_readfirstlane(tid >> 6);
    const int G = gridDim.x; const int bx = blockIdx.x; const int vcu = (G % 8 == 0) ? (bx % 8) * (G / 8) + bx / 8 : bx;
    const float* x = args.in[0]; const float* attn_g = args.in[1]; const float* w_in = args.in[2]; const float* fbias = args.in[3];
    const float* fox_g = args.in[4]; const float* sb_g = args.in[5]; const float* w_out = args.in[6]; const float* ffn_g = args.in[7];
    const float* w_up = args.in[8]; const float* conv_w = args.in[9]; const float* conv_b = args.in[10]; const float* w_down = args.in[11]; const float* final_g = args.in[12];
    float* out = args.out; unsigned char* ws = args.ws;
    bf16* Win_t = (bf16*)(ws + WS_WIN); bf16* Wout_t = (bf16*)(ws + WS_WOUT); bf16* Wup_t = (bf16*)(ws + WS_WUP); bf16* Wdn_t = (bf16*)(ws + WS_WDN);
    float* LF = (float*)(ws + WS_LF); float* F2 = (float*)(ws + WS_F2); float* SS = (float*)(ws + WS_SS); float* PS = (float*)(ws + WS_PS); float* PS2 = (float*)(ws + WS_PS2);
    float* HALO4 = (float*)(ws + WS_HALO); bf16* XN = (bf16*)(ws + WS_XN); bf16* QB = (bf16*)(ws + WS_Q); bf16* KB = (bf16*)(ws + WS_K); bf16* VB = (bf16*)(ws + WS_V); bf16* OB = (bf16*)(ws + WS_O);
    bf16* UB = (bf16*)(ws + WS_U); bf16* FS3 = (bf16*)(ws + WS_FS3); unsigned* CTL = (unsigned*)(ws + WS_CTL);
    const int gw = vcu * NWAVES + wave, NGW = G * NWAVES;
    volatile LAS unsigned* xst = (volatile LAS unsigned*)(lds + LDS_BYTES - 16);
    if (tid == 0) { xst[0] = 0u; xst[1] = 0u; }
    unsigned* XBAR = (unsigned*)(ws + WS_CTL + 262144);
    __syncthreads();
    XcdBarrier xbar = xcd_barrier_post(XBAR, xst);

    {
        LAS float* scr = (LAS float*)(lds + wave * 16384);
        constexpr int I_IN = 16 * 96, I_OUT = 16 * 32, I_UP = 16 * 176, I_DN = 44 * 32, NITEMS = I_IN + I_OUT + I_UP + I_DN;
        for (int it = gw; it < NITEMS; it += NGW) {
            int r = it;
            if (r < I_IN) { const int kb = r / 96, nb = r % 96, seg = nb >> 4, nbs = nb & 15;
                const int srcc = (seg == 0) ? 0 : (seg == 1) ? 1544 : (seg == 2) ? 512 : (seg == 3) ? 2056 : (seg == 4) ? 1024 : 2568;
                transpose_item(w_in, INC, 1024, srcc, Win_t, seg * 512, nullptr, scr, kb, nbs, lane); continue; } r -= I_IN;
            if (r < I_OUT) { const int kb = r / 32, nb = r % 32; transpose_item(w_out, 1024, 1024, 0, Wout_t, 0, (kb < 8) ? fox_g : (sb_g - 512), scr, kb, nb, lane); continue; } r -= I_OUT;
            if (r < I_UP) { const int kb = r / 176, nb = r % 176, pn = nb >> 3, jb = nb & 7; const int srcc = (jb < 4) ? 128 * pn + 32 * jb : DFF + 128 * pn + 32 * (jb - 4);
                transpose_item(w_up, NUP, 1024, srcc - 32 * nb, Wup_t, 0, ffn_g, scr, kb, nb, lane); continue; } r -= I_UP;
            { const int kb = r / 32, nb = r % 32; transpose_item(w_down, 1024, DFF, 0, Wdn_t, 0, nullptr, scr, kb, nb, lane); }
        }
        __syncthreads();
        LAS float* Wf = (LAS float*)lds;
        for (int i = tid; i < 1024 * 8; i += NWAVES * 64) Wf[i] = w_in[(size_t)(i >> 3) * INC + 1536 + (i & 7)];
        __syncthreads();
        f32x4 gv[4];
#pragma unroll
        for (int j = 0; j < 4; ++j) gv[j] = ((const f32x4*)attn_g)[lane + 64 * j];
        f32x4 vn[4];
        if (gw < MROWS) { const f32x4* xr = (const f32x4*)(x + (size_t)gw * DMODEL) + lane;
#pragma unroll
            for (int j = 0; j < 4; ++j) vn[j] = xr[64 * j]; }
        for (int m = gw; m < MROWS; m += NGW) {
            f32x4 v[4]; float s2 = 0.f;
#pragma unroll
            for (int j = 0; j < 4; ++j) { v[j] = vn[j]; s2 += (v[j].x * v[j].x + v[j].y * v[j].y) + (v[j].z * v[j].z + v[j].w * v[j].w); }
            if (m + NGW < MROWS) { const f32x4* xr = (const f32x4*)(x + (size_t)(m + NGW) * DMODEL) + lane;
#pragma unroll
                for (int j = 0; j < 4; ++j) vn[j] = xr[64 * j]; }
            const float rstd = 1.0f / sqrtf(wave_sum(s2) * (1.0f / DMODEL) + RMS_EPS);
            unsigned long long* o8 = (unsigned long long*)(XN + (size_t)m * DMODEL) + lane;
            float fa[8];
#pragma unroll
            for (int e = 0; e < 8; ++e) fa[e] = 0.f;
#pragma unroll
            for (int j = 0; j < 4; ++j) { v[j] = v[j] * rstd * gv[j];
                o8[64 * j] = (unsigned long long)pk2(v[j].x, v[j].y) | ((unsigned long long)pk2(v[j].z, v[j].w) << 32);
#pragma unroll
                for (int i = 0; i < 4; ++i) { const int k = 256 * j + 4 * lane + i; const f32x4 wa = *(const LAS f32x4*)(Wf + k * 8), wb = *(const LAS f32x4*)(Wf + k * 8 + 4); const float hk = v[j][i];
                    fa[0] += hk * wa[0]; fa[1] += hk * wa[1]; fa[2] += hk * wa[2]; fa[3] += hk * wa[3]; fa[4] += hk * wb[0]; fa[5] += hk * wb[1]; fa[6] += hk * wb[2]; fa[7] += hk * wb[3]; } }
            float r4[4], r2[2], r1;
            { const bool h = (lane & 32) != 0;
#pragma unroll
              for (int e = 0; e < 4; ++e) { const float snd = h ? fa[e] : fa[e + 4], kp = h ? fa[e + 4] : fa[e]; r4[e] = kp + __shfl_xor(snd, 32); } }
            { const bool h = (lane & 16) != 0;
#pragma unroll
              for (int e = 0; e < 2; ++e) { const float snd = h ? r4[e] : r4[e + 2], kp = h ? r4[e + 2] : r4[e]; r2[e] = kp + __shfl_xor(snd, 16); } }
            { const bool h = (lane & 8) != 0; const float snd = h ? r2[0] : r2[1], kp = h ? r2[1] : r2[0]; r1 = kp + __shfl_xor(snd, 8); }
            r1 += __shfl_xor(r1, 4); r1 += __shfl_xor(r1, 2); r1 += __shfl_xor(r1, 1);
            if ((lane & 7) == 0) { const int e = lane >> 3; LF[(size_t)m * 8 + e] = log_sigmoid(r1 + fbias[e]); }
        }
    }
    xcd_barrier(xbar);

    {
        LAS float* wtot = (LAS float*)lds;
        for (int bh = bx; bh < 32; bh += G) {
            const int b = bh >> 3, h = bh & 7; const float* src = LF + ((size_t)b * SEQ) * 8 + h;
            float loc[16]; float s = 0.f;
#pragma unroll
            for (int i = 0; i < 16; ++i) { s += src[(size_t)(tid * 16 + i) * 8]; loc[i] = s; }
            float incl = s;
#pragma unroll
            for (int o = 1; o < 64; o <<= 1) { const float t = __shfl_up(incl, o); if (lane >= o) incl += t; }
            if (lane == 63) wtot[wave] = incl;
            __syncthreads();
            float base = incl - s;
            for (int w = 0; w < wave; ++w) base += wtot[w];
            float* dst = F2 + (size_t)bh * SEQ + tid * 16;
#pragma unroll
            for (int i = 0; i < 16; ++i) { const float f = (base + loc[i]) * LOG2E; dst[i] = f;
                const float nf = -f; const unsigned h1 = f2bf(nf); const float r1 = nf - __builtin_bit_cast(float, h1 << 16); const unsigned h2 = f2bf(r1); const float r2 = r1 - __builtin_bit_cast(float, h2 << 16); const unsigned h3 = f2bf(r2);
                v4u o; o.x = h1 | (h2 << 16); o.y = h3; o.z = 0u; o.w = 0u; *(v4u*)(FS3 + ((size_t)bh * SEQ + tid * 16 + i) * 8) = o; }
            __syncthreads();
        }
        pg8::Gemm g{XN, Win_t, MROWS, 3072, 1024, 1024}; pg8::StaticOrder S; S.init(MROWS, 3072, G, bx);
        pg8::EpiQKV E{QB, 1024, 1024, (size_t)(WS_K - WS_Q) / 2, att::C2, CTL + 64};
        pg8::gemm_phase<pg8::EpiQKV, pg8::StaticOrder, true, true>(lds, g, S, E);
    }
    xcd_barrier(xbar);

    {
        volatile LAS unsigned* qw = (volatile LAS unsigned*)(lds + att::L_FLAG + 64);
        for (;;) {
            if (tid == 0) qw[0] = atomicAdd(CTL, 1u);
            __syncthreads();
            const unsigned idx = qw[0];
            if (idx >= 2048u) break;
            if (idx < 1024u) { const int qb = 31 - (int)(idx >> 5), bh = (int)(idx & 31);
                att::fox_unit(bh >> 3, bh & 7, qb, QB, KB, VB, OB, F2, FS3, CTL + 64, SS, lds); }
            else { const int u = (int)idx - 1024, qb = 31 - (u >> 5), bh = u & 31;
                att::sb_unit(bh >> 3, 8 + (bh & 7), qb, QB, KB, VB, OB, SS, lds); }
        }
    }
    xcd_barrier(xbar);

    {
        pg8::Gemm g{OB, Wout_t, MROWS, 1024, 1024, 1024}; pg8::StaticOrder S; S.init(MROWS, 1024, G, bx);
        LAS float* tab = (LAS float*)(lds + RING_BYTES);
        { pg8::Unit u; for (int ui = 0; ui < 7 && S.next(ui, u); ++ui) if (tid < 256) {
              const float* p = SS + (size_t)(u.pm * 256 + tid) * 16;
              const f32x4 a = *(const f32x4*)p, b = *(const f32x4*)(p + 4), c = *(const f32x4*)(p + 8), d = *(const f32x4*)(p + 12);
              const float sf = ((a[0] + a[1]) + (a[2] + a[3])) + ((b[0] + b[1]) + (b[2] + b[3])), ss = ((c[0] + c[1]) + (c[2] + c[3])) + ((d[0] + d[1]) + (d[2] + d[3]));
              const float rf = 1.0f / sqrtf(sf * (1.0f / 512.0f) + RMS_EPS), rs = 1.0f / sqrtf(ss * (1.0f / 512.0f) + RMS_EPS);
              tab[(ui * 256 + tid) * 2] = rf / rs; tab[(ui * 256 + tid) * 2 + 1] = rs; }
          __syncthreads(); }
        pg8::EpiOut E{x, out, XN, tab, PS};
        pg8::gemm_phase<pg8::EpiOut, pg8::StaticOrder, true, true>(lds, g, S, E);
    }
    xcd_barrier(xbar);

    {
        pg8::Gemm g{XN, Wup_t, MROWS, NUP, 1024, 1024}; pg8::StaticOrder S; S.init(MROWS, NUP, G, bx);
        float* RSTD1 = (float*)(ws + WS_CTL + 65536);
        { pg8::Unit u; for (int ui = 0; S.next(ui, u); ++ui) if (tid < 256) { const int r = u.pm * 256 + tid; RSTD1[r] = __builtin_amdgcn_rsqf(pg8::sum16(PS + (size_t)r * 16) * (1.0f / 1024.0f) + RMS_EPS); }
          __syncthreads(); }
        pg8::EpiUpConv E{UB, RSTD1, HALO4, conv_w, conv_b, (LAS float*)(lds + RING_BYTES)};
        pg8::gemm_phase<pg8::EpiUpConv, pg8::StaticOrder, true, true>(lds, g, S, E);
    }
    xcd_barrier(xbar);

    {
        for (int idx = bx * (NWAVES * 64) + tid; idx < 128 * 2 * 704; idx += G * NWAVES * 64) {
            const int pm = idx / 1408, rem = idx % 1408, t = rem / 704, c4 = (rem % 704) * 4;
            const bool first = (pm & 31) == 0;
            const float* h0 = HALO4 + (size_t)(pm * 4) * 5632; const float* hp = HALO4 + (size_t)((first ? pm : pm - 1) * 4) * 5632;
            const f32x4 z = {0.f, 0.f, 0.f, 0.f};
            f32x4 ug[3], uv[3];
            ug[2] = *(const f32x4*)(h0 + t * 5632 + c4); uv[2] = *(const f32x4*)(h0 + t * 5632 + DFF + c4);
            if (t == 1) { ug[1] = *(const f32x4*)(h0 + c4); uv[1] = *(const f32x4*)(h0 + DFF + c4); } else { ug[1] = first ? z : *(const f32x4*)(hp + 3 * 5632 + c4); uv[1] = first ? z : *(const f32x4*)(hp + 3 * 5632 + DFF + c4); }
            { const int pr = (t == 1) ? 3 : 2; ug[0] = first ? z : *(const f32x4*)(hp + pr * 5632 + c4); uv[0] = first ? z : *(const f32x4*)(hp + pr * 5632 + DFF + c4); }
            f32x4 og = *(const f32x4*)(conv_b + c4), ov = *(const f32x4*)(conv_b + DFF + c4);
#pragma unroll
            for (int k = 0; k < 3; ++k) { og += *(const f32x4*)(conv_w + (size_t)k * NUP + c4) * ug[k]; ov += *(const f32x4*)(conv_w + (size_t)k * NUP + DFF + c4) * uv[k]; }
            float res[4];
#pragma unroll
            for (int i = 0; i < 4; ++i) res[i] = og[i] / (1.0f + __expf(-og[i])) * ov[i];
            unsigned long long o = (unsigned long long)pk2(res[0], res[1]) | ((unsigned long long)pk2(res[2], res[3]) << 32);
            *(unsigned long long*)(UB + (size_t)(pm * 256 + t) * DFF + c4) = o;
        }
    }
    xcd_barrier(xbar);

    {
        pg8::Gemm g{UB, Wdn_t, MROWS, 1024, DFF, DFF}; pg8::StaticOrder S; S.init(MROWS, 1024, G, bx);
        pg8::EpiDown E{out, out, PS2};
        pg8::gemm_phase<pg8::EpiDown, pg8::StaticOrder, true, true>(lds, g, S, E);
    }
    xcd_barrier(xbar);

    {
        int lane6 = threadIdx.x & 63; asm volatile("" : "+v"(lane6));
        f32x4 gv[4];
#pragma unroll
        for (int j = 0; j < 4; ++j) gv[j] = ((const f32x4*)final_g)[lane6 + 64 * j];
        for (int m = gw; m < MROWS; m += NGW) {
            const float rstd = 1.0f / sqrtf(pg8::sum16(PS2 + (size_t)m * 16) * (1.0f / DMODEL) + RMS_EPS);
            f32x4* xr = (f32x4*)(out + (size_t)m * DMODEL) + lane6;
#pragma unroll
            for (int j = 0; j < 4; ++j) { const f32x4 v = xr[64 * j]; xr[64 * j] = v * rstd * gv[j]; }
        }
    }
    if (args.coop_sync) cg::this_grid().sync();
}

extern "C" void kernel_launch(void* const* d_in, const int* in_sizes, int n_in, void* d_out, int out_size, void* d_ws, size_t ws_size, hipStream_t stream) {
    static int grid = 0;
    if (grid == 0) {
        if (n_in != 13 || ws_size < WS_END) { fprintf(stderr, "kernel_launch: unexpected inputs (n_in %d, ws %zu)\n", n_in, ws_size); grid = -1; return; }
        int dev = 0, cus = 0, per_cu = 0;
        hipGetDevice(&dev); hipDeviceGetAttribute(&cus, hipDeviceAttributeMultiprocessorCount, dev);
        hipFuncSetAttribute((const void*)fwd_megakernel, hipFuncAttributeMaxDynamicSharedMemorySize, LDS_BYTES);
        hipOccupancyMaxActiveBlocksPerMultiprocessor(&per_cu, (const void*)fwd_megakernel, NWAVES * 64, LDS_BYTES);
        (void)hipGetLastError();
        if (per_cu < 1) per_cu = 1;
        grid = cus * per_cu; if (grid > 256) grid = 256;
    }
    if (grid < 0) return;
    if (hipMemsetAsync((unsigned char*)d_ws + WS_CTL, 0, 262144 + 16384, stream) != hipSuccess) { fprintf(stderr, "kernel_launch: hipMemsetAsync failed\n"); return; }
    Args a{};
    for (int i = 0; i < 13; ++i) a.in[i] = (const float*)d_in[i];
    a.out = (float*)d_out; a.ws = (unsigned char*)d_ws;
    void* kargs[] = {&a};
    hipError_t e = hipLaunchCooperativeKernel((const void*)fwd_megakernel, dim3(grid), dim3(NWAVES * 64), kargs, LDS_BYTES, stream);
    if (e != hipSuccess) fprintf(stderr, "cooperative launch failed: %s (grid %d)\n", hipGetErrorString(e), grid);
}
```

```cpp
#include <hip/hip_runtime.h>
#include <hip/hip_cooperative_groups.h>
#include <cstdio>
#include <cstdint>
#include <cmath>
namespace cg = cooperative_groups;
namespace pg8 {
#define PG8_LAS __attribute__((address_space(3)))
typedef unsigned short bf16_t;
typedef short bf16x8 __attribute__((ext_vector_type(8)));
typedef float f32x4 __attribute__((ext_vector_type(4)));
typedef unsigned u32x4 __attribute__((ext_vector_type(4)));
constexpr int BM = 256, BK = 64, HALF = 128, HTB = HALF * BK * 2  , STAGE_BYTES = 8 * HTB, NXCD = 8, WGM = 8;

__host__ __device__ __forceinline__ int lds_byte(int r, int c) { const int st = (r >> 4) * 2 + (c >> 5), rr = r & 15, cc = c & 31, ob = rr * 64 + cc * 2; return st * 1024 + (ob ^ (((ob >> 9) & 1) << 5)); }
__host__ __device__ __forceinline__ void stage_rc(int b, int& R, int& C) { const int st = b / 1024, sb = b % 1024, swz = sb ^ (((sb >> 9) & 1) << 5); R = (st >> 1) * 16 + swz / 64; C = (st & 1) * 32 + (swz % 64) / 2; }
__host__ __device__ __forceinline__ int perm32(int rho) { const int n = rho >> 4, i = rho & 15; return 8 * (i >> 2) + 4 * n + (i & 3); }

struct Unit { int pm, pn, idx; };
struct Gemm { const bf16_t* A; const bf16_t* Bt; int M, N, K, lda; };

struct StaticOrder {
    int nM, nN, nwg, G, c;
    __host__ __device__ void init(int M, int N, int G_, int c_) { nM = M / BM; nN = N / BM; nwg = nM * nN; G = G_; c = c_; }
    __host__ __device__ bool next(int i, Unit& u) const {
        const long L = (long)i * G + c; if (L >= nwg) return false;
        int wgid = (int)L; { const int q = nwg / NXCD, r = nwg % NXCD, xcd = wgid % NXCD, off = wgid / NXCD; wgid = (xcd < r ? xcd * (q + 1) : r * (q + 1) + (xcd - r) * q) + off; }
        const int nig = WGM * nN, gid = wgid / nig, fm = gid * WGM, gsz = (nM - fm) < WGM ? (nM - fm) : WGM;
        u.pm = fm + ((wgid % nig) % gsz); u.pn = (wgid % nig) / gsz; u.idx = i; return true;
    }
    __device__ __forceinline__ void a_ready(const Unit&) const {}
    __device__ __forceinline__ void done(const Unit&) const {}
};

__device__ __forceinline__ unsigned cvt_pk_bf16(float lo, float hi) { unsigned r; asm volatile("v_cvt_pk_bf16_f32 %0, %1, %2" : "=v"(r) : "v"(lo), "v"(hi)); return r; }
typedef float f32x2 __attribute__((ext_vector_type(2)));

typedef unsigned u32x2 __attribute__((ext_vector_type(2)));
constexpr float RMS_EPS = 1e-6f;
__device__ __forceinline__ float sum16(const float* p) {
    const f32x4 a = *(const f32x4*)p, b = *(const f32x4*)(p + 4), c = *(const f32x4*)(p + 8), d = *(const f32x4*)(p + 12);
    return ((a[0] + a[1]) + (a[2] + a[3])) + ((b[0] + b[1]) + (b[2] + b[3])) + ((c[0] + c[1]) + (c[2] + c[3])) + ((d[0] + d[1]) + (d[2] + d[3]));
}

struct EpiQKV {
    static constexpr bool PERM = true, AFTER_DRAIN = false, HAS_MID = false;
    bf16_t* O; int ldc; int split_cols; size_t split_stride; float scale0; unsigned* kmax;
    __device__ __forceinline__ void operator()(f32x4 (&acc)[2][2][4][2], const Unit& u, int wr, int wc, int fr, int fq) const {
        const int row0 = u.pm * BM + wr * 64 + fr; int colt = u.pn * BM; bf16_t* base = O;
        float sc = 1.f; const int t = colt / split_cols; { base += (size_t)t * split_stride; colt -= t * split_cols; if (t == 0) sc = scale0; }
        const int col0 = colt + wc * 32 + 8 * fq;
        const bool knorm = (t == 1) && (colt < 512);
        float hm[2] = {0.f, 0.f};
#pragma unroll
        for (int ai = 0; ai < 2; ++ai)
#pragma unroll
            for (int m = 0; m < 4; ++m) { bf16_t* rowp = base + (size_t)(row0 + ai * HALF + m * 16) * ldc + col0;
#pragma unroll
                for (int bj = 0; bj < 2; ++bj) { f32x4 v0 = acc[ai][bj][m][0] * sc, v1 = acc[ai][bj][m][1] * sc;
                    u32x4 w; w.x = cvt_pk_bf16(v0[0], v0[1]); w.y = cvt_pk_bf16(v0[2], v0[3]); w.z = cvt_pk_bf16(v1[0], v1[1]); w.w = cvt_pk_bf16(v1[2], v1[3]);
                    *(u32x4*)(rowp + bj * HALF) = w;
                    if (knorm) { float s = ((v0[0] * v0[0] + v0[1] * v0[1]) + (v0[2] * v0[2] + v0[3] * v0[3])) + ((v1[0] * v1[0] + v1[1] * v1[1]) + (v1[2] * v1[2] + v1[3] * v1[3]));
                        s += __shfl_xor(s, 16); s += __shfl_xor(s, 32); hm[bj] = fmaxf(hm[bj], s); } } }
        if (knorm) {
#pragma unroll
            for (int o = 1; o < 16; o <<= 1) { hm[0] = fmaxf(hm[0], __shfl_xor(hm[0], o)); hm[1] = fmaxf(hm[1], __shfl_xor(hm[1], o)); }
            if (fr == 0 && fq == 0) { const int b = (u.pm * BM) >> 13;
                atomicMax(kmax + b * 8 + ((colt + wc * 32) >> 6), __float_as_uint(hm[0])); atomicMax(kmax + b * 8 + ((colt + 128 + wc * 32) >> 6), __float_as_uint(hm[1])); } }
    }
};

#define PG8_DPP(v, ctrl) __builtin_bit_cast(float, __builtin_amdgcn_update_dpp(0, __builtin_bit_cast(int, (v)), (ctrl), 0xf, 0xf, true))
struct EpiUpConv {
    static constexpr bool PERM = true, AFTER_DRAIN = false, HAS_MID = false;
    bf16_t* G; const float* PS  ; float* HALO4; const float* cw; const float* cb; PG8_LAS float* hal;
    __device__ __forceinline__ void operator()(f32x4 (&acc)[2][2][4][2], const Unit& u, int wr, int wc, int fr_, int fq_) const {
        int fr = fr_, fq = fq_; asm volatile("" : "+v"(fr), "+v"(fq));
        const int row0 = u.pm * BM + wr * 64 + fr; const int colw = wc * 32 + 8 * fq; const int c0 = u.pn * 128;
#pragma unroll
        for (int ai = 0; ai < 2; ++ai)
#pragma unroll
            for (int m = 0; m < 4; ++m) { const int r = row0 + ai * HALF + m * 16; const float rs = *(const float*)((const char*)PS + (unsigned)r * 4u);
#pragma unroll
                for (int bj = 0; bj < 2; ++bj)
#pragma unroll
                    for (int n = 0; n < 2; ++n) acc[ai][bj][m][n] = acc[ai][bj][m][n] * rs;
                asm volatile("" ::: "memory"); __builtin_amdgcn_sched_barrier(0); }
        f32x4 W[2][4];
#define PG8_LDW(BUF, N_, BJ_) do { const unsigned ch_ = (unsigned)((BJ_) * 2816 + c0 + colw + 4 * (N_)) * 4u; \
            W[BUF][0] = *(const f32x4*)((const char*)cw + ch_); W[BUF][1] = *(const f32x4*)((const char*)cw + 5632u * 4u + ch_); \
            W[BUF][2] = *(const f32x4*)((const char*)cw + 2u * 5632u * 4u + ch_); W[BUF][3] = *(const f32x4*)((const char*)cb + ch_); } while (0)
        PG8_LDW(0, 0, 0);
        if (fr >= 14) {
#pragma unroll
            for (int ai = 0; ai < 2; ++ai)
#pragma unroll
                for (int bj = 0; bj < 2; ++bj)
#pragma unroll
                    for (int n = 0; n < 2; ++n) *(PG8_LAS f32x4*)(hal + (((ai * 2 + wr) * 2 + (fr - 14)) * 256 + bj * 128 + colw + 4 * n)) = acc[ai][bj][3][n];
            if (wr == 1) {
#pragma unroll
                for (int bj = 0; bj < 2; ++bj)
#pragma unroll
                    for (int n = 0; n < 2; ++n) *(f32x4*)(HALO4 + (size_t)(u.pm * 4 + 2 + (fr - 14)) * 5632 + bj * 2816 + c0 + colw + 4 * n) = acc[1][bj][3][n]; }
        }
        if (wr == 0 && fr < 2) {
#pragma unroll
            for (int bj = 0; bj < 2; ++bj)
#pragma unroll
                for (int n = 0; n < 2; ++n) *(f32x4*)(HALO4 + (size_t)(u.pm * 4 + fr) * 5632 + bj * 2816 + c0 + colw + 4 * n) = acc[0][bj][0][n]; }
        asm volatile("s_waitcnt lgkmcnt(0)\n\ts_barrier" ::: "memory");
        const int hrow = (fr == 15) ? 1 : 0;
#pragma unroll
        for (int n = 0; n < 2; ++n) {
#pragma unroll
            for (int bj = 0; bj < 2; ++bj) {
                const int gi = n * 2 + bj;
                if (gi == 0) PG8_LDW(1, 0, 1); else if (gi == 1) PG8_LDW(0, 1, 0); else if (gi == 2) PG8_LDW(1, 1, 1);
                const f32x4 w0 = W[gi & 1][0], w1 = W[gi & 1][1], w2 = W[gi & 1][2], bb = W[gi & 1][3];
#pragma unroll
                for (int ai = 0; ai < 2; ++ai) {
                    f32x4 prev;
                    if (ai == 0 && wr == 0) prev = (f32x4){0.f, 0.f, 0.f, 0.f};
                    else prev = *(const PG8_LAS f32x4*)(hal + (((ai * 2 + wr - 1) * 2 + hrow) * 256 + bj * 128 + colw + 4 * n));
#pragma unroll
                    for (int m = 0; m < 4; ++m) { const f32x4 cur = acc[ai][bj][m][n]; f32x4 o;
#pragma unroll
                        for (int i = 0; i < 4; ++i) {
                            float s1, s2;
                            asm volatile("s_nop 1\n\tv_mov_b32_dpp %0, %2 row_ror:1 row_mask:0xf bank_mask:0xf\n\tv_mov_b32_dpp %1, %2 row_ror:2 row_mask:0xf bank_mask:0xf\n\t"
                                         "v_mov_b32_dpp %0, %3 row_shr:1 row_mask:0xf bank_mask:0xf\n\tv_mov_b32_dpp %1, %3 row_shr:2 row_mask:0xf bank_mask:0xf"
                                         : "=&v"(s1), "=&v"(s2) : "v"(prev[i]), "v"(cur[i]), "v"(w1[i]), "v"(w0[i]));
                            float t = bb[i] + w2[i] * cur[i] + w1[i] * s1 + w0[i] * s2; asm volatile("" : "+v"(t)); o[i] = t; }
                        acc[ai][bj][m][n] = o; prev = cur; __builtin_amdgcn_sched_barrier(0); }
                }
                asm volatile("" ::: "memory"); __builtin_amdgcn_sched_barrier(0);
            }
#pragma unroll
            for (int ai = 0; ai < 2; ++ai)
#pragma unroll
                for (int m = 0; m < 4; ++m) { int rowb = row0; asm volatile("" : "+v"(rowb)); const f32x4 cg = acc[ai][0][m][n], cv = acc[ai][1][m][n]; float res[4];
#pragma unroll
                    for (int i = 0; i < 4; ++i) { const float g = cg[i]; res[i] = g * __builtin_amdgcn_rcpf(1.0f + __builtin_amdgcn_exp2f(-1.4426950408889634f * g)) * cv[i]; }
                    u32x2 w; w.x = cvt_pk_bf16(res[0], res[1]); w.y = cvt_pk_bf16(res[2], res[3]);
                    const bool skip = (ai == 0) && (m == 0) && (wr == 0) && (fr < 2);
                    if (!skip) *(u32x2*)((char*)G + ((unsigned)(rowb + ai * HALF + m * 16) * 2816u + (unsigned)(c0 + colw + 4 * n)) * 2u) = w; __builtin_amdgcn_sched_barrier(0); }
            asm volatile("" ::: "memory");
        }
    }
};

struct EpiOut {
    static constexpr bool PERM = false, AFTER_DRAIN = false, HAS_MID = true;
    const float* X; float* X1; bf16_t* XB; const PG8_LAS float* tab; float* PS;
    __device__ __forceinline__ void mid(f32x4 (&acc)[2][2][4][2], const Unit& u, int wr, int wc, int fr, int fq) const {
        const PG8_LAS float* t = tab + (u.idx * 256 + wr * 64 + fr) * 2;
#pragma unroll
        for (int ai = 0; ai < 2; ++ai)
#pragma unroll
            for (int m = 0; m < 4; ++m) { const float ratio = t[(ai * HALF + m * 16) * 2];
#pragma unroll
                for (int bj = 0; bj < 2; ++bj)
#pragma unroll
                    for (int n = 0; n < 2; ++n) acc[ai][bj][m][n] = acc[ai][bj][m][n] * ratio; }
    }
    __device__ __forceinline__ void operator()(f32x4 (&acc)[2][2][4][2], const Unit& u, int wr, int wc, int fr, int fq) const {
        const int row0 = u.pm * BM + wr * 64 + fr; const int col0 = u.pn * BM + wc * 32 + 4 * fq;
        const PG8_LAS float* t = tab + (u.idx * 256 + wr * 64 + fr) * 2 + 1;
#pragma unroll
        for (int ai = 0; ai < 2; ++ai)
#pragma unroll
            for (int m = 0; m < 4; ++m) { const int r = row0 + ai * HALF + m * 16; const float rs = t[(ai * HALF + m * 16) * 2]; const size_t off = (size_t)r * 1024 + col0; float sq = 0.f;
#pragma unroll
                for (int bj = 0; bj < 2; ++bj)
#pragma unroll
                    for (int n = 0; n < 2; ++n) { const size_t o2 = off + bj * HALF + n * 16; const f32x4 xv = *(const f32x4*)(X + o2); const f32x4 o = xv + acc[ai][bj][m][n] * rs;
                        *(f32x4*)(X1 + o2) = o; u32x2 w; w.x = cvt_pk_bf16(o[0], o[1]); w.y = cvt_pk_bf16(o[2], o[3]); *(u32x2*)(XB + o2) = w;
                        sq += (o[0] * o[0] + o[1] * o[1]) + (o[2] * o[2] + o[3] * o[3]); }
                sq += __shfl_xor(sq, 16); sq += __shfl_xor(sq, 32);
                if (fq == 0) PS[(size_t)r * 16 + u.pn * 4 + wc] = sq;
                asm volatile("" ::: "memory"); }
    }
};

struct EpiDown {
    static constexpr bool PERM = false, AFTER_DRAIN = false, HAS_MID = false;
    const float* X1; float* OUT; float* PS;
    __device__ __forceinline__ void operator()(f32x4 (&acc)[2][2][4][2], const Unit& u, int wr, int wc, int fr, int fq) const {
        const int row0 = u.pm * BM + wr * 64 + fr; const int col0 = u.pn * BM + wc * 32 + 4 * fq;
#pragma unroll
        for (int ai = 0; ai < 2; ++ai)
#pragma unroll
            for (int m = 0; m < 4; ++m) { const int r = row0 + ai * HALF + m * 16; const size_t off = (size_t)r * 1024 + col0; float sq = 0.f;
#pragma unroll
                for (int bj = 0; bj < 2; ++bj)
#pragma unroll
                    for (int n = 0; n < 2; ++n) { const size_t o2 = off + bj * HALF + n * 16; const f32x4 xv = *(const f32x4*)(X1 + o2); const f32x4 o = xv + acc[ai][bj][m][n];
                        *(f32x4*)(OUT + o2) = o; sq += (o[0] * o[0] + o[1] * o[1]) + (o[2] * o[2] + o[3] * o[3]); }
                sq += __shfl_xor(sq, 16); sq += __shfl_xor(sq, 32);
                if (fq == 0) PS[(size_t)r * 16 + u.pn * 4 + wc] = sq;
                asm volatile("" ::: "memory"); }
    }
};
template <class Epi, class Sched, bool ALIGN_EPI = false, bool SP2 = false>
__device__ __forceinline__ void gemm_phase(PG8_LAS unsigned char* lds, const Gemm g, const Sched& S, const Epi& E) {
    int tid_ = threadIdx.x; asm volatile("" : "+v"(tid_));
    const int tid = tid_, wid = __builtin_amdgcn_readfirstlane(tid >> 6), lane = tid & 63, wr = wid >> 2, wc = wid & 3, fr = lane & 15, fq = lane >> 4;
    const int K = g.K, nt = K / BK;
    unsigned voffA[2], voffB[2];
#pragma unroll
    for (int i = 0; i < 2; ++i) { int R, C; stage_rc(tid * 16 + i * 8192, R, C); const int Rb = Epi::PERM ? ((R & ~31) + perm32(R & 31)) : R;
        voffA[i] = (unsigned)(R * g.lda + C) * 2u; voffB[i] = (unsigned)(Rb * K + C) * 2u; }
    const size_t kstep = (size_t)(BK * 2);
    const size_t hstepA = (size_t)HALF * g.lda * 2, hstepB = (size_t)HALF * K * 2;
    const size_t tstepA = 2 * hstepA, tstepB = 2 * hstepB;
    const unsigned ldsw = (unsigned)wid * 1024u;
    const int aoff = lds_byte(wr * 64 + fr, fq * 8), boff = lds_byte(wc * 32 + fr, fq * 8);
#define PG8_SA(b, h) (((b) * 2 + (h)) * HTB)
#define PG8_SB(b, h) ((4 + (b) * 2 + (h)) * HTB)
#define PG8_STAGE(bufoff, gbase, voff) do { _Pragma("unroll") for (int _i = 0; _i < 2; ++_i) \
        __builtin_amdgcn_global_load_lds((const unsigned*)((const char*)(gbase) + (voff)[_i]), (PG8_LAS unsigned*)(lds + (bufoff) + ldsw + _i * 8192), 16, 0, 0); } while (0)
#define PG8_LDA(dst, b, h) do { _Pragma("unroll") for (int m = 0; m < 4; ++m) _Pragma("unroll") for (int k = 0; k < 2; ++k) dst[m][k] = *(const PG8_LAS bf16x8*)(lds + PG8_SA(b, h) + aoff + m * 2048 + k * 1024); } while (0)
#define PG8_LDB(dst, b, h) do { _Pragma("unroll") for (int n = 0; n < 2; ++n) _Pragma("unroll") for (int k = 0; k < 2; ++k) dst[n][k] = *(const PG8_LAS bf16x8*)(lds + PG8_SB(b, h) + boff + n * 2048 + k * 1024); } while (0)
#define PG8_MMA(ai, bj, At, Bt) do { __builtin_amdgcn_s_setprio(1); _Pragma("unroll") for (int m = 0; m < 4; ++m) _Pragma("unroll") for (int n = 0; n < 2; ++n) _Pragma("unroll") for (int k = 0; k < 2; ++k) \
        acc[ai][bj][m][n] = __builtin_amdgcn_mfma_f32_16x16x32_bf16(Bt[n][k], At[m][k], acc[ai][bj][m][n], 0, 0, 0); __builtin_amdgcn_s_setprio(0); } while (0)
#define PG8_WAIT_V(n) asm volatile("s_waitcnt vmcnt(" #n ")" ::: "memory")
#define PG8_WAIT_L(n) asm volatile("s_waitcnt lgkmcnt(" #n ")" ::: "memory")
#define PG8_BAR __builtin_amdgcn_s_barrier()
#define PG8_SCHED __builtin_amdgcn_sched_barrier(0)
    Unit cur, nxt; int ui = 0;
    if (!S.next(0, cur)) return;
    f32x4 acc[2][2][4][2];
#pragma unroll
    for (int a = 0; a < 2; ++a)
#pragma unroll
        for (int b = 0; b < 2; ++b)
#pragma unroll
            for (int m = 0; m < 4; ++m)
#pragma unroll
                for (int n = 0; n < 2; ++n) acc[a][b][m][n] = (f32x4){0.f, 0.f, 0.f, 0.f};
    bf16x8 At[4][2], B0[2][2], B1[2][2];
    const char* cA = (const char*)g.A + (size_t)cur.pm * tstepA; const char* cB = (const char*)g.Bt + (size_t)cur.pn * tstepB;
    S.a_ready(cur);
    if constexpr (SP2) {
        PG8_STAGE(PG8_SB(0, 0), cB, voffB); PG8_STAGE(PG8_SB(0, 1), cB + hstepB, voffB); PG8_STAGE(PG8_SA(0, 0), cA, voffA); PG8_STAGE(PG8_SA(0, 1), cA + hstepA, voffA);
        if (wr == 1) PG8_BAR;
        PG8_WAIT_V(2); PG8_BAR;
        PG8_STAGE(PG8_SB(1, 0), cB + kstep, voffB); PG8_STAGE(PG8_SA(1, 0), cA + kstep, voffA); PG8_STAGE(PG8_SB(1, 1), cB + hstepB + kstep, voffB);
        PG8_WAIT_V(6); PG8_BAR;
    } else {
        PG8_STAGE(PG8_SB(0, 0), cB, voffB); PG8_STAGE(PG8_SA(0, 0), cA, voffA); PG8_STAGE(PG8_SB(0, 1), cB + hstepB, voffB); PG8_STAGE(PG8_SA(0, 1), cA + hstepA, voffA);
        if (wr == 1) PG8_BAR;
        PG8_WAIT_V(4); PG8_BAR;
        PG8_STAGE(PG8_SB(1, 0), cB + kstep, voffB); PG8_STAGE(PG8_SA(1, 0), cA + kstep, voffA); PG8_STAGE(PG8_SB(1, 1), cB + hstepB + kstep, voffB);
        PG8_WAIT_V(6); PG8_BAR;
    }
    for (;;) {
        const bool has_next = S.next(ui + 1, nxt);
        const char* nA = has_next ? (const char*)g.A + (size_t)nxt.pm * tstepA : cA; const char* nB = has_next ? (const char*)g.Bt + (size_t)nxt.pn * tstepB : cB;
        for (int t = 0; t < nt; t += 2) {
            if constexpr (Epi::HAS_MID) { if (t == (nt >> 1)) E.mid(acc, cur, wr, wc, fr, fq); }
            const bool last = (t == nt - 2);
            const char* a1 = cA + (size_t)(t + 1) * kstep;
            const char* a2 = last ? nA : cA + (size_t)(t + 2) * kstep; const char* b2 = last ? nB : cB + (size_t)(t + 2) * kstep;
            const char* a3 = a2 + kstep; const char* b3 = b2 + kstep;
            if (last && has_next) S.a_ready(nxt);
            if constexpr (SP2) {
            PG8_LDB(B0, 0, 0); PG8_LDB(B1, 0, 1); PG8_SCHED; PG8_LDA(At, 0, 0); PG8_STAGE(PG8_SA(1, 1), a1 + hstepA, voffA);
            PG8_WAIT_V(8); PG8_WAIT_L(0); PG8_BAR; PG8_MMA(0, 0, At, B0); PG8_MMA(0, 1, At, B1); PG8_BAR; PG8_SCHED;
            PG8_LDA(At, 0, 1); PG8_STAGE(PG8_SB(0, 0), b2, voffB); PG8_STAGE(PG8_SB(0, 1), b2 + hstepB, voffB); PG8_STAGE(PG8_SA(0, 0), a2, voffA);
            PG8_WAIT_V(8); PG8_WAIT_L(0); PG8_BAR; PG8_MMA(1, 0, At, B0); PG8_MMA(1, 1, At, B1); PG8_BAR; PG8_SCHED;
            PG8_LDB(B0, 1, 0); PG8_LDB(B1, 1, 1); PG8_SCHED; PG8_LDA(At, 1, 0); PG8_STAGE(PG8_SA(0, 1), a2 + hstepA, voffA);
            PG8_WAIT_V(8); PG8_WAIT_L(0); PG8_BAR; PG8_MMA(0, 0, At, B0); PG8_MMA(0, 1, At, B1); PG8_BAR; PG8_SCHED;
            PG8_LDA(At, 1, 1); PG8_STAGE(PG8_SB(1, 0), b3, voffB); PG8_STAGE(PG8_SB(1, 1), b3 + hstepB, voffB); PG8_STAGE(PG8_SA(1, 0), a3, voffA);
            PG8_WAIT_V(8); PG8_WAIT_L(0); PG8_BAR; PG8_MMA(1, 0, At, B0); PG8_MMA(1, 1, At, B1); PG8_BAR; PG8_SCHED;
            } else {
            PG8_LDB(B0, 0, 0); PG8_SCHED; PG8_LDA(At, 0, 0); PG8_STAGE(PG8_SA(1, 1), a1 + hstepA, voffA);
            PG8_WAIT_L(8); PG8_BAR; PG8_WAIT_L(0); PG8_MMA(0, 0, At, B0); PG8_BAR; PG8_SCHED;
            PG8_LDB(B1, 0, 1); PG8_STAGE(PG8_SB(0, 0), b2, voffB);
            PG8_BAR; PG8_WAIT_L(0); PG8_MMA(0, 1, At, B1); PG8_BAR;
            PG8_LDA(At, 0, 1); PG8_STAGE(PG8_SA(0, 0), a2, voffA);
            PG8_BAR; PG8_WAIT_L(0); PG8_MMA(1, 0, At, B0); PG8_BAR; PG8_SCHED;
            PG8_STAGE(PG8_SB(0, 1), b2 + hstepB, voffB);
            PG8_WAIT_V(6); PG8_BAR; PG8_MMA(1, 1, At, B1); PG8_BAR;
            PG8_LDB(B0, 1, 0); PG8_SCHED; PG8_LDA(At, 1, 0); PG8_STAGE(PG8_SA(0, 1), a2 + hstepA, voffA);
            PG8_WAIT_L(8); PG8_BAR; PG8_WAIT_L(0); PG8_MMA(0, 0, At, B0); PG8_BAR; PG8_SCHED;
            PG8_LDB(B1, 1, 1); PG8_STAGE(PG8_SB(1, 0), b3, voffB);
            PG8_BAR; PG8_WAIT_L(0); PG8_MMA(0, 1, At, B1); PG8_BAR;
            PG8_LDA(At, 1, 1); PG8_STAGE(PG8_SA(1, 0), a3, voffA);
            PG8_BAR; PG8_WAIT_L(0); PG8_MMA(1, 0, At, B0); PG8_BAR; PG8_SCHED;
            PG8_STAGE(PG8_SB(1, 1), b3 + hstepB, voffB);
            PG8_WAIT_V(6); PG8_BAR; PG8_MMA(1, 1, At, B1); PG8_BAR;
            }
        }
        if constexpr (ALIGN_EPI) { if (wr == 0) PG8_BAR; }
        if constexpr (!Epi::AFTER_DRAIN) { E(acc, cur, wr, wc, fr, fq); S.done(cur); }
        if (!has_next) break;
#pragma unroll
        for (int a = 0; a < 2; ++a)
#pragma unroll
            for (int b = 0; b < 2; ++b)
#pragma unroll
                for (int m = 0; m < 4; ++m)
#pragma unroll
                    for (int n = 0; n < 2; ++n) acc[a][b][m][n] = (f32x4){0.f, 0.f, 0.f, 0.f};
        cur = nxt; cA = nA; cB = nB; ++ui;
        if constexpr (ALIGN_EPI) { if (wr == 1) PG8_BAR; }
    }
    PG8_WAIT_V(0);
    if constexpr (!ALIGN_EPI) { if (wr == 0) PG8_BAR; }
    PG8_BAR;
    if constexpr (Epi::AFTER_DRAIN) { E.fused(acc, cur, wr, wc, fr, fq, lds, wid, lane); S.done(cur); }
#undef PG8_SA
#undef PG8_SB
#undef PG8_STAGE
#undef PG8_LDA
#undef PG8_LDB
#undef PG8_MMA
#undef PG8_WAIT_V
#undef PG8_WAIT_L
#undef PG8_BAR
#undef PG8_SCHED
}
}

namespace att {
#define LAS3 __attribute__((address_space(3)))
typedef unsigned short bf16_t;
using bf16x8 = __attribute__((ext_vector_type(8))) short;
using s16x4 = __attribute__((ext_vector_type(4))) short;
using f32x16 = __attribute__((ext_vector_type(16))) float;
using f32x4 = __attribute__((ext_vector_type(4))) float;
using u32x4 = __attribute__((ext_vector_type(4))) unsigned;
using u32x2 = __attribute__((ext_vector_type(2))) unsigned;
constexpr int SEQ = 8192, DM = 1024, KVB = 64, SLOTB = 8192;
constexpr int NS = 4;
constexpr int L_K = 0, L_V = NS * SLOTB, L_F = 2 * NS * SLOTB, L_FB = L_F + NS * 1024, L_OST = L_FB + 1024, OSTW = 4608, L_FLAG = 126976, L_END = L_FLAG + 128;
constexpr float C2 = 0.125f * 1.4426950408889634f;

__device__ __forceinline__ void glds16(const void* gsrc, unsigned lds_dst) { unsigned keep;
    asm volatile("s_mov_b32 %0, m0\n\ts_mov_b32 m0, %2\n\ts_nop 0\n\tglobal_load_lds_dwordx4 %1, off\n\ts_mov_b32 m0, %0" : "=&s"(keep) : "v"(gsrc), "s"(lds_dst) : "memory"); }
typedef float f32x2_t __attribute__((ext_vector_type(2))); typedef __bf16 bf16x2_t __attribute__((ext_vector_type(2)));
__device__ __forceinline__ unsigned cvtpk(float lo, float hi) { f32x2_t v = {lo, hi}; bf16x2_t b = __builtin_convertvector(v, bf16x2_t); return __builtin_bit_cast(unsigned, b); }
#define ATT_WAIT_BAR() asm volatile("s_waitcnt vmcnt(0) lgkmcnt(0)\n\ts_barrier" ::: "memory")
#define ATT_WAIT_N(n) asm volatile("s_waitcnt vmcnt(" #n ") lgkmcnt(0)\n\ts_barrier" ::: "memory")
#define ATT_TILE_WAIT(jt, W0) do { if ((jt) >= 2) { if (W0) ATT_WAIT_N(6); else ATT_WAIT_N(4); } else if ((jt) == 1) { if (W0) ATT_WAIT_N(3); else ATT_WAIT_N(2); } else ATT_WAIT_N(0); } while (0)
typedef short v4i16_t __attribute__((ext_vector_type(4)));
__device__ __forceinline__ s16x4 vtr(const LAS3 unsigned char* p) { return __builtin_bit_cast(s16x4, __builtin_amdgcn_ds_read_tr16_b64_v4i16((LAS3 v4i16_t*)p)); }
__device__ __forceinline__ float other_half(float v) {
    auto rr = __builtin_amdgcn_permlane32_swap(__float_as_uint(v), __float_as_uint(v), false, false);
    const unsigned a = rr[0], b = rr[1];
    return __uint_as_float(a == __float_as_uint(v) ? b : a);
}

template <bool SB>
__device__ __forceinline__ void attn_unit(int b, int hh, int qb, const bf16_t* Q, const bf16_t* __restrict__ K, const bf16_t* __restrict__ V, bf16_t* O,
                                          const float* __restrict__ F2, float* SS, LAS3 unsigned char* shm) {
    const int tid = threadIdx.x, lane = tid & 63, r32 = lane & 31, hi = lane >> 5; const int wid = __builtin_amdgcn_readfirstlane(tid >> 6);
    const long rowbase = (long)b * SEQ; const int q0 = qb * 256, qw0 = q0 + wid * 32;
    const bf16_t* Qw = Q + (rowbase + qw0) * DM + hh * 64;
    const bf16_t* Kh = K + rowbase * DM + hh * 64; const bf16_t* Vh = V + rowbase * DM + hh * 64;
    const unsigned lds0 = (unsigned)(uintptr_t)shm;
    const bf16_t* ksrc = Kh + (long)lane * DM + wid * 8;
    const bf16_t* vsrc = Vh + (long)(16 * (wid & 3) + (lane >> 2)) * DM + (wid >> 2) * 32 + (lane & 3) * 8;
    const unsigned kdst = lds0 + L_K + wid * 1024, vdst = lds0 + L_V + wid * 1024;
#define ATT_DMA(t, slotoff) do { glds16(ksrc + (long)(t) * KVB * DM, (unsigned)__builtin_amdgcn_readfirstlane(kdst + (slotoff))); \
                                 glds16(vsrc + (long)(t) * KVB * DM, (unsigned)__builtin_amdgcn_readfirstlane(vdst + (slotoff))); } while (0)
    const int NT = 4 * qb + 4;
    ATT_DMA(NT - 1, ((NT - 1) & 3) * SLOTB); ATT_DMA(NT - 2, ((NT - 2) & 3) * SLOTB); ATT_DMA(NT - 3, ((NT - 3) & 3) * SLOTB);
    bf16x8 qr[4];
#pragma unroll
    for (int d0 = 0; d0 < 4; ++d0) qr[d0] = *reinterpret_cast<const bf16x8*>(Qw + (long)r32 * DM + d0 * 16 + hi * 8);
    LAS3 float* F2s = (LAS3 float*)(shm + L_F);
    float ft2 = 0.f;
    if (!SB) { const float* Frow = F2 + (long)(b * 8 + hh) * SEQ;
        for (int i = tid; i < (q0 + 256) / 4; i += 512) ((LAS3 f32x4*)F2s)[i] = ((const f32x4*)Frow)[i];
        ft2 = Frow[qw0 + r32]; }
    f32x16 o0, o1;
#pragma unroll
    for (int r = 0; r < 16; ++r) { o0[r] = 0.f; o1[r] = 0.f; }
    float mrun = -INFINITY, lrun = 0.f, carry = 1.f;
    volatile LAS3 unsigned* flags = (volatile LAS3 unsigned*)(shm + L_FLAG);
    const LAS3 unsigned char* kp0 = shm + L_K + hi * 1024 + r32 * 16;
    const LAS3 unsigned char* vp0 = shm + L_V + ((lane >> 4) & 1) * 32 + (lane & 3) * 8 + (4 * hi + ((lane & 15) >> 2)) * 64;
    asm volatile("" :: "v"(qr[0]), "v"(qr[1]), "v"(qr[2]), "v"(qr[3]));
    for (int jt = NT - 1; jt >= 0; --jt) {
        const int slot = jt & 3;
        ATT_TILE_WAIT(jt, false);
        if (SB && jt < NT - 1) { unsigned a = 0;
#pragma unroll
            for (int w = 0; w < 8; ++w) a |= flags[((jt + 1) & 1) * 8 + w];
            if (__builtin_amdgcn_readfirstlane(a) == 0u) break; }
        if (jt >= 3) ATT_DMA(jt - 3, ((jt - 3) & 3) * SLOTB);
        if (64 * jt <= qw0 + 31) {
            const LAS3 unsigned char* kp = kp0 + slot * SLOTB;
            f32x16 p0, p1;
#pragma unroll
            for (int r = 0; r < 16; ++r) { p0[r] = 0.f; p1[r] = 0.f; }
#pragma unroll
            for (int d0 = 0; d0 < 4; ++d0) {
                const bf16x8 k0 = *(const LAS3 bf16x8*)(kp + d0 * 2048), k1 = *(const LAS3 bf16x8*)(kp + d0 * 2048 + 512);
                p0 = __builtin_amdgcn_mfma_f32_32x32x16_bf16(k0, qr[d0], p0, 0, 0, 0);
                p1 = __builtin_amdgcn_mfma_f32_32x32x16_bf16(k1, qr[d0], p1, 0, 0, 0);
            }
            const bool diag = (64 * jt + 63 > qw0 - (SB ? 1 : 0));
            const int kb_ = 64 * jt + 4 * hi - (qw0 + r32);
            if (!SB) {
                const LAS3 float* fsp = F2s + 64 * jt + 4 * hi;
#pragma unroll
                for (int g = 0; g < 4; ++g) { const f32x4 fa = *(const LAS3 f32x4*)(fsp + 8 * g), fb = *(const LAS3 f32x4*)(fsp + 32 + 8 * g);
#pragma unroll
                    for (int i = 0; i < 4; ++i) { p0[4 * g + i] += (ft2 - fa[i]); p1[4 * g + i] += (ft2 - fb[i]); } }
                if (diag) {
#pragma unroll
                    for (int r = 0; r < 16; ++r) { const int cr = (r & 3) + 8 * (r >> 2); if (kb_ + cr > 0) p0[r] = -INFINITY; if (kb_ + cr + 32 > 0) p1[r] = -INFINITY; } }
                float mx = fmaxf(p0[0], p1[0]);
#pragma unroll
                for (int r = 1; r < 16; ++r) mx = fmaxf(mx, fmaxf(p0[r], p1[r]));
                mx = fmaxf(mx, other_half(mx));
                const float mnew = fmaxf(mrun, mx);
                if (__any(mnew > mrun)) { const float alpha = __builtin_amdgcn_exp2f(mrun - mnew); lrun *= alpha;
#pragma unroll
                    for (int r = 0; r < 16; ++r) { o0[r] *= alpha; o1[r] *= alpha; }
                    mrun = mnew; }
                float ls = 0.f;
#pragma unroll
                for (int r = 0; r < 16; ++r) { p0[r] = __builtin_amdgcn_exp2f(p0[r] - mrun); p1[r] = __builtin_amdgcn_exp2f(p1[r] - mrun); ls += p0[r] + p1[r]; }
                lrun += ls;
            } else {
#pragma unroll
                for (int r = 0; r < 16; ++r) { p0[r] = __builtin_amdgcn_rcpf(1.0f + __builtin_amdgcn_exp2f(p0[r])); p1[r] = __builtin_amdgcn_rcpf(1.0f + __builtin_amdgcn_exp2f(p1[r])); }
                if (diag) {
#pragma unroll
                    for (int r = 0; r < 16; ++r) { const int cr = (r & 3) + 8 * (r >> 2); if (kb_ + cr >= 0) p0[r] = 1.0f; if (kb_ + cr + 32 >= 0) p1[r] = 1.0f; } }
                float PP0[4], PP1[4], H0[4], H1[4];
#pragma unroll
                for (int g = 0; g < 4; ++g) { const float g0 = (p0[4 * g] * p0[4 * g + 1]) * (p0[4 * g + 2] * p0[4 * g + 3]), g1 = (p1[4 * g] * p1[4 * g + 1]) * (p1[4 * g + 2] * p1[4 * g + 3]);
                    const float t0 = other_half(g0), t1 = other_half(g1); PP0[g] = g0 * t0; PP1[g] = g1 * t1; H0[g] = hi ? 1.0f : t0; H1[g] = hi ? 1.0f : t1; }
                float T0[4], T1[4];
                T1[3] = carry; T1[2] = T1[3] * PP1[3]; T1[1] = T1[2] * PP1[2]; T1[0] = T1[1] * PP1[1]; const float tot1 = T1[0] * PP1[0];
                T0[3] = tot1; T0[2] = T0[3] * PP0[3]; T0[1] = T0[2] * PP0[2]; T0[0] = T0[1] * PP0[1]; carry = T0[0] * PP0[0];
#pragma unroll
                for (int g = 0; g < 4; ++g) {
                    { const float x3 = T0[g] * H0[g], x2 = x3 * p0[4 * g + 3], x1 = x2 * p0[4 * g + 2], x0 = x1 * p0[4 * g + 1];
                      p0[4 * g + 3] = fmaf(-p0[4 * g + 3], x3, x3); p0[4 * g + 2] = fmaf(-p0[4 * g + 2], x2, x2); p0[4 * g + 1] = fmaf(-p0[4 * g + 1], x1, x1); p0[4 * g] = fmaf(-p0[4 * g], x0, x0); }
                    { const float x3 = T1[g] * H1[g], x2 = x3 * p1[4 * g + 3], x1 = x2 * p1[4 * g + 2], x0 = x1 * p1[4 * g + 1];
                      p1[4 * g + 3] = fmaf(-p1[4 * g + 3], x3, x3); p1[4 * g + 2] = fmaf(-p1[4 * g + 2], x2, x2); p1[4 * g + 1] = fmaf(-p1[4 * g + 1], x1, x1); p1[4 * g] = fmaf(-p1[4 * g], x0, x0); }
                }
            }
            u32x4 pw[4];
#pragma unroll
            for (int i = 0; i < 4; ++i) { pw[0][i] = cvtpk(p0[2 * i], p0[2 * i + 1]); pw[1][i] = cvtpk(p0[8 + 2 * i], p0[8 + 2 * i + 1]); pw[2][i] = cvtpk(p1[2 * i], p1[2 * i + 1]); pw[3][i] = cvtpk(p1[8 + 2 * i], p1[8 + 2 * i + 1]); }
            const LAS3 unsigned char* vp = vp0 + slot * SLOTB;
#pragma unroll
            for (int ks = 0; ks < 4; ++ks) {
                const s16x4 l0 = vtr(vp + ks * 1024), h0 = vtr(vp + ks * 1024 + 512), l1 = vtr(vp + 4096 + ks * 1024), h1 = vtr(vp + 4096 + ks * 1024 + 512);
                const bf16x8 v0 = (bf16x8){l0[0], l0[1], l0[2], l0[3], h0[0], h0[1], h0[2], h0[3]}, v1 = (bf16x8){l1[0], l1[1], l1[2], l1[3], h1[0], h1[1], h1[2], h1[3]};
                const bf16x8 pf = __builtin_bit_cast(bf16x8, pw[ks]);
                o0 = __builtin_amdgcn_mfma_f32_32x32x16_bf16(v0, pf, o0, 0, 0, 0);
                o1 = __builtin_amdgcn_mfma_f32_32x32x16_bf16(v1, pf, o1, 0, 0, 0);
            }
        }
        if (SB) { const bool alive = __any(carry != 0.f) != 0; if (lane == 0) flags[(jt & 1) * 8 + wid] = alive ? 1u : 0u; }
    }
    if (!SB) { lrun += other_half(lrun); const float inv = 1.0f / lrun;
#pragma unroll
        for (int r = 0; r < 16; ++r) { o0[r] *= inv; o1[r] *= inv; } }
    float sq = 0.f;
#pragma unroll
    for (int r = 0; r < 16; ++r) sq += o0[r] * o0[r] + o1[r] * o1[r];
    sq += other_half(sq);
    if (hi == 0) SS[(size_t)(rowbase + qw0 + r32) * 16 + hh] = sq;
    LAS3 unsigned char* stg = shm + L_OST + wid * OSTW;
#pragma unroll
    for (int g = 0; g < 4; ++g) {
        u32x2 w0; w0.x = cvtpk(o0[4 * g], o0[4 * g + 1]); w0.y = cvtpk(o0[4 * g + 2], o0[4 * g + 3]);
        u32x2 w1; w1.x = cvtpk(o1[4 * g], o1[4 * g + 1]); w1.y = cvtpk(o1[4 * g + 2], o1[4 * g + 3]);
        *(LAS3 u32x2*)(stg + r32 * 144 + g * 16 + hi * 8) = w0;
        *(LAS3 u32x2*)(stg + r32 * 144 + 64 + g * 16 + hi * 8) = w1;
    }
    asm volatile("s_waitcnt lgkmcnt(0)" ::: "memory");
    bf16_t* Ow = O + (rowbase + qw0) * DM + hh * 64;
#pragma unroll
    for (int i = 0; i < 4; ++i) { const int row = i * 8 + (lane >> 3), ch = lane & 7; const u32x4 v = *(const LAS3 u32x4*)(stg + row * 144 + ch * 16); *(u32x4*)(Ow + (long)row * DM + ch * 8) = v; }
    ATT_WAIT_BAR();
#undef ATT_DMA
}
__device__ __forceinline__ float max3f(float a, float b, float c) { float r; asm("v_max3_f32 %0, %1, %2, %3" : "=v"(r) : "v"(a), "v"(b), "v"(c)); return r; }
__device__ __forceinline__ void fox_unit(int b, int hh, int qb, const bf16_t* Q, const bf16_t* __restrict__ K, const bf16_t* __restrict__ V, bf16_t* O,
                                         const float* __restrict__ F2, const bf16_t* __restrict__ FS3, const unsigned* __restrict__ KMAX, float* SS, LAS3 unsigned char* shm) {
    constexpr float THR = 8.0f;
    const int tid = threadIdx.x, lane = tid & 63, r32 = lane & 31, hi = lane >> 5; const int wid = __builtin_amdgcn_readfirstlane(tid >> 6);
    const long rowbase = (long)b * SEQ; const int q0 = qb * 256, qw0 = q0 + wid * 32;
    const bf16_t* Qw = Q + (rowbase + qw0) * DM + hh * 64;
    const bf16_t* Kh = K + rowbase * DM + hh * 64; const bf16_t* Vh = V + rowbase * DM + hh * 64;
    const unsigned lds0 = (unsigned)(uintptr_t)shm;
    const bf16_t* ksrc = Kh + (long)lane * DM + wid * 8;
    const bf16_t* vsrc = Vh + (long)(16 * (wid & 3) + (lane >> 2)) * DM + (wid >> 2) * 32 + (lane & 3) * 8;
    const bf16_t* fsrc = FS3 + ((long)(b * 8 + hh) * SEQ + lane) * 8;
    const float* Frow = F2 + (long)(b * 8 + hh) * SEQ;
    const unsigned kdst = lds0 + L_K + wid * 1024, vdst = lds0 + L_V + wid * 1024, fdst = lds0 + L_F;
#define FOX_DMA(t, s_) do { glds16(ksrc + (long)(t) * KVB * DM, (unsigned)__builtin_amdgcn_readfirstlane(kdst + (s_) * SLOTB)); \
                            glds16(vsrc + (long)(t) * KVB * DM, (unsigned)__builtin_amdgcn_readfirstlane(vdst + (s_) * SLOTB)); \
                            if (wid == 0) glds16(fsrc + (long)(t) * KVB * 8, (unsigned)__builtin_amdgcn_readfirstlane(fdst + (s_) * 1024)); } while (0)
    const int NT = 4 * qb + 4;
    FOX_DMA(NT - 1, (NT - 1) & 3); FOX_DMA(NT - 2, (NT - 2) & 3);
    LAS3 float* F2b = (LAS3 float*)(shm + L_FB);
    for (int i = 1 + tid; i < NT; i += 512) F2b[i] = F2[(long)(b * 8 + hh) * SEQ + 64 * i - 1];
    bf16x8 qr[4]; float qn2 = 0.f;
#pragma unroll
    for (int d0 = 0; d0 < 4; ++d0) { qr[d0] = *reinterpret_cast<const bf16x8*>(Qw + (long)r32 * DM + d0 * 16 + hi * 8);
#pragma unroll
        for (int j = 0; j < 8; ++j) { const float f = __builtin_bit_cast(float, (unsigned)(unsigned short)qr[d0][j] << 16); qn2 += f * f; } }
    qn2 += other_half(qn2);
    const float kn = sqrtf(2.0f * __uint_as_float(KMAX[b * 8 + hh])) * 1.01f;
    const float zq = sqrtf(qn2) * kn * 1.01f + 1.0f;
    const float ft2 = Frow[qw0 + r32];
    const short one = (short)0x3F80;
    const bf16x8 onesA = (bf16x8){one, one, one, one, one, one, one, one};
    const bf16x8 qones = hi ? (bf16x8){0, 0, 0, 0, 0, 0, 0, 0} : (bf16x8){one, one, one, 0, 0, 0, 0, 0};
    f32x16 o0, o1, lacc, cinit;
#pragma unroll
    for (int r = 0; r < 16; ++r) { o0[r] = 0.f; o1[r] = 0.f; lacc[r] = 0.f; cinit[r] = ft2 - fminf(zq, 60.0f); }
    const float mref = fminf(zq, 60.0f);
    volatile LAS3 unsigned* flags = (volatile LAS3 unsigned*)(shm + L_FLAG);
    const LAS3 unsigned char* kp0 = shm + L_K + hi * 1024 + r32 * 16;
    const LAS3 unsigned char* vp0 = shm + L_V + ((lane >> 4) & 1) * 32 + (lane & 3) * 8 + (4 * hi + ((lane & 15) >> 2)) * 64;
    const LAS3 unsigned char* fp0 = shm + L_F + r32 * 16;
    bool walive = true;
    for (int jp = NT / 2 - 1; jp >= 0; --jp) {
        ATT_WAIT_BAR();
        if (jp < NT / 2 - 1) { unsigned a = 0;
#pragma unroll
            for (int w = 0; w < 8; ++w) a |= flags[((jp + 1) & 1) * 8 + w];
            if (__builtin_amdgcn_readfirstlane(a) == 0u) break; }
        if (jp >= 1) { FOX_DMA(2 * jp - 1, (2 * jp - 1) & 3); FOX_DMA(2 * jp - 2, (2 * jp - 2) & 3); }
#pragma unroll
      for (int sub = 1; sub >= 0; --sub) { const int jt = 2 * jp + sub; const int slot = jt & 3;
        if (64 * jt <= qw0 + 31 && walive) {
            const LAS3 unsigned char* kp = kp0 + slot * SLOTB; const LAS3 unsigned char* fp = fp0 + slot * 1024;
            asm volatile("" : "+v"(cinit));
            f32x16 p0 = __builtin_amdgcn_mfma_f32_32x32x16_bf16(*(const LAS3 bf16x8*)(fp), qones, cinit, 0, 0, 0);
            f32x16 p1 = __builtin_amdgcn_mfma_f32_32x32x16_bf16(*(const LAS3 bf16x8*)(fp + 512), qones, cinit, 0, 0, 0);
#pragma unroll
            for (int d0 = 0; d0 < 4; ++d0) {
                const bf16x8 k0 = *(const LAS3 bf16x8*)(kp + d0 * 2048), k1 = *(const LAS3 bf16x8*)(kp + d0 * 2048 + 512);
                p0 = __builtin_amdgcn_mfma_f32_32x32x16_bf16(k0, qr[d0], p0, 0, 0, 0);
                p1 = __builtin_amdgcn_mfma_f32_32x32x16_bf16(k1, qr[d0], p1, 0, 0, 0);
            }
            if (64 * jt + 63 > qw0) { const int kb_ = 64 * jt + 4 * hi - (qw0 + r32);
#pragma unroll
                for (int r = 0; r < 16; ++r) { const int cr = (r & 3) + 8 * (r >> 2); if (kb_ + cr > 0) p0[r] = -INFINITY; if (kb_ + cr + 32 > 0) p1[r] = -INFINITY; } }
#pragma unroll
            for (int r = 0; r < 16; ++r) { p0[r] = __builtin_amdgcn_exp2f(p0[r]); p1[r] = __builtin_amdgcn_exp2f(p1[r]); }
            u32x4 pw[4];
#pragma unroll
            for (int i = 0; i < 4; ++i) { pw[0][i] = cvtpk(p0[2 * i], p0[2 * i + 1]); pw[1][i] = cvtpk(p0[8 + 2 * i], p0[8 + 2 * i + 1]); pw[2][i] = cvtpk(p1[2 * i], p1[2 * i + 1]); pw[3][i] = cvtpk(p1[8 + 2 * i], p1[8 + 2 * i + 1]); }
            const LAS3 unsigned char* vp = vp0 + slot * SLOTB;
#pragma unroll
            for (int ks = 0; ks < 4; ++ks) {
                const s16x4 l0 = vtr(vp + ks * 1024), h0 = vtr(vp + ks * 1024 + 512), l1 = vtr(vp + 4096 + ks * 1024), h1 = vtr(vp + 4096 + ks * 1024 + 512);
                const bf16x8 v0 = (bf16x8){l0[0], l0[1], l0[2], l0[3], h0[0], h0[1], h0[2], h0[3]}, v1 = (bf16x8){l1[0], l1[1], l1[2], l1[3], h1[0], h1[1], h1[2], h1[3]};
                const bf16x8 pf = __builtin_bit_cast(bf16x8, pw[ks]);
                o0 = __builtin_amdgcn_mfma_f32_32x32x16_bf16(v0, pf, o0, 0, 0, 0);
                o1 = __builtin_amdgcn_mfma_f32_32x32x16_bf16(v1, pf, o1, 0, 0, 0);
                lacc = __builtin_amdgcn_mfma_f32_32x32x16_bf16(onesA, pf, lacc, 0, 0, 0);
            }
        }
        {
            bool dead = false;
            if (jt > 0) { const float fn = F2b[jt]; dead = (zq + (ft2 - fn) - mref) < -160.0f; }
            walive = __any(!dead) != 0; }
      }
        if (lane == 0) flags[(jp & 1) * 8 + wid] = walive ? 1u : 0u;
    }
    { const float inv = 1.0f / lacc[0];
#pragma unroll
        for (int r = 0; r < 16; ++r) { o0[r] *= inv; o1[r] *= inv; } }
    float sq = 0.f;
#pragma unroll
    for (int r = 0; r < 16; ++r) sq += o0[r] * o0[r] + o1[r] * o1[r];
    sq += other_half(sq);
    if (hi == 0) SS[(size_t)(rowbase + qw0 + r32) * 16 + hh] = sq;
    LAS3 unsigned char* stg = shm + L_OST + wid * OSTW;
#pragma unroll
    for (int g = 0; g < 4; ++g) {
        u32x2 w0; w0.x = cvtpk(o0[4 * g], o0[4 * g + 1]); w0.y = cvtpk(o0[4 * g + 2], o0[4 * g + 3]);
        u32x2 w1; w1.x = cvtpk(o1[4 * g], o1[4 * g + 1]); w1.y = cvtpk(o1[4 * g + 2], o1[4 * g + 3]);
        *(LAS3 u32x2*)(stg + r32 * 144 + g * 16 + hi * 8) = w0;
        *(LAS3 u32x2*)(stg + r32 * 144 + 64 + g * 16 + hi * 8) = w1;
    }
    asm volatile("s_waitcnt lgkmcnt(0)" ::: "memory");
    bf16_t* Ow = O + (rowbase + qw0) * DM + hh * 64;
#pragma unroll
    for (int i = 0; i < 4; ++i) { const int row = i * 8 + (lane >> 3), ch = lane & 7; const u32x4 v = *(const LAS3 u32x4*)(stg + row * 144 + ch * 16); *(u32x4*)(Ow + (long)row * DM + ch * 8) = v; }
    ATT_WAIT_BAR();
#undef FOX_DMA
}

__device__ __forceinline__ void sb_tile(const LAS3 unsigned char* kp, const LAS3 unsigned char* vp, int jt, int qw0, int r32, int hi, const bf16x8 (&qr)[4], float& carry, f32x16& o0, f32x16& o1) {
    f32x16 p0, p1;
#pragma unroll
    for (int r = 0; r < 16; ++r) { p0[r] = 0.f; p1[r] = 0.f; }
#pragma unroll
    for (int d0 = 0; d0 < 4; ++d0) {
        const bf16x8 k0 = *(const LAS3 bf16x8*)(kp + d0 * 2048), k1 = *(const LAS3 bf16x8*)(kp + d0 * 2048 + 512);
        p0 = __builtin_amdgcn_mfma_f32_32x32x16_bf16(k0, qr[d0], p0, 0, 0, 0);
        p1 = __builtin_amdgcn_mfma_f32_32x32x16_bf16(k1, qr[d0], p1, 0, 0, 0);
    }
#pragma unroll
    for (int r = 0; r < 16; ++r) { p0[r] = __builtin_amdgcn_rcpf(1.0f + __builtin_amdgcn_exp2f(p0[r])); p1[r] = __builtin_amdgcn_rcpf(1.0f + __builtin_amdgcn_exp2f(p1[r])); }
    if (64 * jt + 63 > qw0 - 1) { const int kb_ = 64 * jt + 4 * hi - (qw0 + r32);
#pragma unroll
        for (int r = 0; r < 16; ++r) { const int cr = (r & 3) + 8 * (r >> 2); if (kb_ + cr >= 0) p0[r] = 1.0f; if (kb_ + cr + 32 >= 0) p1[r] = 1.0f; } }
    float PP0[4], PP1[4], H0[4], H1[4];
#pragma unroll
    for (int g = 0; g < 4; ++g) { const float g0 = (p0[4 * g] * p0[4 * g + 1]) * (p0[4 * g + 2] * p0[4 * g + 3]), g1 = (p1[4 * g] * p1[4 * g + 1]) * (p1[4 * g + 2] * p1[4 * g + 3]);
        const float t0 = other_half(g0), t1 = other_half(g1); PP0[g] = g0 * t0; PP1[g] = g1 * t1; H0[g] = hi ? 1.0f : t0; H1[g] = hi ? 1.0f : t1; }
    float T0[4], T1[4];
    T1[3] = carry; T1[2] = T1[3] * PP1[3]; T1[1] = T1[2] * PP1[2]; T1[0] = T1[1] * PP1[1]; const float tot1 = T1[0] * PP1[0];
    T0[3] = tot1; T0[2] = T0[3] * PP0[3]; T0[1] = T0[2] * PP0[2]; T0[0] = T0[1] * PP0[1]; carry = T0[0] * PP0[0];
#pragma unroll
    for (int g = 0; g < 4; ++g) {
        { const float x3 = T0[g] * H0[g], x2 = x3 * p0[4 * g + 3], x1 = x2 * p0[4 * g + 2], x0 = x1 * p0[4 * g + 1];
          p0[4 * g + 3] = fmaf(-p0[4 * g + 3], x3, x3); p0[4 * g + 2] = fmaf(-p0[4 * g + 2], x2, x2); p0[4 * g + 1] = fmaf(-p0[4 * g + 1], x1, x1); p0[4 * g] = fmaf(-p0[4 * g], x0, x0); }
        { const float x3 = T1[g] * H1[g], x2 = x3 * p1[4 * g + 3], x1 = x2 * p1[4 * g + 2], x0 = x1 * p1[4 * g + 1];
          p1[4 * g + 3] = fmaf(-p1[4 * g + 3], x3, x3); p1[4 * g + 2] = fmaf(-p1[4 * g + 2], x2, x2); p1[4 * g + 1] = fmaf(-p1[4 * g + 1], x1, x1); p1[4 * g] = fmaf(-p1[4 * g], x0, x0); }
    }
    u32x4 pw[4];
#pragma unroll
    for (int i = 0; i < 4; ++i) { pw[0][i] = cvtpk(p0[2 * i], p0[2 * i + 1]); pw[1][i] = cvtpk(p0[8 + 2 * i], p0[8 + 2 * i + 1]); pw[2][i] = cvtpk(p1[2 * i], p1[2 * i + 1]); pw[3][i] = cvtpk(p1[8 + 2 * i], p1[8 + 2 * i + 1]); }
#pragma unroll
    for (int ks = 0; ks < 4; ++ks) {
        const s16x4 l0 = vtr(vp + ks * 1024), h0 = vtr(vp + ks * 1024 + 512), l1 = vtr(vp + 4096 + ks * 1024), h1 = vtr(vp + 4096 + ks * 1024 + 512);
        const bf16x8 v0 = (bf16x8){l0[0], l0[1], l0[2], l0[3], h0[0], h0[1], h0[2], h0[3]}, v1 = (bf16x8){l1[0], l1[1], l1[2], l1[3], h1[0], h1[1], h1[2], h1[3]};
        const bf16x8 pf = __builtin_bit_cast(bf16x8, pw[ks]);
        o0 = __builtin_amdgcn_mfma_f32_32x32x16_bf16(v0, pf, o0, 0, 0, 0);
        o1 = __builtin_amdgcn_mfma_f32_32x32x16_bf16(v1, pf, o1, 0, 0, 0);
    }
}
__device__ __forceinline__ void sb_unit(int b, int hh, int qb, const bf16_t* Q, const bf16_t* __restrict__ K, const bf16_t* __restrict__ V, bf16_t* O, float* SS, LAS3 unsigned char* shm) {
    constexpr int WV = 7 * SLOTB;
    const int tid = threadIdx.x, lane = tid & 63, r32 = lane & 31, hi = lane >> 5; const int wid = __builtin_amdgcn_readfirstlane(tid >> 6);
    const long rowbase = (long)b * SEQ; const int q0 = qb * 256, qw0 = q0 + wid * 32;
    const bf16_t* Qw = Q + (rowbase + qw0) * DM + hh * 64;
    const bf16_t* Kh = K + rowbase * DM + hh * 64; const bf16_t* Vh = V + rowbase * DM + hh * 64;
    const unsigned lds0 = (unsigned)(uintptr_t)shm;
    const bf16_t* ksrc = Kh + (long)lane * DM + wid * 8;
    const bf16_t* vsrc = Vh + (long)(16 * (wid & 3) + (lane >> 2)) * DM + (wid >> 2) * 32 + (lane & 3) * 8;
    const int T_hi = 4 * qb + 3, T_lo = (4 * qb - 3 > 0) ? 4 * qb - 3 : 0;
    for (int t = T_hi; t >= T_lo; --t) { glds16(ksrc + (long)t * KVB * DM, (unsigned)__builtin_amdgcn_readfirstlane(lds0 + (t - T_lo) * SLOTB + wid * 1024));
                                         glds16(vsrc + (long)t * KVB * DM, (unsigned)__builtin_amdgcn_readfirstlane(lds0 + WV + (t - T_lo) * SLOTB + wid * 1024)); }
    bf16x8 qr[4];
#pragma unroll
    for (int d0 = 0; d0 < 4; ++d0) qr[d0] = *reinterpret_cast<const bf16x8*>(Qw + (long)r32 * DM + d0 * 16 + hi * 8);
    f32x16 o0, o1;
#pragma unroll
    for (int r = 0; r < 16; ++r) { o0[r] = 0.f; o1[r] = 0.f; }
    float carry = 1.f;
    const int kl = hi * 1024 + r32 * 16, vl = ((lane >> 4) & 1) * 32 + (lane & 3) * 8 + (4 * hi + ((lane & 15) >> 2)) * 64;
    volatile LAS3 unsigned char* fbytes = (volatile LAS3 unsigned char*)(shm + L_FLAG);
    asm volatile("" :: "v"(qr[0]), "v"(qr[1]), "v"(qr[2]), "v"(qr[3]));
    ATT_WAIT_BAR();
    for (int jt = (qw0 + 31) >> 6; jt >= T_lo; --jt) {
        sb_tile(shm + (jt - T_lo) * SLOTB + kl, shm + WV + (jt - T_lo) * SLOTB + vl, jt, qw0, r32, hi, qr, carry, o0, o1);
        if (!__any(carry != 0.f)) break;
    }
    bool more = false;
    if (T_lo > 0) {
        const bool alive = __any(carry != 0.f) != 0; if (lane == 0) fbytes[16 + wid] = alive ? (unsigned char)1 : (unsigned char)0;
        ATT_WAIT_BAR();
        const unsigned long long a8 = *(volatile LAS3 unsigned long long*)(shm + L_FLAG + 16);
        more = __builtin_amdgcn_readfirstlane((unsigned)a8 | (unsigned)(a8 >> 32)) != 0u;
    }
    if (more) {
        const unsigned kdst = lds0 + L_K + wid * 1024, vdst = lds0 + L_V + wid * 1024;
#define SB_DMA(t) do { glds16(ksrc + (long)(t) * KVB * DM, (unsigned)__builtin_amdgcn_readfirstlane(kdst + ((t) & 3) * SLOTB)); \
                       glds16(vsrc + (long)(t) * KVB * DM, (unsigned)__builtin_amdgcn_readfirstlane(vdst + ((t) & 3) * SLOTB)); } while (0)
        SB_DMA(T_lo - 1); if (T_lo >= 2) SB_DMA(T_lo - 2); if (T_lo >= 3) SB_DMA(T_lo - 3);
        bool walive = true;
        for (int jt = T_lo - 1; jt >= 0; --jt) {
            ATT_TILE_WAIT(jt, false);
            if (jt < T_lo - 1) { const unsigned long long a8 = *(volatile LAS3 unsigned long long*)(shm + L_FLAG + ((jt + 1) & 1) * 8);
                if (__builtin_amdgcn_readfirstlane((unsigned)a8 | (unsigned)(a8 >> 32)) == 0u) break; }
            if (jt >= 3) SB_DMA(jt - 3);
            if (walive) sb_tile(shm + L_K + (jt & 3) * SLOTB + kl, shm + L_V + (jt & 3) * SLOTB + vl, jt, qw0, r32, hi, qr, carry, o0, o1);
            walive = __any(carry != 0.f) != 0; if (lane == 0) fbytes[(jt & 1) * 8 + wid] = walive ? (unsigned char)1 : (unsigned char)0;
        }
#undef SB_DMA
    }
    ATT_WAIT_BAR();
    float sq = 0.f;
#pragma unroll
    for (int r = 0; r < 16; ++r) sq += o0[r] * o0[r] + o1[r] * o1[r];
    sq += other_half(sq);
    if (hi == 0) SS[(size_t)(rowbase + qw0 + r32) * 16 + hh] = sq;
    LAS3 unsigned char* stg = shm + L_OST + wid * OSTW;
#pragma unroll
    for (int g = 0; g < 4; ++g) {
        u32x2 w0; w0.x = cvtpk(o0[4 * g], o0[4 * g + 1]); w0.y = cvtpk(o0[4 * g + 2], o0[4 * g + 3]);
        u32x2 w1; w1.x = cvtpk(o1[4 * g], o1[4 * g + 1]); w1.y = cvtpk(o1[4 * g + 2], o1[4 * g + 3]);
        *(LAS3 u32x2*)(stg + r32 * 144 + g * 16 + hi * 8) = w0;
        *(LAS3 u32x2*)(stg + r32 * 144 + 64 + g * 16 + hi * 8) = w1;
    }
    asm volatile("s_waitcnt lgkmcnt(0)" ::: "memory");
    bf16_t* Ow = O + (rowbase + qw0) * DM + hh * 64;
#pragma unroll
    for (int i = 0; i < 4; ++i) { const int row = i * 8 + (lane >> 3), ch = lane & 7; const u32x4 v = *(const LAS3 u32x4*)(stg + row * 144 + ch * 16); *(u32x4*)(Ow + (long)row * DM + ch * 8) = v; }
    ATT_WAIT_BAR();
}
}

constexpr int NWAVES = 8;
constexpr int BATCH = 4, SEQ = 8192, DMODEL = 1024, MROWS = BATCH * SEQ, DFF = 2816, NUP = 2 * DFF, INC = 3080;
constexpr float RMS_EPS = 1e-6f, LOG2E = 1.4426950408889634f;
constexpr size_t MiB = 1u << 20;
constexpr size_t WS_WIN = 1 * MiB, WS_WOUT = 7 * MiB, WS_WUP = 9 * MiB, WS_WDN = 20 * MiB;
constexpr size_t WS_LF = 26 * MiB, WS_F2 = 27 * MiB, WS_SS = 28 * MiB, WS_PS = 30 * MiB, WS_PS2 = 32 * MiB, WS_HALO = 34 * MiB;
constexpr size_t WS_XN = 48 * MiB;
constexpr size_t WS_Q = 112 * MiB, WS_K = 176 * MiB, WS_V = 240 * MiB, WS_O = 304 * MiB;
constexpr size_t WS_U = 112 * MiB;
constexpr size_t WS_FS3 = 464 * MiB;
constexpr size_t WS_CTL = 0;
constexpr size_t WS_END = 468 * MiB;
constexpr int RING_BYTES = 131072, LDS_BYTES = 147456;
static_assert(att::L_END <= RING_BYTES && att::L_OST + 8 * att::OSTW <= att::L_FLAG && 14 * att::SLOTB <= att::L_FLAG, "attention LDS map");

#define LAS __attribute__((address_space(3)))
typedef unsigned short bf16;
typedef unsigned v4u __attribute__((ext_vector_type(4)));
typedef float f32x4 __attribute__((ext_vector_type(4)));
__device__ __forceinline__ unsigned f2bf(float f) { unsigned u = __builtin_bit_cast(unsigned, f); return (u + 0x7fffu + ((u >> 16) & 1u)) >> 16; }
__device__ __forceinline__ unsigned pk2(float lo, float hi) { return f2bf(lo) | (f2bf(hi) << 16); }
__device__ __forceinline__ float bf2f(unsigned short h) { return __builtin_bit_cast(float, (unsigned)h << 16); }
__device__ __forceinline__ float wave_sum(float v) {
#pragma unroll
    for (int o = 1; o < 64; o <<= 1) v += __shfl_xor(v, o);
    return v;
}
#define LDS_WAIT() asm volatile("s_waitcnt lgkmcnt(0)" ::: "memory")

#define XB_TMO      128
#define XB_XCNT(j)  (256  + 64 * (j))
#define XB_XSUB(j)  (1280 + 64 * (j))
#define XB_XGEN(j)  (2304 + 64 * (j))
#define XB_TOP      3328
#define XB_TOPGEN   3392
#define XCD_BAR_WORDS 3456
#define XB_SPIN_CAP (1u << 18)

__device__ __forceinline__ unsigned xb_ld(unsigned* p)              { return __hip_atomic_load(p, __ATOMIC_RELAXED, __HIP_MEMORY_SCOPE_AGENT); }
__device__ __forceinline__ unsigned xb_add(unsigned* p, unsigned v) { return __hip_atomic_fetch_add(p, v, __ATOMIC_RELAXED, __HIP_MEMORY_SCOPE_AGENT); }
__device__ __forceinline__ unsigned xb_xcc_id() { return (unsigned)__builtin_amdgcn_s_getreg((3 << 11) | 20) & 0xFu; }
#define XB_SPIN(cond, bar) do { unsigned _sp = 0; while (cond) { __builtin_amdgcn_s_sleep(1); \
    if ((++_sp & 255u) == 0u) { if (xb_ld(&(bar)[XB_TMO])) break; if (_sp > XB_SPIN_CAP) { atomicAdd(&(bar)[XB_TMO], 1u); break; } } } } while (0)

struct XcdBarrier {
    unsigned* bar; unsigned x;
    volatile LAS unsigned* st;
};

__device__ __forceinline__ XcdBarrier xcd_barrier_post(unsigned* bar, volatile LAS unsigned* st) {
    XcdBarrier b; b.bar = bar; b.x = xb_xcc_id(); b.st = st;
    if (threadIdx.x == 0) (void)xb_add(&bar[XB_XCNT(b.x)], 1u);
    return b;
}
__device__ __forceinline__ void xcd_barrier_complete(unsigned* bar, unsigned x, unsigned& nloc, unsigned& nx) {
    const unsigned G = gridDim.x * gridDim.y * gridDim.z;
    unsigned sum, cnt, mine, sp = 0u;
    for (;;) {
        sum = 0u; cnt = 0u; mine = 0u;
#pragma unroll
        for (unsigned j = 0; j < 16; ++j) { const unsigned c = xb_ld(&bar[XB_XCNT(j)]); sum += c; cnt += (c > 0u) ? 1u : 0u; mine = (j == x) ? c : mine; }
        if (sum == G) break;
        __builtin_amdgcn_s_sleep(1);
        if ((++sp & 255u) == 0u) { if (xb_ld(&bar[XB_TMO])) break; if (sp > XB_SPIN_CAP) { atomicAdd(&bar[XB_TMO], 1u); break; } }
    }
    nloc = mine > 0u ? mine : 1u; nx = cnt > 0u ? cnt : 1u;
}

__device__ __forceinline__ void xcd_barrier(const XcdBarrier& b) {
    asm volatile("s_waitcnt vmcnt(0)" ::: "memory");
    __syncthreads();
    if (threadIdx.x == 0) {
        unsigned* bar = b.bar;
        __builtin_amdgcn_s_waitcnt(0);
        unsigned nloc = b.st[0], nx = b.st[1];
        if (nloc == 0u) { xcd_barrier_complete(bar, b.x, nloc, nx); b.st[0] = nloc; b.st[1] = nx; }
        const unsigned old = xb_add(&bar[XB_XSUB(b.x)], 1u);
        const unsigned gen = old / nloc;
        if (old + 1u == (gen + 1u) * nloc) {
            __builtin_amdgcn_fence(__ATOMIC_RELEASE, "agent");
            asm volatile("s_waitcnt vmcnt(0)" ::: "memory");
            const unsigned og = xb_add(&bar[XB_TOP], 1u);
            const unsigned tg = og / nx;
            if (og + 1u == (tg + 1u) * nx) xb_add(&bar[XB_TOPGEN], 1u);
            else XB_SPIN(xb_ld(&bar[XB_TOPGEN]) == tg, bar);
            __builtin_amdgcn_fence(__ATOMIC_ACQUIRE, "agent");
            xb_add(&bar[XB_XGEN(b.x)], 1u);
            asm volatile("s_waitcnt vmcnt(0)" ::: "memory");
        } else {
            XB_SPIN(xb_ld(&bar[XB_XGEN(b.x)]) == gen, bar);
            __builtin_amdgcn_fence(__ATOMIC_ACQUIRE, "agent");
            asm volatile("s_waitcnt vmcnt(0)" ::: "memory");
        }
    }
    __syncthreads();
}

struct Args { const float* in[13]; float* out; unsigned char* ws; int coop_sync; int pad; };

__device__ __forceinline__ void transpose_item(const float* W, int ldw, int K, int srccol0, bf16* WT, int dstrow0, const float* gain, LAS float* scr, int kb, int nb, int lane) {
    const int k0 = 64 * kb, n0 = 32 * nb;
#pragma unroll
    for (int i = 0; i < 32; ++i) { const int kk = 2 * i + (lane >> 5); float w = W[(size_t)(k0 + kk) * ldw + srccol0 + n0 + (lane & 31)]; if (gain) w *= gain[k0 + kk]; scr[kk * 33 + (lane & 31)] = w; }
    LDS_WAIT(); asm volatile("" ::: "memory");
    const int c = lane & 7;
#pragma unroll
    for (int j = 0; j < 4; ++j) { const int n = (lane >> 3) + 8 * j; const LAS float* s = scr + (8 * c) * 33 + n;
        v4u o; o.x = pk2(s[0 * 33], s[1 * 33]); o.y = pk2(s[2 * 33], s[3 * 33]); o.z = pk2(s[4 * 33], s[5 * 33]); o.w = pk2(s[6 * 33], s[7 * 33]);
        *(v4u*)(WT + (size_t)(dstrow0 + n0 + n) * K + k0 + 8 * c) = o; }
    LDS_WAIT(); asm volatile("" ::: "memory");
}

__device__ __forceinline__ float log_sigmoid(float y) { return fminf(y, 0.f) - log1pf(expf(-fabsf(y))); }

__global__ void __launch_bounds__(NWAVES * 64, 2) fwd_megakernel(Args args) {
    extern __shared__ __attribute__((aligned(16))) unsigned char lds_raw[];
    LAS unsigned char* lds = (LAS unsigned char*)lds_raw;
    const int tid = threadIdx.x, lane = tid & 63, wave = __builtin_amdgcn_readfirstlane(tid >> 6);
    const int G = gridDim.x; const int bx = blockIdx.x; const int vcu = (G % 8 == 0) ? (bx % 8) * (G / 8) + bx / 8 : bx;
    const float* x = args.in[0]; const float* attn_g = args.in[1]; const float* w_in = args.in[2]; const float* fbias = args.in[3];
    const float* fox_g = args.in[4]; const float* sb_g = args.in[5]; const float* w_out = args.in[6]; const float* ffn_g = args.in[7];
    const float* w_up = args.in[8]; const float* conv_w = args.in[9]; const float* conv_b = args.in[10]; const float* w_down = args.in[11]; const float* final_g = args.in[12];
    float* out = args.out; unsigned char* ws = args.ws;
    bf16* Win_t = (bf16*)(ws + WS_WIN); bf16* Wout_t = (bf16*)(ws + WS_WOUT); bf16* Wup_t = (bf16*)(ws + WS_WUP); bf16* Wdn_t = (bf16*)(ws + WS_WDN);
    float* LF = (float*)(ws + WS_LF); float* F2 = (float*)(ws + WS_F2); float* SS = (float*)(ws + WS_SS); float* PS = (float*)(ws + WS_PS); float* PS2 = (float*)(ws + WS_PS2);
    float* HALO4 = (float*)(ws + WS_HALO); bf16* XN = (bf16*)(ws + WS_XN); bf16* QB = (bf16*)(ws + WS_Q); bf16* KB = (bf16*)(ws + WS_K); bf16* VB = (bf16*)(ws + WS_V); bf16* OB = (bf16*)(ws + WS_O);
    bf16* UB = (bf16*)(ws + WS_U); bf16* FS3 = (bf16*)(ws + WS_FS3); unsigned* CTL = (unsigned*)(ws + WS_CTL);
    const int gw = vcu * NWAVES + wave, NGW = G * NWAVES;
    volatile LAS unsigned* xst = (volatile LAS unsigned*)(lds + LDS_BYTES - 16);
    if (tid == 0) { xst[0] = 0u; xst[1] = 0u; }
    unsigned* XBAR = (unsigned*)(ws + WS_CTL + 262144);
    __syncthreads();
    XcdBarrier xbar = xcd_barrier_post(XBAR, xst);

    {
        LAS float* scr = (LAS float*)(lds + wave * 16384);
        constexpr int I_IN = 16 * 96, I_OUT = 16 * 32, I_UP = 16 * 176, I_DN = 44 * 32, NITEMS = I_IN + I_OUT + I_UP + I_DN;
        for (int it = gw; it < NITEMS; it += NGW) {
            int r = it;
            if (r < I_IN) { const int kb = r / 96, nb = r % 96, seg = nb >> 4, nbs = nb & 15;
                const int srcc = (seg == 0) ? 0 : (seg == 1) ? 1544 : (seg == 2) ? 512 : (seg == 3) ? 2056 : (seg == 4) ? 1024 : 2568;
                transpose_item(w_in, INC, 1024, srcc, Win_t, seg * 512, nullptr, scr, kb, nbs, lane); continue; } r -= I_IN;
            if (r < I_OUT) { const int kb = r / 32, nb = r % 32; transpose_item(w_out, 1024, 1024, 0, Wout_t, 0, (kb < 8) ? fox_g : (sb_g - 512), scr, kb, nb, lane); continue; } r -= I_OUT;
            if (r < I_UP) { const int kb = r / 176, nb = r % 176, pn = nb >> 3, jb = nb & 7; const int srcc = (jb < 4) ? 128 * pn + 32 * jb : DFF + 128 * pn + 32 * (jb - 4);
                transpose_item(w_up, NUP, 1024, srcc - 32 * nb, Wup_t, 0, ffn_g, scr, kb, nb, lane); continue; } r -= I_UP;
            { const int kb = r / 32, nb = r % 32; transpose_item(w_down, 1024, DFF, 0, Wdn_t, 0, nullptr, scr, kb, nb, lane); }
        }
        __syncthreads();
        LAS float* Wf = (LAS float*)lds;
        for (int i = tid; i < 1024 * 8; i += NWAVES * 64) Wf[i] = w_in[(size_t)(i >> 3) * INC + 1536 + (i & 7)];
        __syncthreads();
        f32x4 gv[4];
#pragma unroll
        for (int j = 0; j < 4; ++j) gv[j] = ((const f32x4*)attn_g)[lane + 64 * j];
        f32x4 vn[4];
        if (gw < MROWS) { const f32x4* xr = (const f32x4*)(x + (size_t)gw * DMODEL) + lane;
#pragma unroll
            for (int j = 0; j < 4; ++j) vn[j] = xr[64 * j]; }
        for (int m = gw; m < MROWS; m += NGW) {
            f32x4 v[4]; float s2 = 0.f;
#pragma unroll
            for (int j = 0; j < 4; ++j) { v[j] = vn[j]; s2 += (v[j].x * v[j].x + v[j].y * v[j].y) + (v[j].z * v[j].z + v[j].w * v[j].w); }
            if (m + NGW < MROWS) { const f32x4* xr = (const f32x4*)(x + (size_t)(m + NGW) * DMODEL) + lane;
#pragma unroll
                for (int j = 0; j < 4; ++j) vn[j] = xr[64 * j]; }
            const float rstd = 1.0f / sqrtf(wave_sum(s2) * (1.0f / DMODEL) + RMS_EPS);
            unsigned long long* o8 = (unsigned long long*)(XN + (size_t)m * DMODEL) + lane;
            float fa[8];
#pragma unroll
            for (int e = 0; e < 8; ++e) fa[e] = 0.f;
#pragma unroll
            for (int j = 0; j < 4; ++j) { v[j] = v[j] * rstd * gv[j];
                o8[64 * j] = (unsigned long long)pk2(v[j].x, v[j].y) | ((unsigned long long)pk2(v[j].z, v[j].w) << 32);
#pragma unroll
                for (int i = 0; i < 4; ++i) { const int k = 256 * j + 4 * lane + i; const f32x4 wa = *(const LAS f32x4*)(Wf + k * 8), wb = *(const LAS f32x4*)(Wf + k * 8 + 4); const float hk = v[j][i];
                    fa[0] += hk * wa[0]; fa[1] += hk * wa[1]; fa[2] += hk * wa[2]; fa[3] += hk * wa[3]; fa[4] += hk * wb[0]; fa[5] += hk * wb[1]; fa[6] += hk * wb[2]; fa[7] += hk * wb[3]; } }
            float r4[4], r2[2], r1;
            { const bool h = (lane & 32) != 0;
#pragma unroll
              for (int e = 0; e < 4; ++e) { const float snd = h ? fa[e] : fa[e + 4], kp = h ? fa[e + 4] : fa[e]; r4[e] = kp + __shfl_xor(snd, 32); } }
            { const bool h = (lane & 16) != 0;
#pragma unroll
              for (int e = 0; e < 2; ++e) { const float snd = h ? r4[e] : r4[e + 2], kp = h ? r4[e + 2] : r4[e]; r2[e] = kp + __shfl_xor(snd, 16); } }
            { const bool h = (lane & 8) != 0; const float snd = h ? r2[0] : r2[1], kp = h ? r2[1] : r2[0]; r1 = kp + __shfl_xor(snd, 8); }
            r1 += __shfl_xor(r1, 4); r1 += __shfl_xor(r1, 2); r1 += __shfl_xor(r1, 1);
            if ((lane & 7) == 0) { const int e = lane >> 3; LF[(size_t)m * 8 + e] = log_sigmoid(r1 + fbias[e]); }
        }
    }
    xcd_barrier(xbar);

    {
        LAS float* wtot = (LAS float*)lds;
        for (int bh = bx; bh < 32; bh += G) {
            const int b = bh >> 3, h = bh & 7; const float* src = LF + ((size_t)b * SEQ) * 8 + h;
            float loc[16]; float s = 0.f;
#pragma unroll
            for (int i = 0; i < 16; ++i) { s += src[(size_t)(tid * 16 + i) * 8]; loc[i] = s; }
            float incl = s;
#pragma unroll
            for (int o = 1; o < 64; o <<= 1) { const float t = __shfl_up(incl, o); if (lane >= o) incl += t; }
            if (lane == 63) wtot[wave] = incl;
            __syncthreads();
            float base = incl - s;
            for (int w = 0; w < wave; ++w) base += wtot[w];
            float* dst = F2 + (size_t)bh * SEQ + tid * 16;
#pragma unroll
            for (int i = 0; i < 16; ++i) { const float f = (base + loc[i]) * LOG2E; dst[i] = f;
                const float nf = -f; const unsigned h1 = f2bf(nf); const float r1 = nf - __builtin_bit_cast(float, h1 << 16); const unsigned h2 = f2bf(r1); const float r2 = r1 - __builtin_bit_cast(float, h2 << 16); const unsigned h3 = f2bf(r2);
                v4u o; o.x = h1 | (h2 << 16); o.y = h3; o.z = 0u; o.w = 0u; *(v4u*)(FS3 + ((size_t)bh * SEQ + tid * 16 + i) * 8) = o; }
            __syncthreads();
        }
        pg8::Gemm g{XN, Win_t, MROWS, 3072, 1024, 1024}; pg8::StaticOrder S; S.init(MROWS, 3072, G, bx);
        pg8::EpiQKV E{QB, 1024, 1024, (size_t)(WS_K - WS_Q) / 2, att::C2, CTL + 64};
        pg8::gemm_phase<pg8::EpiQKV, pg8::StaticOrder, true, true>(lds, g, S, E);
    }
    xcd_barrier(xbar);

    {
        volatile LAS unsigned* qw = (volatile LAS unsigned*)(lds + att::L_FLAG + 64);
        for (;;) {
            if (tid == 0) qw[0] = atomicAdd(CTL, 1u);
            __syncthreads();
            const unsigned idx = qw[0];
            if (idx >= 2048u) break;
            if (idx < 1024u) { const int qb = 31 - (int)(idx >> 5), bh = (int)(idx & 31);
                att::fox_unit(bh >> 3, bh & 7, qb, QB, KB, VB, OB, F2, FS3, CTL + 64, SS, lds); }
            else { const int u = (int)idx - 1024, qb = 31 - (u >> 5), bh = u & 31;
                att::sb_unit(bh >> 3, 8 + (bh & 7), qb, QB, KB, VB, OB, SS, lds); }
        }
    }
    xcd_barrier(xbar);

    {
        pg8::Gemm g{OB, Wout_t, MROWS, 1024, 1024, 1024}; pg8::StaticOrder S; S.init(MROWS, 1024, G, bx);
        LAS float* tab = (LAS float*)(lds + RING_BYTES);
        { pg8::Unit u; for (int ui = 0; ui < 7 && S.next(ui, u); ++ui) if (tid < 256) {
              const float* p = SS + (size_t)(u.pm * 256 + tid) * 16;
              const f32x4 a = *(const f32x4*)p, b = *(const f32x4*)(p + 4), c = *(const f32x4*)(p + 8), d = *(const f32x4*)(p + 12);
              const float sf = ((a[0] + a[1]) + (a[2] + a[3])) + ((b[0] + b[1]) + (b[2] + b[3])), ss = ((c[0] + c[1]) + (c[2] + c[3])) + ((d[0] + d[1]) + (d[2] + d[3]));
              const float rf = 1.0f / sqrtf(sf * (1.0f / 512.0f) + RMS_EPS), rs = 1.0f / sqrtf(ss * (1.0f / 512.0f) + RMS_EPS);
              tab[(ui * 256 + tid) * 2] = rf / rs; tab[(ui * 256 + tid) * 2 + 1] = rs; }
          __syncthreads(); }
        pg8::EpiOut E{x, out, XN, tab, PS};
        pg8::gemm_phase<pg8::EpiOut, pg8::StaticOrder, true, true>(lds, g, S, E);
    }
    xcd_barrier(xbar);

    {
        pg8::Gemm g{XN, Wup_t, MROWS, NUP, 1024, 1024}; pg8::StaticOrder S; S.init(MROWS, NUP, G, bx);
        float* RSTD1 = (float*)(ws + WS_CTL + 65536);
        { pg8::Unit u; for (int ui = 0; S.next(ui, u); ++ui) if (tid < 256) { const int r = u.pm * 256 + tid; RSTD1[r] = __builtin_amdgcn_rsqf(pg8::sum16(PS + (size_t)r * 16) * (1.0f / 1024.0f) + RMS_EPS); }
          __syncthreads(); }
        pg8::EpiUpConv E{UB, RSTD1, HALO4, conv_w, conv_b, (LAS float*)(lds + RING_BYTES)};
        pg8::gemm_phase<pg8::EpiUpConv, pg8::StaticOrder, true, true>(lds, g, S, E);
    }
    xcd_barrier(xbar);

    {
        for (int idx = bx * (NWAVES * 64) + tid; idx < 128 * 2 * 704; idx += G * NWAVES * 64) {
            const int pm = idx / 1408, rem = idx % 1408, t = rem / 704, c4 = (rem % 704) * 4;
            const bool first = (pm & 31) == 0;
            const float* h0 = HALO4 + (size_t)(pm * 4) * 5632; const float* hp = HALO4 + (size_t)((first ? pm : pm - 1) * 4) * 5632;
            const f32x4 z = {0.f, 0.f, 0.f, 0.f};
            f32x4 ug[3], uv[3];
            ug[2] = *(const f32x4*)(h0 + t * 5632 + c4); uv[2] = *(const f32x4*)(h0 + t * 5632 + DFF + c4);
            if (t == 1) { ug[1] = *(const f32x4*)(h0 + c4); uv[1] = *(const f32x4*)(h0 + DFF + c4); } else { ug[1] = first ? z : *(const f32x4*)(hp + 3 * 5632 + c4); uv[1] = first ? z : *(const f32x4*)(hp + 3 * 5632 + DFF + c4); }
            { const int pr = (t == 1) ? 3 : 2; ug[0] = first ? z : *(const f32x4*)(hp + pr * 5632 + c4); uv[0] = first ? z : *(const f32x4*)(hp + pr * 5632 + DFF + c4); }
            f32x4 og = *(const f32x4*)(conv_b + c4), ov = *(const f32x4*)(conv_b + DFF + c4);
#pragma unroll
            for (int k = 0; k < 3; ++k) { og += *(const f32x4*)(conv_w + (size_t)k * NUP + c4) * ug[k]; ov += *(const f32x4*)(conv_w + (size_t)k * NUP + DFF + c4) * uv[k]; }
            float res[4];
#pragma unroll
            for (int i = 0; i < 4; ++i) res[i] = og[i] / (1.0f + __expf(-og[i])) * ov[i];
            unsigned long long o = (unsigned long long)pk2(res[0], res[1]) | ((unsigned long long)pk2(res[2], res[3]) << 32);
            *(unsigned long long*)(UB + (size_t)(pm * 256 + t) * DFF + c4) = o;
        }
    }
    xcd_barrier(xbar);

    {
        pg8::Gemm g{UB, Wdn_t, MROWS, 1024, DFF, DFF}; pg8::StaticOrder S; S.init(MROWS, 1024, G, bx);
        pg8::EpiDown E{out, out, PS2};
        pg8::gemm_phase<pg8::EpiDown, pg8::StaticOrder, true, true>(lds, g, S, E);
    }
    xcd_barrier(xbar);

    {
        int lane6 = threadIdx.x & 63; asm volatile("" : "+v"(lane6));
        f32x4 gv[4];
#pragma unroll
        for (int j = 0; j < 4; ++j) gv[j] = ((const f32x4*)final_g)[lane6 + 64 * j];
        for (int m = gw; m < MROWS; m += NGW) {
            const float rstd = 1.0f / sqrtf(pg8::sum16(PS2 + (size_t)m * 16) * (1.0f / DMODEL) + RMS_EPS);
            f32x4* xr = (f32x4*)(out + (size_t)m * DMODEL) + lane6;
#pragma unroll
            for (int j = 0; j < 4; ++j) { const f32x4 v = xr[64 * j]; xr[64 * j] = v * rstd * gv[j]; }
        }
    }
    if (args.coop_sync) cg::this_grid().sync();
}

extern "C" void kernel_launch(void* const* d_in, const int* in_sizes, int n_in, void* d_out, int out_size, void* d_ws, size_t ws_size, hipStream_t stream) {
    static int grid = 0;
    if (grid == 0) {
        if (n_in != 13 || ws_size < WS_END) { fprintf(stderr, "kernel_launch: unexpected inputs (n_in %d, ws %zu)\n", n_in, ws_size); grid = -1; return; }
        int dev = 0, cus = 0, per_cu = 0;
        hipGetDevice(&dev); hipDeviceGetAttribute(&cus, hipDeviceAttributeMultiprocessorCount, dev);
        hipFuncSetAttribute((const void*)fwd_megakernel, hipFuncAttributeMaxDynamicSharedMemorySize, LDS_BYTES);
        hipOccupancyMaxActiveBlocksPerMultiprocessor(&per_cu, (const void*)fwd_megakernel, NWAVES * 64, LDS_BYTES);
        (void)hipGetLastError();
        if (per_cu < 1) per_cu = 1;
        grid = cus * per_cu; if (grid > 256) grid = 256;
    }
    if (grid < 0) return;
    if (hipMemsetAsync((unsigned char*)d_ws + WS_CTL, 0, 262144 + 16384, stream) != hipSuccess) { fprintf(stderr, "kernel_launch: hipMemsetAsync failed\n"); return; }
    Args a{};
    for (int i = 0; i < 13; ++i) a.in[i] = (const float*)d_in[i];
    a.out = (float*)d_out; a.ws = (unsigned char*)d_ws;
    void* kargs[] = {&a};
    hipError_t e = hipLaunchCooperativeKernel((const void*)fwd_megakernel, dim3(grid), dim3(NWAVES * 64), kargs, LDS_BYTES, stream);
    if (e != hipSuccess) fprintf(stderr, "cooperative launch failed: %s (grid %d)\n", hipGetErrorString(e), grid);
}
```

```cpp
#include <hip/hip_runtime.h>
#include <hip/hip_cooperative_groups.h>
#include <cstdio>
#include <cstdint>
#include <cmath>
namespace cg = cooperative_groups;
namespace pg8 {
#define PG8_LAS __attribute__((address_space(3)))
typedef unsigned short bf16_t;
typedef short bf16x8 __attribute__((ext_vector_type(8)));
typedef float f32x4 __attribute__((ext_vector_type(4)));
typedef unsigned u32x4 __attribute__((ext_vector_type(4)));
constexpr int BM = 256, BK = 64, HALF = 128, HTB = HALF * BK * 2  , STAGE_BYTES = 8 * HTB, NXCD = 8, WGM = 8;

__host__ __device__ __forceinline__ int lds_byte(int r, int c) { const int st = (r >> 4) * 2 + (c >> 5), rr = r & 15, cc = c & 31, ob = rr * 64 + cc * 2; return st * 1024 + (ob ^ (((ob >> 9) & 1) << 5)); }
__host__ __device__ __forceinline__ void stage_rc(int b, int& R, int& C) { const int st = b / 1024, sb = b % 1024, swz = sb ^ (((sb >> 9) & 1) << 5); R = (st >> 1) * 16 + swz / 64; C = (st & 1) * 32 + (swz % 64) / 2; }
__host__ __device__ __forceinline__ int perm32(int rho) { const int n = rho >> 4, i = rho & 15; return 8 * (i >> 2) + 4 * n + (i & 3); }

struct Unit { int pm, pn, idx; };
struct Gemm { const bf16_t* A; const bf16_t* Bt; int M, N, K, lda; };

struct StaticOrder {
    int nM, nN, nwg, G, c;
    __host__ __device__ void init(int M, int N, int G_, int c_) { nM = M / BM; nN = N / BM; nwg = nM * nN; G = G_; c = c_; }
    __host__ __device__ bool next(int i, Unit& u) const {
        const long L = (long)i * G + c; if (L >= nwg) return false;
        int wgid = (int)L; { const int q = nwg / NXCD, r = nwg % NXCD, xcd = wgid % NXCD, off = wgid / NXCD; wgid = (xcd < r ? xcd * (q + 1) : r * (q + 1) + (xcd - r) * q) + off; }
        const int nig = WGM * nN, gid = wgid / nig, fm = gid * WGM, gsz = (nM - fm) < WGM ? (nM - fm) : WGM;
        u.pm = fm + ((wgid % nig) % gsz); u.pn = (wgid % nig) / gsz; u.idx = i; return true;
    }
    __device__ __forceinline__ void a_ready(const Unit&) const {}
    __device__ __forceinline__ void done(const Unit&) const {}
};

__device__ __forceinline__ unsigned cvt_pk_bf16(float lo, float hi) { unsigned r; asm volatile("v_cvt_pk_bf16_f32 %0, %1, %2" : "=v"(r) : "v"(lo), "v"(hi)); return r; }
typedef float f32x2 __attribute__((ext_vector_type(2)));

typedef unsigned u32x2 __attribute__((ext_vector_type(2)));
constexpr float RMS_EPS = 1e-6f;
__device__ __forceinline__ float sum16(const float* p) {
    const f32x4 a = *(const f32x4*)p, b = *(const f32x4*)(p + 4), c = *(const f32x4*)(p + 8), d = *(const f32x4*)(p + 12);
    return ((a[0] + a[1]) + (a[2] + a[3])) + ((b[0] + b[1]) + (b[2] + b[3])) + ((c[0] + c[1]) + (c[2] + c[3])) + ((d[0] + d[1]) + (d[2] + d[3]));
}

struct EpiQKV {
    static constexpr bool PERM = true, AFTER_DRAIN = false, HAS_MID = false;
    bf16_t* O; int ldc; int split_cols; size_t split_stride; float scale0; unsigned* kmax;
    __device__ __forceinline__ void operator()(f32x4 (&acc)[2][2][4][2], const Unit& u, int wr, int wc, int fr, int fq) const {
        const int row0 = u.pm * BM + wr * 64 + fr; int colt = u.pn * BM; bf16_t* base = O;
        float sc = 1.f; const int t = colt / split_cols; { base += (size_t)t * split_stride; colt -= t * split_cols; if (t == 0) sc = scale0; }
        const int col0 = colt + wc * 32 + 8 * fq;
        const bool knorm = (t == 1) && (colt < 512);
        float hm[2] = {0.f, 0.f};
#pragma unroll
        for (int ai = 0; ai < 2; ++ai)
#pragma unroll
            for (int m = 0; m < 4; ++m) { bf16_t* rowp = base + (size_t)(row0 + ai * HALF + m * 16) * ldc + col0;
#pragma unroll
                for (int bj = 0; bj < 2; ++bj) { f32x4 v0 = acc[ai][bj][m][0] * sc, v1 = acc[ai][bj][m][1] * sc;
                    u32x4 w; w.x = cvt_pk_bf16(v0[0], v0[1]); w.y = cvt_pk_bf16(v0[2], v0[3]); w.z = cvt_pk_bf16(v1[0], v1[1]); w.w = cvt_pk_bf16(v1[2], v1[3]);
                    *(u32x4*)(rowp + bj * HALF) = w;
                    if (knorm) { float s = ((v0[0] * v0[0] + v0[1] * v0[1]) + (v0[2] * v0[2] + v0[3] * v0[3])) + ((v1[0] * v1[0] + v1[1] * v1[1]) + (v1[2] * v1[2] + v1[3] * v1[3]));
                        s += __shfl_xor(s, 16); s += __shfl_xor(s, 32); hm[bj] = fmaxf(hm[bj], s); } } }
        if (knorm) {
#pragma unroll
            for (int o = 1; o < 16; o <<= 1) { hm[0] = fmaxf(hm[0], __shfl_xor(hm[0], o)); hm[1] = fmaxf(hm[1], __shfl_xor(hm[1], o)); }
            if (fr == 0 && fq == 0) { const int b = (u.pm * BM) >> 13;
                atomicMax(kmax + b * 8 + ((colt + wc * 32) >> 6), __float_as_uint(hm[0])); atomicMax(kmax + b * 8 + ((colt + 128 + wc * 32) >> 6), __float_as_uint(hm[1])); } }
    }
};

#define PG8_DPP(v, ctrl) __builtin_bit_cast(float, __builtin_amdgcn_update_dpp(0, __builtin_bit_cast(int, (v)), (ctrl), 0xf, 0xf, true))
struct EpiUpConv {
    static constexpr bool PERM = true, AFTER_DRAIN = false, HAS_MID = false;
    bf16_t* G; const float* PS  ; float* HALO4; const float* cw; const float* cb; PG8_LAS float* hal;
    __device__ __forceinline__ void operator()(f32x4 (&acc)[2][2][4][2], const Unit& u, int wr, int wc, int fr_, int fq_) const {
        int fr = fr_, fq = fq_; asm volatile("" : "+v"(fr), "+v"(fq));
        const int row0 = u.pm * BM + wr * 64 + fr; const int colw = wc * 32 + 8 * fq; const int c0 = u.pn * 128;
#pragma unroll
        for (int ai = 0; ai < 2; ++ai)
#pragma unroll
            for (int m = 0; m < 4; ++m) { const int r = row0 + ai * HALF + m * 16; const float rs = *(const float*)((const char*)PS + (unsigned)r * 4u);
#pragma unroll
                for (int bj = 0; bj < 2; ++bj)
#pragma unroll
                    for (int n = 0; n < 2; ++n) acc[ai][bj][m][n] = acc[ai][bj][m][n] * rs;
                asm volatile("" ::: "memory"); __builtin_amdgcn_sched_barrier(0); }
        f32x4 W[2][4];
#define PG8_LDW(BUF, N_, BJ_) do { const unsigned ch_ = (unsigned)((BJ_) * 2816 + c0 + colw + 4 * (N_)) * 4u; \
            W[BUF][0] = *(const f32x4*)((const char*)cw + ch_); W[BUF][1] = *(const f32x4*)((const char*)cw + 5632u * 4u + ch_); \
            W[BUF][2] = *(const f32x4*)((const char*)cw + 2u * 5632u * 4u + ch_); W[BUF][3] = *(const f32x4*)((const char*)cb + ch_); } while (0)
        PG8_LDW(0, 0, 0);
        if (fr >= 14) {
#pragma unroll
            for (int ai = 0; ai < 2; ++ai)
#pragma unroll
                for (int bj = 0; bj < 2; ++bj)
#pragma unroll
                    for (int n = 0; n < 2; ++n) *(PG8_LAS f32x4*)(hal + (((ai * 2 + wr) * 2 + (fr - 14)) * 256 + bj * 128 + colw + 4 * n)) = acc[ai][bj][3][n];
            if (wr == 1) {
#pragma unroll
                for (int bj = 0; bj < 2; ++bj)
#pragma unroll
                    for (int n = 0; n < 2; ++n) *(f32x4*)(HALO4 + (size_t)(u.pm * 4 + 2 + (fr - 14)) * 5632 + bj * 2816 + c0 + colw + 4 * n) = acc[1][bj][3][n]; }
        }
        if (wr == 0 && fr < 2) {
#pragma unroll
            for (int bj = 0; bj < 2; ++bj)
#pragma unroll
                for (int n = 0; n < 2; ++n) *(f32x4*)(HALO4 + (size_t)(u.pm * 4 + fr) * 5632 + bj * 2816 + c0 + colw + 4 * n) = acc[0][bj][0][n]; }
        asm volatile("s_waitcnt lgkmcnt(0)\n\ts_barrier" ::: "memory");
        const int hrow = (fr == 15) ? 1 : 0;
#pragma unroll
        for (int n = 0; n < 2; ++n) {
#pragma unroll
            for (int bj = 0; bj < 2; ++bj) {
                const int gi = n * 2 + bj;
                if (gi == 0) PG8_LDW(1, 0, 1); else if (gi == 1) PG8_LDW(0, 1, 0); else if (gi == 2) PG8_LDW(1, 1, 1);
                const f32x4 w0 = W[gi & 1][0], w1 = W[gi & 1][1], w2 = W[gi & 1][2], bb = W[gi & 1][3];
#pragma unroll
                for (int ai = 0; ai < 2; ++ai) {
                    f32x4 prev;
                    if (ai == 0 && wr == 0) prev = (f32x4){0.f, 0.f, 0.f, 0.f};
                    else prev = *(const PG8_LAS f32x4*)(hal + (((ai * 2 + wr - 1) * 2 + hrow) * 256 + bj * 128 + colw + 4 * n));
#pragma unroll
                    for (int m = 0; m < 4; ++m) { const f32x4 cur = acc[ai][bj][m][n]; f32x4 o;
#pragma unroll
                        for (int i = 0; i < 4; ++i) {
                            float s1, s2;
                            asm volatile("s_nop 1\n\tv_mov_b32_dpp %0, %2 row_ror:1 row_mask:0xf bank_mask:0xf\n\tv_mov_b32_dpp %1, %2 row_ror:2 row_mask:0xf bank_mask:0xf\n\t"
                                         "v_mov_b32_dpp %0, %3 row_shr:1 row_mask:0xf bank_mask:0xf\n\tv_mov_b32_dpp %1, %3 row_shr:2 row_mask:0xf bank_mask:0xf"
                                         : "=&v"(s1), "=&v"(s2) : "v"(prev[i]), "v"(cur[i]), "v"(w1[i]), "v"(w0[i]));
                            float t = bb[i] + w2[i] * cur[i] + w1[i] * s1 + w0[i] * s2; asm volatile("" : "+v"(t)); o[i] = t; }
                        acc[ai][bj][m][n] = o; prev = cur; __builtin_amdgcn_sched_barrier(0); }
                }
                asm volatile("" ::: "memory"); __builtin_amdgcn_sched_barrier(0);
            }
#pragma unroll
            for (int ai = 0; ai < 2; ++ai)
#pragma unroll
                for (int m = 0; m < 4; ++m) { int rowb = row0; asm volatile("" : "+v"(rowb)); const f32x4 cg = acc[ai][0][m][n], cv = acc[ai][1][m][n]; float res[4];
#pragma unroll
                    for (int i = 0; i < 4; ++i) { const float g = cg[i]; res[i] = g * __builtin_amdgcn_rcpf(1.0f + __builtin_amdgcn_exp2f(-1.4426950408889634f * g)) * cv[i]; }
                    u32x2 w; w.x = cvt_pk_bf16(res[0], res[1]); w.y = cvt_pk_bf16(res[2], res[3]);
                    const bool skip = (ai == 0) && (m == 0) && (wr == 0) && (fr < 2);
                    if (!skip) *(u32x2*)((char*)G + ((unsigned)(rowb + ai * HALF + m * 16) * 2816u + (unsigned)(c0 + colw + 4 * n)) * 2u) = w; __builtin_amdgcn_sched_barrier(0); }
            asm volatile("" ::: "memory");
        }
    }
};

struct EpiOut {
    static constexpr bool PERM = false, AFTER_DRAIN = false, HAS_MID = true;
    const float* X; float* X1; bf16_t* XB; const PG8_LAS float* tab; float* PS;
    __device__ __forceinline__ void mid(f32x4 (&acc)[2][2][4][2], const Unit& u, int wr, int wc, int fr, int fq) const {
        const PG8_LAS float* t = tab + (u.idx * 256 + wr * 64 + fr) * 2;
#pragma unroll
        for (int ai = 0; ai < 2; ++ai)
#pragma unroll
            for (int m = 0; m < 4; ++m) { const float ratio = t[(ai * HALF + m * 16) * 2];
#pragma unroll
                for (int bj = 0; bj < 2; ++bj)
#pragma unroll
                    for (int n = 0; n < 2; ++n) acc[ai][bj][m][n] = acc[ai][bj][m][n] * ratio; }
    }
    __device__ __forceinline__ void operator()(f32x4 (&acc)[2][2][4][2], const Unit& u, int wr, int wc, int fr, int fq) const {
        const int row0 = u.pm * BM + wr * 64 + fr; const int col0 = u.pn * BM + wc * 32 + 4 * fq;
        const PG8_LAS float* t = tab + (u.idx * 256 + wr * 64 + fr) * 2 + 1;
        f32x4 xn[2][2];
#pragma unroll
        for (int bj = 0; bj < 2; ++bj)
#pragma unroll
            for (int n = 0; n < 2; ++n) xn[bj][n] = *(const f32x4*)(X + (size_t)row0 * 1024 + col0 + bj * HALF + n * 16);
#pragma unroll
        for (int ai = 0; ai < 2; ++ai)
#pragma unroll
            for (int m = 0; m < 4; ++m) { const int r = row0 + ai * HALF + m * 16; const float rs = t[(ai * HALF + m * 16) * 2]; const size_t off = (size_t)r * 1024 + col0; float sq = 0.f;
                f32x4 xv[2][2];
#pragma unroll
                for (int bj = 0; bj < 2; ++bj)
#pragma unroll
                    for (int n = 0; n < 2; ++n) xv[bj][n] = xn[bj][n];
                if (ai * 4 + m < 7) { const int r2 = row0 + ((ai * 4 + m + 1) >> 2) * HALF + ((ai * 4 + m + 1) & 3) * 16;
#pragma unroll
                    for (int bj = 0; bj < 2; ++bj)
#pragma unroll
                        for (int n = 0; n < 2; ++n) xn[bj][n] = *(const f32x4*)(X + (size_t)r2 * 1024 + col0 + bj * HALF + n * 16); }
#pragma unroll
                for (int bj = 0; bj < 2; ++bj)
#pragma unroll
                    for (int n = 0; n < 2; ++n) { const size_t o2 = off + bj * HALF + n * 16; const f32x4 o = xv[bj][n] + acc[ai][bj][m][n] * rs;
                        *(f32x4*)(X1 + o2) = o; u32x2 w; w.x = cvt_pk_bf16(o[0], o[1]); w.y = cvt_pk_bf16(o[2], o[3]); *(u32x2*)(XB + o2) = w;
                        sq += (o[0] * o[0] + o[1] * o[1]) + (o[2] * o[2] + o[3] * o[3]); }
                sq += __shfl_xor(sq, 16); sq += __shfl_xor(sq, 32);
                if (fq == 0) PS[(size_t)r * 16 + u.pn * 4 + wc] = sq;
                asm volatile("" ::: "memory"); }
    }
};

struct EpiDown {
    static constexpr bool PERM = false, AFTER_DRAIN = false, HAS_MID = false;
    const float* X1; float* OUT; float* PS;
    __device__ __forceinline__ void operator()(f32x4 (&acc)[2][2][4][2], const Unit& u, int wr, int wc, int fr, int fq) const {
        const int row0 = u.pm * BM + wr * 64 + fr; const int col0 = u.pn * BM + wc * 32 + 4 * fq;
        f32x4 xn[2][2];
#pragma unroll
        for (int bj = 0; bj < 2; ++bj)
#pragma unroll
            for (int n = 0; n < 2; ++n) xn[bj][n] = *(const f32x4*)(X1 + (size_t)row0 * 1024 + col0 + bj * HALF + n * 16);
#pragma unroll
        for (int ai = 0; ai < 2; ++ai)
#pragma unroll
            for (int m = 0; m < 4; ++m) { const int r = row0 + ai * HALF + m * 16; const size_t off = (size_t)r * 1024 + col0; float sq = 0.f;
                f32x4 xv[2][2];
#pragma unroll
                for (int bj = 0; bj < 2; ++bj)
#pragma unroll
                    for (int n = 0; n < 2; ++n) xv[bj][n] = xn[bj][n];
                if (ai * 4 + m < 7) { const int r2 = row0 + ((ai * 4 + m + 1) >> 2) * HALF + ((ai * 4 + m + 1) & 3) * 16;
#pragma unroll
                    for (int bj = 0; bj < 2; ++bj)
#pragma unroll
                        for (int n = 0; n < 2; ++n) xn[bj][n] = *(const f32x4*)(X1 + (size_t)r2 * 1024 + col0 + bj * HALF + n * 16); }
#pragma unroll
                for (int bj = 0; bj < 2; ++bj)
#pragma unroll
                    for (int n = 0; n < 2; ++n) { const size_t o2 = off + bj * HALF + n * 16; const f32x4 o = xv[bj][n] + acc[ai][bj][m][n];
                        *(f32x4*)(OUT + o2) = o; sq += (o[0] * o[0] + o[1] * o[1]) + (o[2] * o[2] + o[3] * o[3]); }
                sq += __shfl_xor(sq, 16); sq += __shfl_xor(sq, 32);
                if (fq == 0) PS[(size_t)r * 16 + u.pn * 4 + wc] = sq;
                asm volatile("" ::: "memory"); }
    }
};
template <class Epi, class Sched, bool ALIGN_EPI = false, bool SP2 = false>
__device__ __forceinline__ void gemm_phase(PG8_LAS unsigned char* lds, const Gemm g, const Sched& S, const Epi& E) {
    int tid_ = threadIdx.x; asm volatile("" : "+v"(tid_));
    const int tid = tid_, wid = __builtin_amdgcn_readfirstlane(tid >> 6), lane = tid & 63, wr = wid >> 2, wc = wid & 3, fr = lane & 15, fq = lane >> 4;
    const int K = g.K, nt = K / BK;
    unsigned voffA[2], voffB[2];
#pragma unroll
    for (int i = 0; i < 2; ++i) { int R, C; stage_rc(tid * 16 + i * 8192, R, C); const int Rb = Epi::PERM ? ((R & ~31) + perm32(R & 31)) : R;
        voffA[i] = (unsigned)(R * g.lda + C) * 2u; voffB[i] = (unsigned)(Rb * K + C) * 2u; }
    const size_t kstep = (size_t)(BK * 2);
    const size_t hstepA = (size_t)HALF * g.lda * 2, hstepB = (size_t)HALF * K * 2;
    const size_t tstepA = 2 * hstepA, tstepB = 2 * hstepB;
    const unsigned ldsw = (unsigned)wid * 1024u;
    const int aoff = lds_byte(wr * 64 + fr, fq * 8), boff = lds_byte(wc * 32 + fr, fq * 8);
#define PG8_SA(b, h) (((b) * 2 + (h)) * HTB)
#define PG8_SB(b, h) ((4 + (b) * 2 + (h)) * HTB)
#define PG8_STAGE(bufoff, gbase, voff) do { _Pragma("unroll") for (int _i = 0; _i < 2; ++_i) \
        __builtin_amdgcn_global_load_lds((const unsigned*)((const char*)(gbase) + (voff)[_i]), (PG8_LAS unsigned*)(lds + (bufoff) + ldsw + _i * 8192), 16, 0, 0); } while (0)
#define PG8_LDA(dst, b, h) do { _Pragma("unroll") for (int m = 0; m < 4; ++m) _Pragma("unroll") for (int k = 0; k < 2; ++k) dst[m][k] = *(const PG8_LAS bf16x8*)(lds + PG8_SA(b, h) + aoff + m * 2048 + k * 1024); } while (0)
#define PG8_LDB(dst, b, h) do { _Pragma("unroll") for (int n = 0; n < 2; ++n) _Pragma("unroll") for (int k = 0; k < 2; ++k) dst[n][k] = *(const PG8_LAS bf16x8*)(lds + PG8_SB(b, h) + boff + n * 2048 + k * 1024); } while (0)
#define PG8_MMA(ai, bj, At, Bt) do { __builtin_amdgcn_s_setprio(1); _Pragma("unroll") for (int m = 0; m < 4; ++m) _Pragma("unroll") for (int n = 0; n < 2; ++n) _Pragma("unroll") for (int k = 0; k < 2; ++k) \
        acc[ai][bj][m][n] = __builtin_amdgcn_mfma_f32_16x16x32_bf16(Bt[n][k], At[m][k], acc[ai][bj][m][n], 0, 0, 0); __builtin_amdgcn_s_setprio(0); } while (0)
#define PG8_WAIT_V(n) asm volatile("s_waitcnt vmcnt(" #n ")" ::: "memory")
#define PG8_WAIT_L(n) asm volatile("s_waitcnt lgkmcnt(" #n ")" ::: "memory")
#define PG8_BAR __builtin_amdgcn_s_barrier()
#define PG8_SCHED __builtin_amdgcn_sched_barrier(0)
    Unit cur, nxt; int ui = 0;
    if (!S.next(0, cur)) return;
    f32x4 acc[2][2][4][2];
#pragma unroll
    for (int a = 0; a < 2; ++a)
#pragma unroll
        for (int b = 0; b < 2; ++b)
#pragma unroll
            for (int m = 0; m < 4; ++m)
#pragma unroll
                for (int n = 0; n < 2; ++n) acc[a][b][m][n] = (f32x4){0.f, 0.f, 0.f, 0.f};
    bf16x8 At[4][2], B0[2][2], B1[2][2];
    const char* cA = (const char*)g.A + (size_t)cur.pm * tstepA; const char* cB = (const char*)g.Bt + (size_t)cur.pn * tstepB;
    S.a_ready(cur);
    if constexpr (SP2) {
        PG8_STAGE(PG8_SB(0, 0), cB, voffB); PG8_STAGE(PG8_SB(0, 1), cB + hstepB, voffB); PG8_STAGE(PG8_SA(0, 0), cA, voffA); PG8_STAGE(PG8_SA(0, 1), cA + hstepA, voffA);
        if (wr == 1) PG8_BAR;
        PG8_WAIT_V(2); PG8_BAR;
        PG8_STAGE(PG8_SB(1, 0), cB + kstep, voffB); PG8_STAGE(PG8_SA(1, 0), cA + kstep, voffA); PG8_STAGE(PG8_SB(1, 1), cB + hstepB + kstep, voffB);
        PG8_WAIT_V(6); PG8_BAR;
    } else {
        PG8_STAGE(PG8_SB(0, 0), cB, voffB); PG8_STAGE(PG8_SA(0, 0), cA, voffA); PG8_STAGE(PG8_SB(0, 1), cB + hstepB, voffB); PG8_STAGE(PG8_SA(0, 1), cA + hstepA, voffA);
        if (wr == 1) PG8_BAR;
        PG8_WAIT_V(4); PG8_BAR;
        PG8_STAGE(PG8_SB(1, 0), cB + kstep, voffB); PG8_STAGE(PG8_SA(1, 0), cA + kstep, voffA); PG8_STAGE(PG8_SB(1, 1), cB + hstepB + kstep, voffB);
        PG8_WAIT_V(6); PG8_BAR;
    }
    for (;;) {
        const bool has_next = S.next(ui + 1, nxt);
        const char* nA = has_next ? (const char*)g.A + (size_t)nxt.pm * tstepA : cA; const char* nB = has_next ? (const char*)g.Bt + (size_t)nxt.pn * tstepB : cB;
        for (int t = 0; t < nt; t += 2) {
            if constexpr (Epi::HAS_MID) { if (t == (nt >> 1)) E.mid(acc, cur, wr, wc, fr, fq); }
            const bool last = (t == nt - 2);
            const char* a1 = cA + (size_t)(t + 1) * kstep;
            const char* a2 = last ? nA : cA + (size_t)(t + 2) * kstep; const char* b2 = last ? nB : cB + (size_t)(t + 2) * kstep;
            const char* a3 = a2 + kstep; const char* b3 = b2 + kstep;
            if (last && has_next) S.a_ready(nxt);
            if constexpr (SP2) {
            PG8_LDB(B0, 0, 0); PG8_LDB(B1, 0, 1); PG8_SCHED; PG8_LDA(At, 0, 0); PG8_STAGE(PG8_SA(1, 1), a1 + hstepA, voffA);
            PG8_WAIT_V(8); PG8_WAIT_L(0); PG8_BAR; PG8_MMA(0, 0, At, B0); PG8_MMA(0, 1, At, B1); PG8_BAR; PG8_SCHED;
            PG8_LDA(At, 0, 1); PG8_STAGE(PG8_SB(0, 0), b2, voffB); PG8_STAGE(PG8_SB(0, 1), b2 + hstepB, voffB); PG8_STAGE(PG8_SA(0, 0), a2, voffA);
            PG8_WAIT_V(8); PG8_WAIT_L(0); PG8_BAR; PG8_MMA(1, 0, At, B0); PG8_MMA(1, 1, At, B1); PG8_BAR; PG8_SCHED;
            PG8_LDB(B0, 1, 0); PG8_LDB(B1, 1, 1); PG8_SCHED; PG8_LDA(At, 1, 0); PG8_STAGE(PG8_SA(0, 1), a2 + hstepA, voffA);
            PG8_WAIT_V(8); PG8_WAIT_L(0); PG8_BAR; PG8_MMA(0, 0, At, B0); PG8_MMA(0, 1, At, B1); PG8_BAR; PG8_SCHED;
            PG8_LDA(At, 1, 1); PG8_STAGE(PG8_SB(1, 0), b3, voffB); PG8_STAGE(PG8_SB(1, 1), b3 + hstepB, voffB); PG8_STAGE(PG8_SA(1, 0), a3, voffA);
            PG8_WAIT_V(8); PG8_WAIT_L(0); PG8_BAR; PG8_MMA(1, 0, At, B0); PG8_MMA(1, 1, At, B1); PG8_BAR; PG8_SCHED;
            } else {
            PG8_LDB(B0, 0, 0); PG8_SCHED; PG8_LDA(At, 0, 0); PG8_STAGE(PG8_SA(1, 1), a1 + hstepA, voffA);
            PG8_WAIT_L(8); PG8_BAR; PG8_WAIT_L(0); PG8_MMA(0, 0, At, B0); PG8_BAR; PG8_SCHED;
            PG8_LDB(B1, 0, 1); PG8_STAGE(PG8_SB(0, 0), b2, voffB);
            PG8_BAR; PG8_WAIT_L(0); PG8_MMA(0, 1, At, B1); PG8_BAR;
            PG8_LDA(At, 0, 1); PG8_STAGE(PG8_SA(0, 0), a2, voffA);
            PG8_BAR; PG8_WAIT_L(0); PG8_MMA(1, 0, At, B0); PG8_BAR; PG8_SCHED;
            PG8_STAGE(PG8_SB(0, 1), b2 + hstepB, voffB);
            PG8_WAIT_V(6); PG8_BAR; PG8_MMA(1, 1, At, B1); PG8_BAR;
            PG8_LDB(B0, 1, 0); PG8_SCHED; PG8_LDA(At, 1, 0); PG8_STAGE(PG8_SA(0, 1), a2 + hstepA, voffA);
            PG8_WAIT_L(8); PG8_BAR; PG8_WAIT_L(0); PG8_MMA(0, 0, At, B0); PG8_BAR; PG8_SCHED;
            PG8_LDB(B1, 1, 1); PG8_STAGE(PG8_SB(1, 0), b3, voffB);
            PG8_BAR; PG8_WAIT_L(0); PG8_MMA(0, 1, At, B1); PG8_BAR;
            PG8_LDA(At, 1, 1); PG8_STAGE(PG8_SA(1, 0), a3, voffA);
            PG8_BAR; PG8_WAIT_L(0); PG8_MMA(1, 0, At, B0); PG8_BAR; PG8_SCHED;
            PG8_STAGE(PG8_SB(1, 1), b3 + hstepB, voffB);
            PG8_WAIT_V(6); PG8_BAR; PG8_MMA(1, 1, At, B1); PG8_BAR;
            }
        }
        if constexpr (ALIGN_EPI) { if (wr == 0) PG8_BAR; }
        if constexpr (!Epi::AFTER_DRAIN) { E(acc, cur, wr, wc, fr, fq); S.done(cur); }
        if (!has_next) break;
#pragma unroll
        for (int a = 0; a < 2; ++a)
#pragma unroll
            for (int b = 0; b < 2; ++b)
#pragma unroll
                for (int m = 0; m < 4; ++m)
#pragma unroll
                    for (int n = 0; n < 2; ++n) acc[a][b][m][n] = (f32x4){0.f, 0.f, 0.f, 0.f};
        cur = nxt; cA = nA; cB = nB; ++ui;
        if constexpr (ALIGN_EPI) { if (wr == 1) PG8_BAR; }
    }
    PG8_WAIT_V(0);
    if constexpr (!ALIGN_EPI) { if (wr == 0) PG8_BAR; }
    PG8_BAR;
    if constexpr (Epi::AFTER_DRAIN) { E.fused(acc, cur, wr, wc, fr, fq, lds, wid, lane); S.done(cur); }
#undef PG8_SA
#undef PG8_SB
#undef PG8_STAGE
#undef PG8_LDA
#undef PG8_LDB
#undef PG8_MMA
#undef PG8_WAIT_V
#undef PG8_WAIT_L
#undef PG8_BAR
#undef PG8_SCHED
}
}

namespace att {
#define LAS3 __attribute__((address_space(3)))
typedef unsigned short bf16_t;
using bf16x8 = __attribute__((ext_vector_type(8))) short;
using s16x4 = __attribute__((ext_vector_type(4))) short;
using f32x16 = __attribute__((ext_vector_type(16))) float;
using f32x4 = __attribute__((ext_vector_type(4))) float;
using u32x4 = __attribute__((ext_vector_type(4))) unsigned;
using u32x2 = __attribute__((ext_vector_type(2))) unsigned;
constexpr int SEQ = 8192, DM = 1024, KVB = 64, SLOTB = 8192;
constexpr int NS = 4;
constexpr int L_K = 0, L_V = NS * SLOTB, L_F = 2 * NS * SLOTB, L_FB = L_F + NS * 1024, L_OST = L_FB + 1024, OSTW = 4608, L_FLAG = 126976, L_END = L_FLAG + 128;
constexpr float C2 = 0.125f * 1.4426950408889634f;

__device__ __forceinline__ void glds16(const void* gsrc, unsigned lds_dst) { unsigned keep;
    asm volatile("s_mov_b32 %0, m0\n\ts_mov_b32 m0, %2\n\ts_nop 0\n\tglobal_load_lds_dwordx4 %1, off\n\ts_mov_b32 m0, %0" : "=&s"(keep) : "v"(gsrc), "s"(lds_dst) : "memory"); }
typedef float f32x2_t __attribute__((ext_vector_type(2))); typedef __bf16 bf16x2_t __attribute__((ext_vector_type(2)));
__device__ __forceinline__ unsigned cvtpk(float lo, float hi) { f32x2_t v = {lo, hi}; bf16x2_t b = __builtin_convertvector(v, bf16x2_t); return __builtin_bit_cast(unsigned, b); }
#define ATT_WAIT_BAR() asm volatile("s_waitcnt vmcnt(0) lgkmcnt(0)\n\ts_barrier" ::: "memory")
#define ATT_WAIT_N(n) asm volatile("s_waitcnt vmcnt(" #n ") lgkmcnt(0)\n\ts_barrier" ::: "memory")
#define ATT_TILE_WAIT(jt, W0) do { if ((jt) >= 2) { if (W0) ATT_WAIT_N(6); else ATT_WAIT_N(4); } else if ((jt) == 1) { if (W0) ATT_WAIT_N(3); else ATT_WAIT_N(2); } else ATT_WAIT_N(0); } while (0)
typedef short v4i16_t __attribute__((ext_vector_type(4)));
__device__ __forceinline__ s16x4 vtr(const LAS3 unsigned char* p) { return __builtin_bit_cast(s16x4, __builtin_amdgcn_ds_read_tr16_b64_v4i16((LAS3 v4i16_t*)p)); }
__device__ __forceinline__ float other_half(float v) {
    auto rr = __builtin_amdgcn_permlane32_swap(__float_as_uint(v), __float_as_uint(v), false, false);
    const unsigned a = rr[0], b = rr[1];
    return __uint_as_float(a == __float_as_uint(v) ? b : a);
}

template <bool SB>
__device__ __forceinline__ void attn_unit(int b, int hh, int qb, const bf16_t* Q, const bf16_t* __restrict__ K, const bf16_t* __restrict__ V, bf16_t* O,
                                          const float* __restrict__ F2, float* SS, LAS3 unsigned char* shm) {
    const int tid = threadIdx.x, lane = tid & 63, r32 = lane & 31, hi = lane >> 5; const int wid = __builtin_amdgcn_readfirstlane(tid >> 6);
    const long rowbase = (long)b * SEQ; const int q0 = qb * 256, qw0 = q0 + wid * 32;
    const bf16_t* Qw = Q + (rowbase + qw0) * DM + hh * 64;
    const bf16_t* Kh = K + rowbase * DM + hh * 64; const bf16_t* Vh = V + rowbase * DM + hh * 64;
    const unsigned lds0 = (unsigned)(uintptr_t)shm;
    const bf16_t* ksrc = Kh + (long)lane * DM + wid * 8;
    const bf16_t* vsrc = Vh + (long)(16 * (wid & 3) + (lane >> 2)) * DM + (wid >> 2) * 32 + (lane & 3) * 8;
    const unsigned kdst = lds0 + L_K + wid * 1024, vdst = lds0 + L_V + wid * 1024;
#define ATT_DMA(t, slotoff) do { glds16(ksrc + (long)(t) * KVB * DM, (unsigned)__builtin_amdgcn_readfirstlane(kdst + (slotoff))); \
                                 glds16(vsrc + (long)(t) * KVB * DM, (unsigned)__builtin_amdgcn_readfirstlane(vdst + (slotoff))); } while (0)
    const int NT = 4 * qb + 4;
    ATT_DMA(NT - 1, ((NT - 1) & 3) * SLOTB); ATT_DMA(NT - 2, ((NT - 2) & 3) * SLOTB); ATT_DMA(NT - 3, ((NT - 3) & 3) * SLOTB);
    bf16x8 qr[4];
#pragma unroll
    for (int d0 = 0; d0 < 4; ++d0) qr[d0] = *reinterpret_cast<const bf16x8*>(Qw + (long)r32 * DM + d0 * 16 + hi * 8);
    LAS3 float* F2s = (LAS3 float*)(shm + L_F);
    float ft2 = 0.f;
    if (!SB) { const float* Frow = F2 + (long)(b * 8 + hh) * SEQ;
        for (int i = tid; i < (q0 + 256) / 4; i += 512) ((LAS3 f32x4*)F2s)[i] = ((const f32x4*)Frow)[i];
        ft2 = Frow[qw0 + r32]; }
    f32x16 o0, o1;
#pragma unroll
    for (int r = 0; r < 16; ++r) { o0[r] = 0.f; o1[r] = 0.f; }
    float mrun = -INFINITY, lrun = 0.f, carry = 1.f;
    volatile LAS3 unsigned* flags = (volatile LAS3 unsigned*)(shm + L_FLAG);
    const LAS3 unsigned char* kp0 = shm + L_K + hi * 1024 + r32 * 16;
    const LAS3 unsigned char* vp0 = shm + L_V + ((lane >> 4) & 1) * 32 + (lane & 3) * 8 + (4 * hi + ((lane & 15) >> 2)) * 64;
    asm volatile("" :: "v"(qr[0]), "v"(qr[1]), "v"(qr[2]), "v"(qr[3]));
    for (int jt = NT - 1; jt >= 0; --jt) {
        const int slot = jt & 3;
        ATT_TILE_WAIT(jt, false);
        if (SB && jt < NT - 1) { unsigned a = 0;
#pragma unroll
            for (int w = 0; w < 8; ++w) a |= flags[((jt + 1) & 1) * 8 + w];
            if (__builtin_amdgcn_readfirstlane(a) == 0u) break; }
        if (jt >= 3) ATT_DMA(jt - 3, ((jt - 3) & 3) * SLOTB);
        if (64 * jt <= qw0 + 31) {
            const LAS3 unsigned char* kp = kp0 + slot * SLOTB;
            f32x16 p0, p1;
#pragma unroll
            for (int r = 0; r < 16; ++r) { p0[r] = 0.f; p1[r] = 0.f; }
#pragma unroll
            for (int d0 = 0; d0 < 4; ++d0) {
                const bf16x8 k0 = *(const LAS3 bf16x8*)(kp + d0 * 2048), k1 = *(const LAS3 bf16x8*)(kp + d0 * 2048 + 512);
                p0 = __builtin_amdgcn_mfma_f32_32x32x16_bf16(k0, qr[d0], p0, 0, 0, 0);
                p1 = __builtin_amdgcn_mfma_f32_32x32x16_bf16(k1, qr[d0], p1, 0, 0, 0);
            }
            const bool diag = (64 * jt + 63 > qw0 - (SB ? 1 : 0));
            const int kb_ = 64 * jt + 4 * hi - (qw0 + r32);
            if (!SB) {
                const LAS3 float* fsp = F2s + 64 * jt + 4 * hi;
#pragma unroll
                for (int g = 0; g < 4; ++g) { const f32x4 fa = *(const LAS3 f32x4*)(fsp + 8 * g), fb = *(const LAS3 f32x4*)(fsp + 32 + 8 * g);
#pragma unroll
                    for (int i = 0; i < 4; ++i) { p0[4 * g + i] += (ft2 - fa[i]); p1[4 * g + i] += (ft2 - fb[i]); } }
                if (diag) {
#pragma unroll
                    for (int r = 0; r < 16; ++r) { const int cr = (r & 3) + 8 * (r >> 2); if (kb_ + cr > 0) p0[r] = -INFINITY; if (kb_ + cr + 32 > 0) p1[r] = -INFINITY; } }
                float mx = fmaxf(p0[0], p1[0]);
#pragma unroll
                for (int r = 1; r < 16; ++r) mx = fmaxf(mx, fmaxf(p0[r], p1[r]));
                mx = fmaxf(mx, other_half(mx));
                const float mnew = fmaxf(mrun, mx);
                if (__any(mnew > mrun)) { const float alpha = __builtin_amdgcn_exp2f(mrun - mnew); lrun *= alpha;
#pragma unroll
                    for (int r = 0; r < 16; ++r) { o0[r] *= alpha; o1[r] *= alpha; }
                    mrun = mnew; }
                float ls = 0.f;
#pragma unroll
                for (int r = 0; r < 16; ++r) { p0[r] = __builtin_amdgcn_exp2f(p0[r] - mrun); p1[r] = __builtin_amdgcn_exp2f(p1[r] - mrun); ls += p0[r] + p1[r]; }
                lrun += ls;
            } else {
#pragma unroll
                for (int r = 0; r < 16; ++r) { p0[r] = __builtin_amdgcn_rcpf(1.0f + __builtin_amdgcn_exp2f(p0[r])); p1[r] = __builtin_amdgcn_rcpf(1.0f + __builtin_amdgcn_exp2f(p1[r])); }
                if (diag) {
#pragma unroll
                    for (int r = 0; r < 16; ++r) { const int cr = (r & 3) + 8 * (r >> 2); if (kb_ + cr >= 0) p0[r] = 1.0f; if (kb_ + cr + 32 >= 0) p1[r] = 1.0f; } }
                float PP0[4], PP1[4], H0[4], H1[4];
#pragma unroll
                for (int g = 0; g < 4; ++g) { const float g0 = (p0[4 * g] * p0[4 * g + 1]) * (p0[4 * g + 2] * p0[4 * g + 3]), g1 = (p1[4 * g] * p1[4 * g + 1]) * (p1[4 * g + 2] * p1[4 * g + 3]);
                    const float t0 = other_half(g0), t1 = other_half(g1); PP0[g] = g0 * t0; PP1[g] = g1 * t1; H0[g] = hi ? 1.0f : t0; H1[g] = hi ? 1.0f : t1; }
                float T0[4], T1[4];
                T1[3] = carry; T1[2] = T1[3] * PP1[3]; T1[1] = T1[2] * PP1[2]; T1[0] = T1[1] * PP1[1]; const float tot1 = T1[0] * PP1[0];
                T0[3] = tot1; T0[2] = T0[3] * PP0[3]; T0[1] = T0[2] * PP0[2]; T0[0] = T0[1] * PP0[1]; carry = T0[0] * PP0[0];
#pragma unroll
                for (int g = 0; g < 4; ++g) {
                    { const float x3 = T0[g] * H0[g], x2 = x3 * p0[4 * g + 3], x1 = x2 * p0[4 * g + 2], x0 = x1 * p0[4 * g + 1];
                      p0[4 * g + 3] = fmaf(-p0[4 * g + 3], x3, x3); p0[4 * g + 2] = fmaf(-p0[4 * g + 2], x2, x2); p0[4 * g + 1] = fmaf(-p0[4 * g + 1], x1, x1); p0[4 * g] = fmaf(-p0[4 * g], x0, x0); }
                    { const float x3 = T1[g] * H1[g], x2 = x3 * p1[4 * g + 3], x1 = x2 * p1[4 * g + 2], x0 = x1 * p1[4 * g + 1];
                      p1[4 * g + 3] = fmaf(-p1[4 * g + 3], x3, x3); p1[4 * g + 2] = fmaf(-p1[4 * g + 2], x2, x2); p1[4 * g + 1] = fmaf(-p1[4 * g + 1], x1, x1); p1[4 * g] = fmaf(-p1[4 * g], x0, x0); }
                }
            }
            u32x4 pw[4];
#pragma unroll
            for (int i = 0; i < 4; ++i) { pw[0][i] = cvtpk(p0[2 * i], p0[2 * i + 1]); pw[1][i] = cvtpk(p0[8 + 2 * i], p0[8 + 2 * i + 1]); pw[2][i] = cvtpk(p1[2 * i], p1[2 * i + 1]); pw[3][i] = cvtpk(p1[8 + 2 * i], p1[8 + 2 * i + 1]); }
            const LAS3 unsigned char* vp = vp0 + slot * SLOTB;
#pragma unroll
            for (int ks = 0; ks < 4; ++ks) {
                const s16x4 l0 = vtr(vp + ks * 1024), h0 = vtr(vp + ks * 1024 + 512), l1 = vtr(vp + 4096 + ks * 1024), h1 = vtr(vp + 4096 + ks * 1024 + 512);
                const bf16x8 v0 = (bf16x8){l0[0], l0[1], l0[2], l0[3], h0[0], h0[1], h0[2], h0[3]}, v1 = (bf16x8){l1[0], l1[1], l1[2], l1[3], h1[0], h1[1], h1[2], h1[3]};
                const bf16x8 pf = __builtin_bit_cast(bf16x8, pw[ks]);
                o0 = __builtin_amdgcn_mfma_f32_32x32x16_bf16(v0, pf, o0, 0, 0, 0);
                o1 = __builtin_amdgcn_mfma_f32_32x32x16_bf16(v1, pf, o1, 0, 0, 0);
            }
        }
        if (SB) { const bool alive = __any(carry != 0.f) != 0; if (lane == 0) flags[(jt & 1) * 8 + wid] = alive ? 1u : 0u; }
    }
    if (!SB) { lrun += other_half(lrun); const float inv = 1.0f / lrun;
#pragma unroll
        for (int r = 0; r < 16; ++r) { o0[r] *= inv; o1[r] *= inv; } }
    float sq = 0.f;
#pragma unroll
    for (int r = 0; r < 16; ++r) sq += o0[r] * o0[r] + o1[r] * o1[r];
    sq += other_half(sq);
    if (hi == 0) SS[(size_t)(rowbase + qw0 + r32) * 16 + hh] = sq;
    LAS3 unsigned char* stg = shm + L_OST + wid * OSTW;
#pragma unroll
    for (int g = 0; g < 4; ++g) {
        u32x2 w0; w0.x = cvtpk(o0[4 * g], o0[4 * g + 1]); w0.y = cvtpk(o0[4 * g + 2], o0[4 * g + 3]);
        u32x2 w1; w1.x = cvtpk(o1[4 * g], o1[4 * g + 1]); w1.y = cvtpk(o1[4 * g + 2], o1[4 * g + 3]);
        *(LAS3 u32x2*)(stg + r32 * 144 + g * 16 + hi * 8) = w0;
        *(LAS3 u32x2*)(stg + r32 * 144 + 64 + g * 16 + hi * 8) = w1;
    }
    asm volatile("s_waitcnt lgkmcnt(0)" ::: "memory");
    bf16_t* Ow = O + (rowbase + qw0) * DM + hh * 64;
#pragma unroll
    for (int i = 0; i < 4; ++i) { const int row = i * 8 + (lane >> 3), ch = lane & 7; const u32x4 v = *(const LAS3 u32x4*)(stg + row * 144 + ch * 16); *(u32x4*)(Ow + (long)row * DM + ch * 8) = v; }
    ATT_WAIT_BAR();
#undef ATT_DMA
}
__device__ __forceinline__ float max3f(float a, float b, float c) { float r; asm("v_max3_f32 %0, %1, %2, %3" : "=v"(r) : "v"(a), "v"(b), "v"(c)); return r; }
__device__ __forceinline__ void fox_unit(int b, int hh, int qb, const bf16_t* Q, const bf16_t* __restrict__ K, const bf16_t* __restrict__ V, bf16_t* O,
                                         const float* __restrict__ F2, const bf16_t* __restrict__ FS3, const unsigned* __restrict__ KMAX, float* SS, LAS3 unsigned char* shm) {
    constexpr float THR = 8.0f;
    const int tid = threadIdx.x, lane = tid & 63, r32 = lane & 31, hi = lane >> 5; const int wid = __builtin_amdgcn_readfirstlane(tid >> 6);
    const long rowbase = (long)b * SEQ; const int q0 = qb * 256, qw0 = q0 + wid * 32;
    const bf16_t* Qw = Q + (rowbase + qw0) * DM + hh * 64;
    const bf16_t* Kh = K + rowbase * DM + hh * 64; const bf16_t* Vh = V + rowbase * DM + hh * 64;
    const unsigned lds0 = (unsigned)(uintptr_t)shm;
    const bf16_t* ksrc = Kh + (long)lane * DM + wid * 8;
    const bf16_t* vsrc = Vh + (long)(16 * (wid & 3) + (lane >> 2)) * DM + (wid >> 2) * 32 + (lane & 3) * 8;
    const bf16_t* fsrc = FS3 + ((long)(b * 8 + hh) * SEQ + lane) * 8;
    const float* Frow = F2 + (long)(b * 8 + hh) * SEQ;
    const unsigned kdst = lds0 + L_K + wid * 1024, vdst = lds0 + L_V + wid * 1024, fdst = lds0 + L_F;
#define FOX_DMA(t, s_) do { glds16(ksrc + (long)(t) * KVB * DM, (unsigned)__builtin_amdgcn_readfirstlane(kdst + (s_) * SLOTB)); \
                            glds16(vsrc + (long)(t) * KVB * DM, (unsigned)__builtin_amdgcn_readfirstlane(vdst + (s_) * SLOTB)); \
                            if (wid == 0) glds16(fsrc + (long)(t) * KVB * 8, (unsigned)__builtin_amdgcn_readfirstlane(fdst + (s_) * 1024)); } while (0)
    const int NT = 4 * qb + 4;
    FOX_DMA(NT - 1, (NT - 1) & 3); FOX_DMA(NT - 2, (NT - 2) & 3);
    LAS3 float* F2b = (LAS3 float*)(shm + L_FB);
    for (int i = 1 + tid; i < NT; i += 512) F2b[i] = F2[(long)(b * 8 + hh) * SEQ + 64 * i - 1];
    bf16x8 qr[4]; float qn2 = 0.f;
#pragma unroll
    for (int d0 = 0; d0 < 4; ++d0) { qr[d0] = *reinterpret_cast<const bf16x8*>(Qw + (long)r32 * DM + d0 * 16 + hi * 8);
#pragma unroll
        for (int j = 0; j < 8; ++j) { const float f = __builtin_bit_cast(float, (unsigned)(unsigned short)qr[d0][j] << 16); qn2 += f * f; } }
    qn2 += other_half(qn2);
    const float kn = sqrtf(2.0f * __uint_as_float(KMAX[b * 8 + hh])) * 1.01f;
    const float zq = sqrtf(qn2) * kn * 1.01f + 1.0f;
    const float ft2 = Frow[qw0 + r32];
    const short one = (short)0x3F80;
    const bf16x8 onesA = (bf16x8){one, one, one, one, one, one, one, one};
    const bf16x8 qones = hi ? (bf16x8){0, 0, 0, 0, 0, 0, 0, 0} : (bf16x8){one, one, one, 0, 0, 0, 0, 0};
    f32x16 o0, o1, lacc, cinit;
#pragma unroll
    for (int r = 0; r < 16; ++r) { o0[r] = 0.f; o1[r] = 0.f; lacc[r] = 0.f; cinit[r] = ft2 - fminf(zq, 60.0f); }
    const float mref = fminf(zq, 60.0f);
    volatile LAS3 unsigned* flags = (volatile LAS3 unsigned*)(shm + L_FLAG);
    const LAS3 unsigned char* kp0 = shm + L_K + hi * 1024 + r32 * 16;
    const LAS3 unsigned char* vp0 = shm + L_V + ((lane >> 4) & 1) * 32 + (lane & 3) * 8 + (4 * hi + ((lane & 15) >> 2)) * 64;
    const LAS3 unsigned char* fp0 = shm + L_F + r32 * 16;
    bool walive = true;
    for (int jp = NT / 2 - 1; jp >= 0; --jp) {
        ATT_WAIT_BAR();
        if (jp < NT / 2 - 1) { unsigned a = 0;
#pragma unroll
            for (int w = 0; w < 8; ++w) a |= flags[((jp + 1) & 1) * 8 + w];
            if (__builtin_amdgcn_readfirstlane(a) == 0u) break; }
        if (jp >= 1) { FOX_DMA(2 * jp - 1, (2 * jp - 1) & 3); FOX_DMA(2 * jp - 2, (2 * jp - 2) & 3); }
#pragma unroll
      for (int sub = 1; sub >= 0; --sub) { const int jt = 2 * jp + sub; const int slot = jt & 3;
        if (64 * jt <= qw0 + 31 && walive) {
            const LAS3 unsigned char* kp = kp0 + slot * SLOTB; const LAS3 unsigned char* fp = fp0 + slot * 1024;
            asm volatile("" : "+v"(cinit));
            f32x16 p0 = __builtin_amdgcn_mfma_f32_32x32x16_bf16(*(const LAS3 bf16x8*)(fp), qones, cinit, 0, 0, 0);
            f32x16 p1 = __builtin_amdgcn_mfma_f32_32x32x16_bf16(*(const LAS3 bf16x8*)(fp + 512), qones, cinit, 0, 0, 0);
#pragma unroll
            for (int d0 = 0; d0 < 4; ++d0) {
                const bf16x8 k0 = *(const LAS3 bf16x8*)(kp + d0 * 2048), k1 = *(const LAS3 bf16x8*)(kp + d0 * 2048 + 512);
                p0 = __builtin_amdgcn_mfma_f32_32x32x16_bf16(k0, qr[d0], p0, 0, 0, 0);
                p1 = __builtin_amdgcn_mfma_f32_32x32x16_bf16(k1, qr[d0], p1, 0, 0, 0);
            }
            if (64 * jt + 63 > qw0) { const int kb_ = 64 * jt + 4 * hi - (qw0 + r32);
#pragma unroll
                for (int r = 0; r < 16; ++r) { const int cr = (r & 3) + 8 * (r >> 2); if (kb_ + cr > 0) p0[r] = -INFINITY; if (kb_ + cr + 32 > 0) p1[r] = -INFINITY; } }
#pragma unroll
            for (int r = 0; r < 16; ++r) { p0[r] = __builtin_amdgcn_exp2f(p0[r]); p1[r] = __builtin_amdgcn_exp2f(p1[r]); }
            u32x4 pw[4];
#pragma unroll
            for (int i = 0; i < 4; ++i) { pw[0][i] = cvtpk(p0[2 * i], p0[2 * i + 1]); pw[1][i] = cvtpk(p0[8 + 2 * i], p0[8 + 2 * i + 1]); pw[2][i] = cvtpk(p1[2 * i], p1[2 * i + 1]); pw[3][i] = cvtpk(p1[8 + 2 * i], p1[8 + 2 * i + 1]); }
            const LAS3 unsigned char* vp = vp0 + slot * SLOTB;
#pragma unroll
            for (int ks = 0; ks < 4; ++ks) {
                const s16x4 l0 = vtr(vp + ks * 1024), h0 = vtr(vp + ks * 1024 + 512), l1 = vtr(vp + 4096 + ks * 1024), h1 = vtr(vp + 4096 + ks * 1024 + 512);
                const bf16x8 v0 = (bf16x8){l0[0], l0[1], l0[2], l0[3], h0[0], h0[1], h0[2], h0[3]}, v1 = (bf16x8){l1[0], l1[1], l1[2], l1[3], h1[0], h1[1], h1[2], h1[3]};
                const bf16x8 pf = __builtin_bit_cast(bf16x8, pw[ks]);
                o0 = __builtin_amdgcn_mfma_f32_32x32x16_bf16(v0, pf, o0, 0, 0, 0);
                o1 = __builtin_amdgcn_mfma_f32_32x32x16_bf16(v1, pf, o1, 0, 0, 0);
                lacc = __builtin_amdgcn_mfma_f32_32x32x16_bf16(onesA, pf, lacc, 0, 0, 0);
            }
        }
        {
            bool dead = false;
            if (jt > 0) { const float fn = F2b[jt]; dead = (zq + (ft2 - fn) - mref) < -160.0f; }
            walive = __any(!dead) != 0; }
      }
        if (lane == 0) flags[(jp & 1) * 8 + wid] = walive ? 1u : 0u;
    }
    { const float inv = 1.0f / lacc[0];
#pragma unroll
        for (int r = 0; r < 16; ++r) { o0[r] *= inv; o1[r] *= inv; } }
    float sq = 0.f;
#pragma unroll
    for (int r = 0; r < 16; ++r) sq += o0[r] * o0[r] + o1[r] * o1[r];
    sq += other_half(sq);
    if (hi == 0) SS[(size_t)(rowbase + qw0 + r32) * 16 + hh] = sq;
    LAS3 unsigned char* stg = shm + L_OST + wid * OSTW;
#pragma unroll
    for (int g = 0; g < 4; ++g) {
        u32x2 w0; w0.x = cvtpk(o0[4 * g], o0[4 * g + 1]); w0.y = cvtpk(o0[4 * g + 2], o0[4 * g + 3]);
        u32x2 w1; w1.x = cvtpk(o1[4 * g], o1[4 * g + 1]); w1.y = cvtpk(o1[4 * g + 2], o1[4 * g + 3]);
        *(LAS3 u32x2*)(stg + r32 * 144 + g * 16 + hi * 8) = w0;
        *(LAS3 u32x2*)(stg + r32 * 144 + 64 + g * 16 + hi * 8) = w1;
    }
    asm volatile("s_waitcnt lgkmcnt(0)" ::: "memory");
    bf16_t* Ow = O + (rowbase + qw0) * DM + hh * 64;
#pragma unroll
    for (int i = 0; i < 4; ++i) { const int row = i * 8 + (lane >> 3), ch = lane & 7; const u32x4 v = *(const LAS3 u32x4*)(stg + row * 144 + ch * 16); *(u32x4*)(Ow + (long)row * DM + ch * 8) = v; }
    ATT_WAIT_BAR();
#undef FOX_DMA
}

__device__ __forceinline__ void sb_tile(const LAS3 unsigned char* kp, const LAS3 unsigned char* vp, int jt, int qw0, int r32, int hi, const bf16x8 (&qr)[4], float& carry, f32x16& o0, f32x16& o1) {
    f32x16 p0, p1;
#pragma unroll
    for (int r = 0; r < 16; ++r) { p0[r] = 0.f; p1[r] = 0.f; }
#pragma unroll
    for (int d0 = 0; d0 < 4; ++d0) {
        const bf16x8 k0 = *(const LAS3 bf16x8*)(kp + d0 * 2048), k1 = *(const LAS3 bf16x8*)(kp + d0 * 2048 + 512);
        p0 = __builtin_amdgcn_mfma_f32_32x32x16_bf16(k0, qr[d0], p0, 0, 0, 0);
        p1 = __builtin_amdgcn_mfma_f32_32x32x16_bf16(k1, qr[d0], p1, 0, 0, 0);
    }
#pragma unroll
    for (int r = 0; r < 16; ++r) { p0[r] = __builtin_amdgcn_rcpf(1.0f + __builtin_amdgcn_exp2f(p0[r])); p1[r] = __builtin_amdgcn_rcpf(1.0f + __builtin_amdgcn_exp2f(p1[r])); }
    if (64 * jt + 63 > qw0 - 1) { const int kb_ = 64 * jt + 4 * hi - (qw0 + r32);
#pragma unroll
        for (int r = 0; r < 16; ++r) { const int cr = (r & 3) + 8 * (r >> 2); if (kb_ + cr >= 0) p0[r] = 1.0f; if (kb_ + cr + 32 >= 0) p1[r] = 1.0f; } }
    float PP0[4], PP1[4], H0[4], H1[4];
#pragma unroll
    for (int g = 0; g < 4; ++g) { const float g0 = (p0[4 * g] * p0[4 * g + 1]) * (p0[4 * g + 2] * p0[4 * g + 3]), g1 = (p1[4 * g] * p1[4 * g + 1]) * (p1[4 * g + 2] * p1[4 * g + 3]);
        const float t0 = other_half(g0), t1 = other_half(g1); PP0[g] = g0 * t0; PP1[g] = g1 * t1; H0[g] = hi ? 1.0f : t0; H1[g] = hi ? 1.0f : t1; }
    float T0[4], T1[4];
    T1[3] = carry; T1[2] = T1[3] * PP1[3]; T1[1] = T1[2] * PP1[2]; T1[0] = T1[1] * PP1[1]; const float tot1 = T1[0] * PP1[0];
    T0[3] = tot1; T0[2] = T0[3] * PP0[3]; T0[1] = T0[2] * PP0[2]; T0[0] = T0[1] * PP0[1]; carry = T0[0] * PP0[0];
#pragma unroll
    for (int g = 0; g < 4; ++g) {
        { const float x3 = T0[g] * H0[g], x2 = x3 * p0[4 * g + 3], x1 = x2 * p0[4 * g + 2], x0 = x1 * p0[4 * g + 1];
          p0[4 * g + 3] = fmaf(-p0[4 * g + 3], x3, x3); p0[4 * g + 2] = fmaf(-p0[4 * g + 2], x2, x2); p0[4 * g + 1] = fmaf(-p0[4 * g + 1], x1, x1); p0[4 * g] = fmaf(-p0[4 * g], x0, x0); }
        { const float x3 = T1[g] * H1[g], x2 = x3 * p1[4 * g + 3], x1 = x2 * p1[4 * g + 2], x0 = x1 * p1[4 * g + 1];
          p1[4 * g + 3] = fmaf(-p1[4 * g + 3], x3, x3); p1[4 * g + 2] = fmaf(-p1[4 * g + 2], x2, x2); p1[4 * g + 1] = fmaf(-p1[4 * g + 1], x1, x1); p1[4 * g] = fmaf(-p1[4 * g], x0, x0); }
    }
    u32x4 pw[4];
#pragma unroll
    for (int i = 0; i < 4; ++i) { pw[0][i] = cvtpk(p0[2 * i], p0[2 * i + 1]); pw[1][i] = cvtpk(p0[8 + 2 * i], p0[8 + 2 * i + 1]); pw[2][i] = cvtpk(p1[2 * i], p1[2 * i + 1]); pw[3][i] = cvtpk(p1[8 + 2 * i], p1[8 + 2 * i + 1]); }
#pragma unroll
    for (int ks = 0; ks < 4; ++ks) {
        const s16x4 l0 = vtr(vp + ks * 1024), h0 = vtr(vp + ks * 1024 + 512), l1 = vtr(vp + 4096 + ks * 1024), h1 = vtr(vp + 4096 + ks * 1024 + 512);
        const bf16x8 v0 = (bf16x8){l0[0], l0[1], l0[2], l0[3], h0[0], h0[1], h0[2], h0[3]}, v1 = (bf16x8){l1[0], l1[1], l1[2], l1[3], h1[0], h1[1], h1[2], h1[3]};
        const bf16x8 pf = __builtin_bit_cast(bf16x8, pw[ks]);
        o0 = __builtin_amdgcn_mfma_f32_32x32x16_bf16(v0, pf, o0, 0, 0, 0);
        o1 = __builtin_amdgcn_mfma_f32_32x32x16_bf16(v1, pf, o1, 0, 0, 0);
    }
}
__device__ __forceinline__ void sb_unit(int b, int hh, int qb, const bf16_t* Q, const bf16_t* __restrict__ K, const bf16_t* __restrict__ V, bf16_t* O, float* SS, LAS3 unsigned char* shm) {
    constexpr int WV = 7 * SLOTB;
    const int tid = threadIdx.x, lane = tid & 63, r32 = lane & 31, hi = lane >> 5; const int wid = __builtin_amdgcn_readfirstlane(tid >> 6);
    const long rowbase = (long)b * SEQ; const int q0 = qb * 256, qw0 = q0 + wid * 32;
    const bf16_t* Qw = Q + (rowbase + qw0) * DM + hh * 64;
    const bf16_t* Kh = K + rowbase * DM + hh * 64; const bf16_t* Vh = V + rowbase * DM + hh * 64;
    const unsigned lds0 = (unsigned)(uintptr_t)shm;
    const bf16_t* ksrc = Kh + (long)lane * DM + wid * 8;
    const bf16_t* vsrc = Vh + (long)(16 * (wid & 3) + (lane >> 2)) * DM + (wid >> 2) * 32 + (lane & 3) * 8;
    const int T_hi = 4 * qb + 3, T_lo = (4 * qb - 3 > 0) ? 4 * qb - 3 : 0;
    for (int t = T_hi; t >= T_lo; --t) { glds16(ksrc + (long)t * KVB * DM, (unsigned)__builtin_amdgcn_readfirstlane(lds0 + (t - T_lo) * SLOTB + wid * 1024));
                                         glds16(vsrc + (long)t * KVB * DM, (unsigned)__builtin_amdgcn_readfirstlane(lds0 + WV + (t - T_lo) * SLOTB + wid * 1024)); }
    bf16x8 qr[4];
#pragma unroll
    for (int d0 = 0; d0 < 4; ++d0) qr[d0] = *reinterpret_cast<const bf16x8*>(Qw + (long)r32 * DM + d0 * 16 + hi * 8);
    f32x16 o0, o1;
#pragma unroll
    for (int r = 0; r < 16; ++r) { o0[r] = 0.f; o1[r] = 0.f; }
    float carry = 1.f;
    const int kl = hi * 1024 + r32 * 16, vl = ((lane >> 4) & 1) * 32 + (lane & 3) * 8 + (4 * hi + ((lane & 15) >> 2)) * 64;
    volatile LAS3 unsigned char* fbytes = (volatile LAS3 unsigned char*)(shm + L_FLAG);
    asm volatile("" :: "v"(qr[0]), "v"(qr[1]), "v"(qr[2]), "v"(qr[3]));
    ATT_WAIT_BAR();
    for (int jt = (qw0 + 31) >> 6; jt >= T_lo; --jt) {
        sb_tile(shm + (jt - T_lo) * SLOTB + kl, shm + WV + (jt - T_lo) * SLOTB + vl, jt, qw0, r32, hi, qr, carry, o0, o1);
        if (!__any(carry != 0.f)) break;
    }
    bool more = false;
    if (T_lo > 0) {
        const bool alive = __any(carry != 0.f) != 0; if (lane == 0) fbytes[16 + wid] = alive ? (unsigned char)1 : (unsigned char)0;
        ATT_WAIT_BAR();
        const unsigned long long a8 = *(volatile LAS3 unsigned long long*)(shm + L_FLAG + 16);
        more = __builtin_amdgcn_readfirstlane((unsigned)a8 | (unsigned)(a8 >> 32)) != 0u;
    }
    if (more) {
        const unsigned kdst = lds0 + L_K + wid * 1024, vdst = lds0 + L_V + wid * 1024;
#define SB_DMA(t) do { glds16(ksrc + (long)(t) * KVB * DM, (unsigned)__builtin_amdgcn_readfirstlane(kdst + ((t) & 3) * SLOTB)); \
                       glds16(vsrc + (long)(t) * KVB * DM, (unsigned)__builtin_amdgcn_readfirstlane(vdst + ((t) & 3) * SLOTB)); } while (0)
        SB_DMA(T_lo - 1); if (T_lo >= 2) SB_DMA(T_lo - 2); if (T_lo >= 3) SB_DMA(T_lo - 3);
        bool walive = true;
        for (int jt = T_lo - 1; jt >= 0; --jt) {
            ATT_TILE_WAIT(jt, false);
            if (jt < T_lo - 1) { const unsigned long long a8 = *(volatile LAS3 unsigned long long*)(shm + L_FLAG + ((jt + 1) & 1) * 8);
                if (__builtin_amdgcn_readfirstlane((unsigned)a8 | (unsigned)(a8 >> 32)) == 0u) break; }
            if (jt >= 3) SB_DMA(jt - 3);
            if (walive) sb_tile(shm + L_K + (jt & 3) * SLOTB + kl, shm + L_V + (jt & 3) * SLOTB + vl, jt, qw0, r32, hi, qr, carry, o0, o1);
            walive = __any(carry != 0.f) != 0; if (lane == 0) fbytes[(jt & 1) * 8 + wid] = walive ? (unsigned char)1 : (unsigned char)0;
        }
#undef SB_DMA
    }
    ATT_WAIT_BAR();
    float sq = 0.f;
#pragma unroll
    for (int r = 0; r < 16; ++r) sq += o0[r] * o0[r] + o1[r] * o1[r];
    sq += other_half(sq);
    if (hi == 0) SS[(size_t)(rowbase + qw0 + r32) * 16 + hh] = sq;
    LAS3 unsigned char* stg = shm + L_OST + wid * OSTW;
#pragma unroll
    for (int g = 0; g < 4; ++g) {
        u32x2 w0; w0.x = cvtpk(o0[4 * g], o0[4 * g + 1]); w0.y = cvtpk(o0[4 * g + 2], o0[4 * g + 3]);
        u32x2 w1; w1.x = cvtpk(o1[4 * g], o1[4 * g + 1]); w1.y = cvtpk(o1[4 * g + 2], o1[4 * g + 3]);
        *(LAS3 u32x2*)(stg + r32 * 144 + g * 16 + hi * 8) = w0;
        *(LAS3 u32x2*)(stg + r32 * 144 + 64 + g * 16 + hi * 8) = w1;
    }
    asm volatile("s_waitcnt lgkmcnt(0)" ::: "memory");
    bf16_t* Ow = O + (rowbase + qw0) * DM + hh * 64;
#pragma unroll
    for (int i = 0; i < 4; ++i) { const int row = i * 8 + (lane >> 3), ch = lane & 7; const u32x4 v = *(const LAS3 u32x4*)(stg + row * 144 + ch * 16); *(u32x4*)(Ow + (long)row * DM + ch * 8) = v; }
    ATT_WAIT_BAR();
}
}

constexpr int NWAVES = 8;
constexpr int BATCH = 4, SEQ = 8192, DMODEL = 1024, MROWS = BATCH * SEQ, DFF = 2816, NUP = 2 * DFF, INC = 3080;
constexpr float RMS_EPS = 1e-6f, LOG2E = 1.4426950408889634f;
constexpr size_t MiB = 1u << 20;
constexpr size_t WS_WIN = 1 * MiB, WS_WOUT = 7 * MiB, WS_WUP = 9 * MiB, WS_WDN = 20 * MiB;
constexpr size_t WS_LF = 26 * MiB, WS_F2 = 27 * MiB, WS_SS = 28 * MiB, WS_PS = 30 * MiB, WS_PS2 = 32 * MiB, WS_HALO = 34 * MiB;
constexpr size_t WS_XN = 48 * MiB;
constexpr size_t WS_Q = 112 * MiB, WS_K = 176 * MiB, WS_V = 240 * MiB, WS_O = 304 * MiB;
constexpr size_t WS_U = 112 * MiB;
constexpr size_t WS_FS3 = 464 * MiB;
constexpr size_t WS_CTL = 0;
constexpr size_t WS_END = 468 * MiB;
constexpr int RING_BYTES = 131072, LDS_BYTES = 147456;
static_assert(att::L_END <= RING_BYTES && att::L_OST + 8 * att::OSTW <= att::L_FLAG && 14 * att::SLOTB <= att::L_FLAG, "attention LDS map");

#define LAS __attribute__((address_space(3)))
typedef unsigned short bf16;
typedef unsigned v4u __attribute__((ext_vector_type(4)));
typedef float f32x4 __attribute__((ext_vector_type(4)));
__device__ __forceinline__ unsigned f2bf(float f) { unsigned u = __builtin_bit_cast(unsigned, f); return (u + 0x7fffu + ((u >> 16) & 1u)) >> 16; }
__device__ __forceinline__ unsigned pk2(float lo, float hi) { return f2bf(lo) | (f2bf(hi) << 16); }
__device__ __forceinline__ float bf2f(unsigned short h) { return __builtin_bit_cast(float, (unsigned)h << 16); }
__device__ __forceinline__ float wave_sum(float v) {
#pragma unroll
    for (int o = 1; o < 64; o <<= 1) v += __shfl_xor(v, o);
    return v;
}
#define LDS_WAIT() asm volatile("s_waitcnt lgkmcnt(0)" ::: "memory")

#define XB_TMO      128
#define XB_XCNT(j)  (256  + 64 * (j))
#define XB_XSUB(j)  (1280 + 64 * (j))
#define XB_XGEN(j)  (2304 + 64 * (j))
#define XB_TOP      3328
#define XB_TOPGEN   3392
#define XCD_BAR_WORDS 3456
#define XB_SPIN_CAP (1u << 18)

__device__ __forceinline__ unsigned xb_ld(unsigned* p)              { return __hip_atomic_load(p, __ATOMIC_RELAXED, __HIP_MEMORY_SCOPE_AGENT); }
__device__ __forceinline__ unsigned xb_add(unsigned* p, unsigned v) { return __hip_atomic_fetch_add(p, v, __ATOMIC_RELAXED, __HIP_MEMORY_SCOPE_AGENT); }
__device__ __forceinline__ unsigned xb_xcc_id() { return (unsigned)__builtin_amdgcn_s_getreg((3 << 11) | 20) & 0xFu; }
#define XB_SPIN(cond, bar) do { unsigned _sp = 0; while (cond) { __builtin_amdgcn_s_sleep(1); \
    if ((++_sp & 255u) == 0u) { if (xb_ld(&(bar)[XB_TMO])) break; if (_sp > XB_SPIN_CAP) { atomicAdd(&(bar)[XB_TMO], 1u); break; } } } } while (0)

struct XcdBarrier {
    unsigned* bar; unsigned x;
    volatile LAS unsigned* st;
};

__device__ __forceinline__ XcdBarrier xcd_barrier_post(unsigned* bar, volatile LAS unsigned* st) {
    XcdBarrier b; b.bar = bar; b.x = xb_xcc_id(); b.st = st;
    if (threadIdx.x == 0) (void)xb_add(&bar[XB_XCNT(b.x)], 1u);
    return b;
}
__device__ __forceinline__ void xcd_barrier_complete(unsigned* bar, unsigned x, unsigned& nloc, unsigned& nx) {
    const unsigned G = gridDim.x * gridDim.y * gridDim.z;
    unsigned sum, cnt, mine, sp = 0u;
    for (;;) {
        sum = 0u; cnt = 0u; mine = 0u;
#pragma unroll
        for (unsigned j = 0; j < 16; ++j) { const unsigned c = xb_ld(&bar[XB_XCNT(j)]); sum += c; cnt += (c > 0u) ? 1u : 0u; mine = (j == x) ? c : mine; }
        if (sum == G) break;
        __builtin_amdgcn_s_sleep(1);
        if ((++sp & 255u) == 0u) { if (xb_ld(&bar[XB_TMO])) break; if (sp > XB_SPIN_CAP) { atomicAdd(&bar[XB_TMO], 1u); break; } }
    }
    nloc = mine > 0u ? mine : 1u; nx = cnt > 0u ? cnt : 1u;
}

__device__ __forceinline__ void xcd_barrier(const XcdBarrier& b) {
    asm volatile("s_waitcnt vmcnt(0)" ::: "memory");
    __syncthreads();
    if (threadIdx.x == 0) {
        unsigned* bar = b.bar;
        __builtin_amdgcn_s_waitcnt(0);
        unsigned nloc = b.st[0], nx = b.st[1];
        if (nloc == 0u) { xcd_barrier_complete(bar, b.x, nloc, nx); b.st[0] = nloc; b.st[1] = nx; }
        const unsigned old = xb_add(&bar[XB_XSUB(b.x)], 1u);
        const unsigned gen = old / nloc;
        if (old + 1u == (gen + 1u) * nloc) {
            __builtin_amdgcn_fence(__ATOMIC_RELEASE, "agent");
            asm volatile("s_waitcnt vmcnt(0)" ::: "memory");
            const unsigned og = xb_add(&bar[XB_TOP], 1u);
            const unsigned tg = og / nx;
            if (og + 1u == (tg + 1u) * nx) xb_add(&bar[XB_TOPGEN], 1u);
            else XB_SPIN(xb_ld(&bar[XB_TOPGEN]) == tg, bar);
            __builtin_amdgcn_fence(__ATOMIC_ACQUIRE, "agent");
            xb_add(&bar[XB_XGEN(b.x)], 1u);
            asm volatile("s_waitcnt vmcnt(0)" ::: "memory");
        } else {
            XB_SPIN(xb_ld(&bar[XB_XGEN(b.x)]) == gen, bar);
            __builtin_amdgcn_fence(__ATOMIC_ACQUIRE, "agent");
            asm volatile("s_waitcnt vmcnt(0)" ::: "memory");
        }
    }
    __syncthreads();
}

struct Args { const float* in[13]; float* out; unsigned char* ws; int coop_sync; int pad; };

__device__ __forceinline__ void transpose_item(const float* W, int ldw, int K, int srccol0, bf16* WT, int dstrow0, const float* gain, LAS float* scr, int kb, int nb, int lane) {
    const int k0 = 64 * kb, n0 = 32 * nb;
#pragma unroll
    for (int i = 0; i < 32; ++i) { const int kk = 2 * i + (lane >> 5); float w = W[(size_t)(k0 + kk) * ldw + srccol0 + n0 + (lane & 31)]; if (gain) w *= gain[k0 + kk]; scr[kk * 33 + (lane & 31)] = w; }
    LDS_WAIT(); asm volatile("" ::: "memory");
    const int c = lane & 7;
#pragma unroll
    for (int j = 0; j < 4; ++j) { const int n = (lane >> 3) + 8 * j; const LAS float* s = scr + (8 * c) * 33 + n;
        v4u o; o.x = pk2(s[0 * 33], s[1 * 33]); o.y = pk2(s[2 * 33], s[3 * 33]); o.z = pk2(s[4 * 33], s[5 * 33]); o.w = pk2(s[6 * 33], s[7 * 33]);
        *(v4u*)(WT + (size_t)(dstrow0 + n0 + n) * K + k0 + 8 * c) = o; }
    LDS_WAIT(); asm volatile("" ::: "memory");
}

__device__ __forceinline__ float log_sigmoid(float y) { return fminf(y, 0.f) - log1pf(expf(-fabsf(y))); }

__global__ void __launch_bounds__(NWAVES * 64, 2) fwd_megakernel(Args args) {
    extern __shared__ __attribute__((aligned(16))) unsigned char lds_raw[];
    LAS unsigned char* lds = (LAS unsigned char*)lds_raw;
    const int tid = threadIdx.x, lane = tid & 63, wave = __builtin_amdgcn_readfirstlane(tid >> 6);
    const int G = gridDim.x; const int bx = blockIdx.x; const int vcu = (G % 8 == 0) ? (bx % 8) * (G / 8) + bx / 8 : bx;
    const float* x = args.in[0]; const float* attn_g = args.in[1]; const float* w_in = args.in[2]; const float* fbias = args.in[3];
    const float* fox_g = args.in[4]; const float* sb_g = args.in[5]; const float* w_out = args.in[6]; const float* ffn_g = args.in[7];
    const float* w_up = args.in[8]; const float* conv_w = args.in[9]; const float* conv_b = args.in[10]; const float* w_down = args.in[11]; const float* final_g = args.in[12];
    float* out = args.out; unsigned char* ws = args.ws;
    bf16* Win_t = (bf16*)(ws + WS_WIN); bf16* Wout_t = (bf16*)(ws + WS_WOUT); bf16* Wup_t = (bf16*)(ws + WS_WUP); bf16* Wdn_t = (bf16*)(ws + WS_WDN);
    float* LF = (float*)(ws + WS_LF); float* F2 = (float*)(ws + WS_F2); float* SS = (float*)(ws + WS_SS); float* PS = (float*)(ws + WS_PS); float* PS2 = (float*)(ws + WS_PS2);
    float* HALO4 = (float*)(ws + WS_HALO); bf16* XN = (bf16*)(ws + WS_XN); bf16* QB = (bf16*)(ws + WS_Q); bf16* KB = (bf16*)(ws + WS_K); bf16* VB = (bf16*)(ws + WS_V); bf16* OB = (bf16*)(ws + WS_O);
    bf16* UB = (bf16*)(ws + WS_U); bf16* FS3 = (bf16*)(ws + WS_FS3); unsigned* CTL = (unsigned*)(ws + WS_CTL);
    const int gw = vcu * NWAVES + wave, NGW = G * NWAVES;
    volatile LAS unsigned* xst = (volatile LAS unsigned*)(lds + LDS_BYTES - 16);
    if (tid == 0) { xst[0] = 0u; xst[1] = 0u; }
    unsigned* XBAR = (unsigned*)(ws + WS_CTL + 262144);
    __syncthreads();
    XcdBarrier xbar = xcd_barrier_post(XBAR, xst);

    {
        LAS float* scr = (LAS float*)(lds + wave * 16384);
        constexpr int I_IN = 16 * 96, I_OUT = 16 * 32, I_UP = 16 * 176, I_DN = 44 * 32, NITEMS = I_IN + I_OUT + I_UP + I_DN;
        for (int it = gw; it < NITEMS; it += NGW) {
            int r = it;
            if (r < I_IN) { const int kb = r / 96, nb = r % 96, seg = nb >> 4, nbs = nb & 15;
                const int srcc = (seg == 0) ? 0 : (seg == 1) ? 1544 : (seg == 2) ? 512 : (seg == 3) ? 2056 : (seg == 4) ? 1024 : 2568;
                transpose_item(w_in, INC, 1024, srcc, Win_t, seg * 512, nullptr, scr, kb, nbs, lane); continue; } r -= I_IN;
            if (r < I_OUT) { const int kb = r / 32, nb = r % 32; transpose_item(w_out, 1024, 1024, 0, Wout_t, 0, (kb < 8) ? fox_g : (sb_g - 512), scr, kb, nb, lane); continue; } r -= I_OUT;
            if (r < I_UP) { const int kb = r / 176, nb = r % 176, pn = nb >> 3, jb = nb & 7; const int srcc = (jb < 4) ? 128 * pn + 32 * jb : DFF + 128 * pn + 32 * (jb - 4);
                transpose_item(w_up, NUP, 1024, srcc - 32 * nb, Wup_t, 0, ffn_g, scr, kb, nb, lane); continue; } r -= I_UP;
            { const int kb = r / 32, nb = r % 32; transpose_item(w_down, 1024, DFF, 0, Wdn_t, 0, nullptr, scr, kb, nb, lane); }
        }
        __syncthreads();
        LAS float* Wf = (LAS float*)lds;
        for (int i = tid; i < 1024 * 8; i += NWAVES * 64) Wf[i] = w_in[(size_t)(i >> 3) * INC + 1536 + (i & 7)];
        __syncthreads();
        f32x4 gv[4];
#pragma unroll
        for (int j = 0; j < 4; ++j) gv[j] = ((const f32x4*)attn_g)[lane + 64 * j];
        f32x4 vn[4];
        if (gw < MROWS) { const f32x4* xr = (const f32x4*)(x + (size_t)gw * DMODEL) + lane;
#pragma unroll
            for (int j = 0; j < 4; ++j) vn[j] = xr[64 * j]; }
        for (int m = gw; m < MROWS; m += NGW) {
            f32x4 v[4]; float s2 = 0.f;
#pragma unroll
            for (int j = 0; j < 4; ++j) { v[j] = vn[j]; s2 += (v[j].x * v[j].x + v[j].y * v[j].y) + (v[j].z * v[j].z + v[j].w * v[j].w); }
            if (m + NGW < MROWS) { const f32x4* xr = (const f32x4*)(x + (size_t)(m + NGW) * DMODEL) + lane;
#pragma unroll
                for (int j = 0; j < 4; ++j) vn[j] = xr[64 * j]; }
            const float rstd = 1.0f / sqrtf(wave_sum(s2) * (1.0f / DMODEL) + RMS_EPS);
            unsigned long long* o8 = (unsigned long long*)(XN + (size_t)m * DMODEL) + lane;
            float fa[8];
#pragma unroll
            for (int e = 0; e < 8; ++e) fa[e] = 0.f;
#pragma unroll
            for (int j = 0; j < 4; ++j) { v[j] = v[j] * rstd * gv[j];
                o8[64 * j] = (unsigned long long)pk2(v[j].x, v[j].y) | ((unsigned long long)pk2(v[j].z, v[j].w) << 32);
#pragma unroll
                for (int i = 0; i < 4; ++i) { const int k = 256 * j + 4 * lane + i; const f32x4 wa = *(const LAS f32x4*)(Wf + k * 8), wb = *(const LAS f32x4*)(Wf + k * 8 + 4); const float hk = v[j][i];
                    fa[0] += hk * wa[0]; fa[1] += hk * wa[1]; fa[2] += hk * wa[2]; fa[3] += hk * wa[3]; fa[4] += hk * wb[0]; fa[5] += hk * wb[1]; fa[6] += hk * wb[2]; fa[7] += hk * wb[3]; } }
            float r4[4], r2[2], r1;
            { const bool h = (lane & 32) != 0;
#pragma unroll
              for (int e = 0; e < 4; ++e) { const float snd = h ? fa[e] : fa[e + 4], kp = h ? fa[e + 4] : fa[e]; r4[e] = kp + __shfl_xor(snd, 32); } }
            { const bool h = (lane & 16) != 0;
#pragma unroll
              for (int e = 0; e < 2; ++e) { const float snd = h ? r4[e] : r4[e + 2], kp = h ? r4[e + 2] : r4[e]; r2[e] = kp + __shfl_xor(snd, 16); } }
            { const bool h = (lane & 8) != 0; const float snd = h ? r2[0] : r2[1], kp = h ? r2[1] : r2[0]; r1 = kp + __shfl_xor(snd, 8); }
            r1 += __shfl_xor(r1, 4); r1 += __shfl_xor(r1, 2); r1 += __shfl_xor(r1, 1);
            if ((lane & 7) == 0) { const int e = lane >> 3; LF[(size_t)m * 8 + e] = log_sigmoid(r1 + fbias[e]); }
        }
    }
    xcd_barrier(xbar);

    {
        LAS float* wtot = (LAS float*)lds;
        for (int bh = bx; bh < 32; bh += G) {
            const int b = bh >> 3, h = bh & 7; const float* src = LF + ((size_t)b * SEQ) * 8 + h;
            float loc[16]; float s = 0.f;
#pragma unroll
            for (int i = 0; i < 16; ++i) { s += src[(size_t)(tid * 16 + i) * 8]; loc[i] = s; }
            float incl = s;
#pragma unroll
            for (int o = 1; o < 64; o <<= 1) { const float t = __shfl_up(incl, o); if (lane >= o) incl += t; }
            if (lane == 63) wtot[wave] = incl;
            __syncthreads();
            float base = incl - s;
            for (int w = 0; w < wave; ++w) base += wtot[w];
            float* dst = F2 + (size_t)bh * SEQ + tid * 16;
#pragma unroll
            for (int i = 0; i < 16; ++i) { const float f = (base + loc[i]) * LOG2E; dst[i] = f;
                const float nf = -f; const unsigned h1 = f2bf(nf); const float r1 = nf - __builtin_bit_cast(float, h1 << 16); const unsigned h2 = f2bf(r1); const float r2 = r1 - __builtin_bit_cast(float, h2 << 16); const unsigned h3 = f2bf(r2);
                v4u o; o.x = h1 | (h2 << 16); o.y = h3; o.z = 0u; o.w = 0u; *(v4u*)(FS3 + ((size_t)bh * SEQ + tid * 16 + i) * 8) = o; }
            __syncthreads();
        }
        pg8::Gemm g{XN, Win_t, MROWS, 3072, 1024, 1024}; pg8::StaticOrder S; S.init(MROWS, 3072, G, bx);
        pg8::EpiQKV E{QB, 1024, 1024, (size_t)(WS_K - WS_Q) / 2, att::C2, CTL + 64};
        pg8::gemm_phase<pg8::EpiQKV, pg8::StaticOrder, true, true>(lds, g, S, E);
    }
    xcd_barrier(xbar);

    {
        volatile LAS unsigned* qw = (volatile LAS unsigned*)(lds + att::L_FLAG + 64);
        for (;;) {
            if (tid == 0) qw[0] = atomicAdd(CTL, 1u);
            __syncthreads();
            const unsigned idx = qw[0];
            if (idx >= 2048u) break;
            if (idx < 1024u) { const int qb = 31 - (int)(idx >> 5), bh = (int)(idx & 31);
                att::fox_unit(bh >> 3, bh & 7, qb, QB, KB, VB, OB, F2, FS3, CTL + 64, SS, lds); }
            else { const int u = (int)idx - 1024, qb = 31 - (u >> 5), bh = u & 31;
                att::sb_unit(bh >> 3, 8 + (bh & 7), qb, QB, KB, VB, OB, SS, lds); }
        }
    }
    xcd_barrier(xbar);

    {
        pg8::Gemm g{OB, Wout_t, MROWS, 1024, 1024, 1024}; pg8::StaticOrder S; S.init(MROWS, 1024, G, bx);
        LAS float* tab = (LAS float*)(lds + RING_BYTES);
        { pg8::Unit u; for (int ui = 0; ui < 7 && S.next(ui, u); ++ui) if (tid < 256) {
              const float* p = SS + (size_t)(u.pm * 256 + tid) * 16;
              const f32x4 a = *(const f32x4*)p, b = *(const f32x4*)(p + 4), c = *(const f32x4*)(p + 8), d = *(const f32x4*)(p + 12);
              const float sf = ((a[0] + a[1]) + (a[2] + a[3])) + ((b[0] + b[1]) + (b[2] + b[3])), ss = ((c[0] + c[1]) + (c[2] + c[3])) + ((d[0] + d[1]) + (d[2] + d[3]));
              const float rf = 1.0f / sqrtf(sf * (1.0f / 512.0f) + RMS_EPS), rs = 1.0f / sqrtf(ss * (1.0f / 512.0f) + RMS_EPS);
              tab[(ui * 256 + tid) * 2] = rf / rs; tab[(ui * 256 + tid) * 2 + 1] = rs; }
          __syncthreads(); }
        pg8::EpiOut E{x, out, XN, tab, PS};
        pg8::gemm_phase<pg8::EpiOut, pg8::StaticOrder, true, true>(lds, g, S, E);
    }
    xcd_barrier(xbar);

    {
        pg8::Gemm g{XN, Wup_t, MROWS, NUP, 1024, 1024}; pg8::StaticOrder S; S.init(MROWS, NUP, G, bx);
        float* RSTD1 = (float*)(ws + WS_CTL + 65536);
        { pg8::Unit u; for (int ui = 0; S.next(ui, u); ++ui) if (tid < 256) { const int r = u.pm * 256 + tid; RSTD1[r] = __builtin_amdgcn_rsqf(pg8::sum16(PS + (size_t)r * 16) * (1.0f / 1024.0f) + RMS_EPS); }
          __syncthreads(); }
        pg8::EpiUpConv E{UB, RSTD1, HALO4, conv_w, conv_b, (LAS float*)(lds + RING_BYTES)};
        pg8::gemm_phase<pg8::EpiUpConv, pg8::StaticOrder, true, true>(lds, g, S, E);
    }
    xcd_barrier(xbar);

    {
        for (int idx = bx * (NWAVES * 64) + tid; idx < 128 * 2 * 704; idx += G * NWAVES * 64) {
            const int pm = idx / 1408, rem = idx % 1408, t = rem / 704, c4 = (rem % 704) * 4;
            const bool first = (pm & 31) == 0;
            const float* h0 = HALO4 + (size_t)(pm * 4) * 5632; const float* hp = HALO4 + (size_t)((first ? pm : pm - 1) * 4) * 5632;
            const f32x4 z = {0.f, 0.f, 0.f, 0.f};
            f32x4 ug[3], uv[3];
            ug[2] = *(const f32x4*)(h0 + t * 5632 + c4); uv[2] = *(const f32x4*)(h0 + t * 5632 + DFF + c4);
            if (t == 1) { ug[1] = *(const f32x4*)(h0 + c4); uv[1] = *(const f32x4*)(h0 + DFF + c4); } else { ug[1] = first ? z : *(const f32x4*)(hp + 3 * 5632 + c4); uv[1] = first ? z : *(const f32x4*)(hp + 3 * 5632 + DFF + c4); }
            { const int pr = (t == 1) ? 3 : 2; ug[0] = first ? z : *(const f32x4*)(hp + pr * 5632 + c4); uv[0] = first ? z : *(const f32x4*)(hp + pr * 5632 + DFF + c4); }
            f32x4 og = *(const f32x4*)(conv_b + c4), ov = *(const f32x4*)(conv_b + DFF + c4);
#pragma unroll
            for (int k = 0; k < 3; ++k) { og += *(const f32x4*)(conv_w + (size_t)k * NUP + c4) * ug[k]; ov += *(const f32x4*)(conv_w + (size_t)k * NUP + DFF + c4) * uv[k]; }
            float res[4];
#pragma unroll
            for (int i = 0; i < 4; ++i) res[i] = og[i] / (1.0f + __expf(-og[i])) * ov[i];
            unsigned long long o = (unsigned long long)pk2(res[0], res[1]) | ((unsigned long long)pk2(res[2], res[3]) << 32);
            *(unsigned long long*)(UB + (size_t)(pm * 256 + t) * DFF + c4) = o;
        }
    }
    xcd_barrier(xbar);

    {
        pg8::Gemm g{UB, Wdn_t, MROWS, 1024, DFF, DFF}; pg8::StaticOrder S; S.init(MROWS, 1024, G, bx);
        pg8::EpiDown E{out, out, PS2};
        pg8::gemm_phase<pg8::EpiDown, pg8::StaticOrder, true, true>(lds, g, S, E);
    }
    xcd_barrier(xbar);

    {
        int lane6 = threadIdx.x & 63; asm volatile("" : "+v"(lane6));
        f32x4 gv[4];
#pragma unroll
        for (int j = 0; j < 4; ++j) gv[j] = ((const f32x4*)final_g)[lane6 + 64 * j];
        for (int m = gw; m < MROWS; m += NGW) {
            const float rstd = 1.0f / sqrtf(pg8::sum16(PS2 + (size_t)m * 16) * (1.0f / DMODEL) + RMS_EPS);
            f32x4* xr = (f32x4*)(out + (size_t)m * DMODEL) + lane6;
#pragma unroll
            for (int j = 0; j < 4; ++j) { const f32x4 v = xr[64 * j]; xr[64 * j] = v * rstd * gv[j]; }
        }
    }
    if (args.coop_sync) cg::this_grid().sync();
}

extern "C" void kernel_launch(void* const* d_in, const int* in_sizes, int n_in, void* d_out, int out_size, void* d_ws, size_t ws_size, hipStream_t stream) {
    static int grid = 0;
    if (grid == 0) {
        if (n_in != 13 || ws_size < WS_END) { fprintf(stderr, "kernel_launch: unexpected inputs (n_in %d, ws %zu)\n", n_in, ws_size); grid = -1; return; }
        int dev = 0, cus = 0, per_cu = 0;
        hipGetDevice(&dev); hipDeviceGetAttribute(&cus, hipDeviceAttributeMultiprocessorCount, dev);
        hipFuncSetAttribute((const void*)fwd_megakernel, hipFuncAttributeMaxDynamicSharedMemorySize, LDS_BYTES);
        hipOccupancyMaxActiveBlocksPerMultiprocessor(&per_cu, (const void*)fwd_megakernel, NWAVES * 64, LDS_BYTES);
        (void)hipGetLastError();
        if (per_cu < 1) per_cu = 1;
        grid = cus * per_cu; if (grid > 256) grid = 256;
    }
    if (grid < 0) return;
    if (hipMemsetAsync((unsigned char*)d_ws + WS_CTL, 0, 262144 + 16384, stream) != hipSuccess) { fprintf(stderr, "kernel_launch: hipMemsetAsync failed\n"); return; }
    Args a{};
    for (int i = 0; i < 13; ++i) a.in[i] = (const float*)d_in[i];
    a.out = (float*)d_out; a.ws = (unsigned char*)d_ws;
    void* kargs[] = {&a};
    hipError_t e = hipLaunchCooperativeKernel((const void*)fwd_megakernel, dim3(grid), dim3(NWAVES * 64), kargs, LDS_BYTES, stream);
    if (e != hipSuccess) fprintf(stderr, "cooperative launch failed: %s (grid %d)\n", hipGetErrorString(e), grid);
}
```

```cpp
#include <hip/hip_runtime.h>
#include <hip/hip_cooperative_groups.h>
#include <cstdio>
#include <cstdint>
#include <cmath>
namespace cg = cooperative_groups;
namespace pg8 {
#define PG8_LAS __attribute__((address_space(3)))
typedef unsigned short bf16_t;
typedef short bf16x8 __attribute__((ext_vector_type(8)));
typedef float f32x4 __attribute__((ext_vector_type(4)));
typedef unsigned u32x4 __attribute__((ext_vector_type(4)));
constexpr int BM = 256, BK = 64, HALF = 128, HTB = HALF * BK * 2  , STAGE_BYTES = 8 * HTB, NXCD = 8, WGM = 8;

__host__ __device__ __forceinline__ int lds_byte(int r, int c) { const int st = (r >> 4) * 2 + (c >> 5), rr = r & 15, cc = c & 31, ob = rr * 64 + cc * 2; return st * 1024 + (ob ^ (((ob >> 9) & 1) << 5)); }
__host__ __device__ __forceinline__ void stage_rc(int b, int& R, int& C) { const int st = b / 1024, sb = b % 1024, swz = sb ^ (((sb >> 9) & 1) << 5); R = (st >> 1) * 16 + swz / 64; C = (st & 1) * 32 + (swz % 64) / 2; }
__host__ __device__ __forceinline__ int perm32(int rho) { const int n = rho >> 4, i = rho & 15; return 8 * (i >> 2) + 4 * n + (i & 3); }

struct Unit { int pm, pn, idx; };
struct Gemm { const bf16_t* A; const bf16_t* Bt; int M, N, K, lda; };

struct StaticOrder {
    int nM, nN, nwg, G, c;
    __host__ __device__ void init(int M, int N, int G_, int c_) { nM = M / BM; nN = N / BM; nwg = nM * nN; G = G_; c = c_; }
    __host__ __device__ bool next(int i, Unit& u) const {
        const long L = (long)i * G + c; if (L >= nwg) return false;
        int wgid = (int)L; { const int q = nwg / NXCD, r = nwg % NXCD, xcd = wgid % NXCD, off = wgid / NXCD; wgid = (xcd < r ? xcd * (q + 1) : r * (q + 1) + (xcd - r) * q) + off; }
        const int nig = WGM * nN, gid = wgid / nig, fm = gid * WGM, gsz = (nM - fm) < WGM ? (nM - fm) : WGM;
        u.pm = fm + ((wgid % nig) % gsz); u.pn = (wgid % nig) / gsz; u.idx = i; return true;
    }
    __device__ __forceinline__ void a_ready(const Unit&) const {}
    __device__ __forceinline__ void done(const Unit&) const {}
};

__device__ __forceinline__ unsigned cvt_pk_bf16(float lo, float hi) { unsigned r; asm volatile("v_cvt_pk_bf16_f32 %0, %1, %2" : "=v"(r) : "v"(lo), "v"(hi)); return r; }
typedef float f32x2 __attribute__((ext_vector_type(2)));

typedef unsigned u32x2 __attribute__((ext_vector_type(2)));
constexpr float RMS_EPS = 1e-6f;
__device__ __forceinline__ float sum16(const float* p) {
    const f32x4 a = *(const f32x4*)p, b = *(const f32x4*)(p + 4), c = *(const f32x4*)(p + 8), d = *(const f32x4*)(p + 12);
    return ((a[0] + a[1]) + (a[2] + a[3])) + ((b[0] + b[1]) + (b[2] + b[3])) + ((c[0] + c[1]) + (c[2] + c[3])) + ((d[0] + d[1]) + (d[2] + d[3]));
}

struct EpiQKV {
    static constexpr bool PERM = true, AFTER_DRAIN = false, HAS_MID = false;
    bf16_t* O; int ldc; int split_cols; size_t split_stride; float scale0; unsigned* kmax;
    __device__ __forceinline__ void operator()(f32x4 (&acc)[2][2][4][2], const Unit& u, int wr, int wc, int fr, int fq) const {
        const int row0 = u.pm * BM + wr * 64 + fr; int colt = u.pn * BM; bf16_t* base = O;
        float sc = 1.f; const int t = colt / split_cols; { base += (size_t)t * split_stride; colt -= t * split_cols; if (t == 0) sc = scale0; }
        const int col0 = colt + wc * 32 + 8 * fq;
        const bool knorm = (t == 1) && (colt < 512);
        float hm[2] = {0.f, 0.f};
#pragma unroll
        for (int ai = 0; ai < 2; ++ai)
#pragma unroll
            for (int m = 0; m < 4; ++m) { bf16_t* rowp = base + (size_t)(row0 + ai * HALF + m * 16) * ldc + col0;
#pragma unroll
                for (int bj = 0; bj < 2; ++bj) { f32x4 v0 = acc[ai][bj][m][0] * sc, v1 = acc[ai][bj][m][1] * sc;
                    u32x4 w; w.x = cvt_pk_bf16(v0[0], v0[1]); w.y = cvt_pk_bf16(v0[2], v0[3]); w.z = cvt_pk_bf16(v1[0], v1[1]); w.w = cvt_pk_bf16(v1[2], v1[3]);
                    *(u32x4*)(rowp + bj * HALF) = w;
                    if (knorm) { float s = ((v0[0] * v0[0] + v0[1] * v0[1]) + (v0[2] * v0[2] + v0[3] * v0[3])) + ((v1[0] * v1[0] + v1[1] * v1[1]) + (v1[2] * v1[2] + v1[3] * v1[3]));
                        s += __shfl_xor(s, 16); s += __shfl_xor(s, 32); hm[bj] = fmaxf(hm[bj], s); } } }
        if (knorm) {
#pragma unroll
            for (int o = 1; o < 16; o <<= 1) { hm[0] = fmaxf(hm[0], __shfl_xor(hm[0], o)); hm[1] = fmaxf(hm[1], __shfl_xor(hm[1], o)); }
            if (fr == 0 && fq == 0) { const int b = (u.pm * BM) >> 13;
                atomicMax(kmax + b * 8 + ((colt + wc * 32) >> 6), __float_as_uint(hm[0])); atomicMax(kmax + b * 8 + ((colt + 128 + wc * 32) >> 6), __float_as_uint(hm[1])); } }
    }
};

#define PG8_DPP(v, ctrl) __builtin_bit_cast(float, __builtin_amdgcn_update_dpp(0, __builtin_bit_cast(int, (v)), (ctrl), 0xf, 0xf, true))
struct EpiUpConv {
    static constexpr bool PERM = true, AFTER_DRAIN = false, HAS_MID = false;
    bf16_t* G; const float* PS  ; float* HALO4; const float* cw; const float* cb; PG8_LAS float* hal;
    __device__ __forceinline__ void operator()(f32x4 (&acc)[2][2][4][2], const Unit& u, int wr, int wc, int fr_, int fq_) const {
        int fr = fr_, fq = fq_; asm volatile("" : "+v"(fr), "+v"(fq));
        const int row0 = u.pm * BM + wr * 64 + fr; const int colw = wc * 32 + 8 * fq; const int c0 = u.pn * 128;
#pragma unroll
        for (int ai = 0; ai < 2; ++ai)
#pragma unroll
            for (int m = 0; m < 4; ++m) { const int r = row0 + ai * HALF + m * 16; const float rs = *(const float*)((const char*)PS + (unsigned)r * 4u);
#pragma unroll
                for (int bj = 0; bj < 2; ++bj)
#pragma unroll
                    for (int n = 0; n < 2; ++n) acc[ai][bj][m][n] = acc[ai][bj][m][n] * rs;
                asm volatile("" ::: "memory"); __builtin_amdgcn_sched_barrier(0); }
        f32x4 W[2][4];
#define PG8_LDW(BUF, N_, BJ_) do { const unsigned ch_ = (unsigned)((BJ_) * 2816 + c0 + colw + 4 * (N_)) * 4u; \
            W[BUF][0] = *(const f32x4*)((const char*)cw + ch_); W[BUF][1] = *(const f32x4*)((const char*)cw + 5632u * 4u + ch_); \
            W[BUF][2] = *(const f32x4*)((const char*)cw + 2u * 5632u * 4u + ch_); W[BUF][3] = *(const f32x4*)((const char*)cb + ch_); } while (0)
        PG8_LDW(0, 0, 0);
        if (fr >= 14) {
#pragma unroll
            for (int ai = 0; ai < 2; ++ai)
#pragma unroll
                for (int bj = 0; bj < 2; ++bj)
#pragma unroll
                    for (int n = 0; n < 2; ++n) *(PG8_LAS f32x4*)(hal + (((ai * 2 + wr) * 2 + (fr - 14)) * 256 + bj * 128 + colw + 4 * n)) = acc[ai][bj][3][n];
            if (wr == 1) {
#pragma unroll
                for (int bj = 0; bj < 2; ++bj)
#pragma unroll
                    for (int n = 0; n < 2; ++n) *(f32x4*)(HALO4 + (size_t)(u.pm * 4 + 2 + (fr - 14)) * 5632 + bj * 2816 + c0 + colw + 4 * n) = acc[1][bj][3][n]; }
        }
        if (wr == 0 && fr < 2) {
#pragma unroll
            for (int bj = 0; bj < 2; ++bj)
#pragma unroll
                for (int n = 0; n < 2; ++n) *(f32x4*)(HALO4 + (size_t)(u.pm * 4 + fr) * 5632 + bj * 2816 + c0 + colw + 4 * n) = acc[0][bj][0][n]; }
        asm volatile("s_waitcnt lgkmcnt(0)\n\ts_barrier" ::: "memory");
        const int hrow = (fr == 15) ? 1 : 0;
#pragma unroll
        for (int n = 0; n < 2; ++n) {
#pragma unroll
            for (int bj = 0; bj < 2; ++bj) {
                const int gi = n * 2 + bj;
                if (gi == 0) PG8_LDW(1, 0, 1); else if (gi == 1) PG8_LDW(0, 1, 0); else if (gi == 2) PG8_LDW(1, 1, 1);
                const f32x4 w0 = W[gi & 1][0], w1 = W[gi & 1][1], w2 = W[gi & 1][2], bb = W[gi & 1][3];
#pragma unroll
                for (int ai = 0; ai < 2; ++ai) {
                    f32x4 prev;
                    if (ai == 0 && wr == 0) prev = (f32x4){0.f, 0.f, 0.f, 0.f};
                    else prev = *(const PG8_LAS f32x4*)(hal + (((ai * 2 + wr - 1) * 2 + hrow) * 256 + bj * 128 + colw + 4 * n));
#pragma unroll
                    for (int m = 0; m < 4; ++m) { const f32x4 cur = acc[ai][bj][m][n]; f32x4 o;
#pragma unroll
                        for (int i = 0; i < 4; ++i) {
                            float s1, s2;
                            asm volatile("s_nop 1\n\tv_mov_b32_dpp %0, %2 row_ror:1 row_mask:0xf bank_mask:0xf\n\tv_mov_b32_dpp %1, %2 row_ror:2 row_mask:0xf bank_mask:0xf\n\t"
                                         "v_mov_b32_dpp %0, %3 row_shr:1 row_mask:0xf bank_mask:0xf\n\tv_mov_b32_dpp %1, %3 row_shr:2 row_mask:0xf bank_mask:0xf"
                                         : "=&v"(s1), "=&v"(s2) : "v"(prev[i]), "v"(cur[i]), "v"(w1[i]), "v"(w0[i]));
                            float t = bb[i] + w2[i] * cur[i] + w1[i] * s1 + w0[i] * s2; asm volatile("" : "+v"(t)); o[i] = t; }
                        acc[ai][bj][m][n] = o; prev = cur; __builtin_amdgcn_sched_barrier(0); }
                }
                asm volatile("" ::: "memory"); __builtin_amdgcn_sched_barrier(0);
            }
#pragma unroll
            for (int ai = 0; ai < 2; ++ai)
#pragma unroll
                for (int m = 0; m < 4; ++m) { int rowb = row0; asm volatile("" : "+v"(rowb)); const f32x4 cg = acc[ai][0][m][n], cv = acc[ai][1][m][n]; float res[4];
#pragma unroll
                    for (int i = 0; i < 4; ++i) { const float g = cg[i]; res[i] = g * __builtin_amdgcn_rcpf(1.0f + __builtin_amdgcn_exp2f(-1.4426950408889634f * g)) * cv[i]; }
                    u32x2 w; w.x = cvt_pk_bf16(res[0], res[1]); w.y = cvt_pk_bf16(res[2], res[3]);
                    const bool skip = (ai == 0) && (m == 0) && (wr == 0) && (fr < 2);
                    if (!skip) *(u32x2*)((char*)G + ((unsigned)(rowb + ai * HALF + m * 16) * 2816u + (unsigned)(c0 + colw + 4 * n)) * 2u) = w; __builtin_amdgcn_sched_barrier(0); }
            asm volatile("" ::: "memory");
        }
    }
};

struct EpiOut {
    static constexpr bool PERM = false, AFTER_DRAIN = false, HAS_MID = true;
    const float* X; float* X1; bf16_t* XB; const PG8_LAS float* tab; float* PS;
    __device__ __forceinline__ void mid(f32x4 (&acc)[2][2][4][2], const Unit& u, int wr, int wc, int fr, int fq) const {
        const PG8_LAS float* t = tab + (u.idx * 256 + wr * 64 + fr) * 2;
#pragma unroll
        for (int ai = 0; ai < 2; ++ai)
#pragma unroll
            for (int m = 0; m < 4; ++m) { const float ratio = t[(ai * HALF + m * 16) * 2];
#pragma unroll
                for (int bj = 0; bj < 2; ++bj)
#pragma unroll
                    for (int n = 0; n < 2; ++n) acc[ai][bj][m][n] = acc[ai][bj][m][n] * ratio; }
    }
    __device__ __forceinline__ void operator()(f32x4 (&acc)[2][2][4][2], const Unit& u, int wr, int wc, int fr, int fq) const {
        const int row0 = u.pm * BM + wr * 64 + fr; const int col0 = u.pn * BM + wc * 32 + 4 * fq;
        const PG8_LAS float* t = tab + (u.idx * 256 + wr * 64 + fr) * 2 + 1;
        f32x4 xn[2][2];
#pragma unroll
        for (int bj = 0; bj < 2; ++bj)
#pragma unroll
            for (int n = 0; n < 2; ++n) xn[bj][n] = *(const f32x4*)(X + (size_t)row0 * 1024 + col0 + bj * HALF + n * 16);
#pragma unroll
        for (int ai = 0; ai < 2; ++ai)
#pragma unroll
            for (int m = 0; m < 4; ++m) { const int r = row0 + ai * HALF + m * 16; const float rs = t[(ai * HALF + m * 16) * 2]; const size_t off = (size_t)r * 1024 + col0; float sq = 0.f;
                f32x4 xv[2][2];
#pragma unroll
                for (int bj = 0; bj < 2; ++bj)
#pragma unroll
                    for (int n = 0; n < 2; ++n) xv[bj][n] = xn[bj][n];
                if (ai * 4 + m < 7) { const int r2 = row0 + ((ai * 4 + m + 1) >> 2) * HALF + ((ai * 4 + m + 1) & 3) * 16;
#pragma unroll
                    for (int bj = 0; bj < 2; ++bj)
#pragma unroll
                        for (int n = 0; n < 2; ++n) xn[bj][n] = *(const f32x4*)(X + (size_t)r2 * 1024 + col0 + bj * HALF + n * 16); }
#pragma unroll
                for (int bj = 0; bj < 2; ++bj)
#pragma unroll
                    for (int n = 0; n < 2; ++n) { const size_t o2 = off + bj * HALF + n * 16; const f32x4 o = xv[bj][n] + acc[ai][bj][m][n] * rs;
                        *(f32x4*)(X1 + o2) = o; u32x2 w; w.x = cvt_pk_bf16(o[0], o[1]); w.y = cvt_pk_bf16(o[2], o[3]); *(u32x2*)(XB + o2) = w;
                        sq += (o[0] * o[0] + o[1] * o[1]) + (o[2] * o[2] + o[3] * o[3]); }
                sq += __shfl_xor(sq, 16); sq += __shfl_xor(sq, 32);
                if (fq == 0) PS[(size_t)r * 16 + u.pn * 4 + wc] = sq;
                asm volatile("" ::: "memory"); }
    }
};

struct EpiDown {
    static constexpr bool PERM = false, AFTER_DRAIN = false, HAS_MID = false;
    const float* X1; float* OUT; float* PS;
    __device__ __forceinline__ void operator()(f32x4 (&acc)[2][2][4][2], const Unit& u, int wr, int wc, int fr, int fq) const {
        const int row0 = u.pm * BM + wr * 64 + fr; const int col0 = u.pn * BM + wc * 32 + 4 * fq;
        f32x4 xn[2][2];
#pragma unroll
        for (int bj = 0; bj < 2; ++bj)
#pragma unroll
            for (int n = 0; n < 2; ++n) xn[bj][n] = *(const f32x4*)(X1 + (size_t)row0 * 1024 + col0 + bj * HALF + n * 16);
#pragma unroll
        for (int ai = 0; ai < 2; ++ai)
#pragma unroll
            for (int m = 0; m < 4; ++m) { const int r = row0 + ai * HALF + m * 16; const size_t off = (size_t)r * 1024 + col0; float sq = 0.f;
                f32x4 xv[2][2];
#pragma unroll
                for (int bj = 0; bj < 2; ++bj)
#pragma unroll
                    for (int n = 0; n < 2; ++n) xv[bj][n] = xn[bj][n];
                if (ai * 4 + m < 7) { const int r2 = row0 + ((ai * 4 + m + 1) >> 2) * HALF + ((ai * 4 + m + 1) & 3) * 16;
#pragma unroll
                    for (int bj = 0; bj < 2; ++bj)
#pragma unroll
                        for (int n = 0; n < 2; ++n) xn[bj][n] = *(const f32x4*)(X1 + (size_t)r2 * 1024 + col0 + bj * HALF + n * 16); }
#pragma unroll
                for (int bj = 0; bj < 2; ++bj)
#pragma unroll
                    for (int n = 0; n < 2; ++n) { const size_t o2 = off + bj * HALF + n * 16; const f32x4 o = xv[bj][n] + acc[ai][bj][m][n];
                        *(f32x4*)(OUT + o2) = o; sq += (o[0] * o[0] + o[1] * o[1]) + (o[2] * o[2] + o[3] * o[3]); }
                sq += __shfl_xor(sq, 16); sq += __shfl_xor(sq, 32);
                if (fq == 0) PS[(size_t)r * 16 + u.pn * 4 + wc] = sq;
                asm volatile("" ::: "memory"); }
    }
};
template <class Epi, class Sched, bool ALIGN_EPI = false, bool SP2 = false>
__device__ __forceinline__ void gemm_phase(PG8_LAS unsigned char* lds, const Gemm g, const Sched& S, const Epi& E) {
    int tid_ = threadIdx.x; asm volatile("" : "+v"(tid_));
    const int tid = tid_, wid = __builtin_amdgcn_readfirstlane(tid >> 6), lane = tid & 63, wr = wid >> 2, wc = wid & 3, fr = lane & 15, fq = lane >> 4;
    const int K = g.K, nt = K / BK;
    unsigned voffA[2], voffB[2];
#pragma unroll
    for (int i = 0; i < 2; ++i) { int R, C; stage_rc(tid * 16 + i * 8192, R, C); const int Rb = Epi::PERM ? ((R & ~31) + perm32(R & 31)) : R;
        voffA[i] = (unsigned)(R * g.lda + C) * 2u; voffB[i] = (unsigned)(Rb * K + C) * 2u; }
    const size_t kstep = (size_t)(BK * 2);
    const size_t hstepA = (size_t)HALF * g.lda * 2, hstepB = (size_t)HALF * K * 2;
    const size_t tstepA = 2 * hstepA, tstepB = 2 * hstepB;
    const unsigned ldsw = (unsigned)wid * 1024u;
    const int aoff = lds_byte(wr * 64 + fr, fq * 8), boff = lds_byte(wc * 32 + fr, fq * 8);
#define PG8_SA(b, h) (((b) * 2 + (h)) * HTB)
#define PG8_SB(b, h) ((4 + (b) * 2 + (h)) * HTB)
#define PG8_STAGE(bufoff, gbase, voff) do { _Pragma("unroll") for (int _i = 0; _i < 2; ++_i) \
        __builtin_amdgcn_global_load_lds((const unsigned*)((const char*)(gbase) + (voff)[_i]), (PG8_LAS unsigned*)(lds + (bufoff) + ldsw + _i * 8192), 16, 0, 0); } while (0)
#define PG8_LDA(dst, b, h) do { _Pragma("unroll") for (int m = 0; m < 4; ++m) _Pragma("unroll") for (int k = 0; k < 2; ++k) dst[m][k] = *(const PG8_LAS bf16x8*)(lds + PG8_SA(b, h) + aoff + m * 2048 + k * 1024); } while (0)
#define PG8_LDB(dst, b, h) do { _Pragma("unroll") for (int n = 0; n < 2; ++n) _Pragma("unroll") for (int k = 0; k < 2; ++k) dst[n][k] = *(const PG8_LAS bf16x8*)(lds + PG8_SB(b, h) + boff + n * 2048 + k * 1024); } while (0)
#define PG8_MMA(ai, bj, At, Bt) do { __builtin_amdgcn_s_setprio(1); _Pragma("unroll") for (int m = 0; m < 4; ++m) _Pragma("unroll") for (int n = 0; n < 2; ++n) _Pragma("unroll") for (int k = 0; k < 2; ++k) \
        acc[ai][bj][m][n] = __builtin_amdgcn_mfma_f32_16x16x32_bf16(Bt[n][k], At[m][k], acc[ai][bj][m][n], 0, 0, 0); __builtin_amdgcn_s_setprio(0); } while (0)
#define PG8_WAIT_V(n) asm volatile("s_waitcnt vmcnt(" #n ")" ::: "memory")
#define PG8_WAIT_L(n) asm volatile("s_waitcnt lgkmcnt(" #n ")" ::: "memory")
#define PG8_BAR __builtin_amdgcn_s_barrier()
#define PG8_SCHED __builtin_amdgcn_sched_barrier(0)
    Unit cur, nxt; int ui = 0;
    if (!S.next(0, cur)) return;
    f32x4 acc[2][2][4][2];
#pragma unroll
    for (int a = 0; a < 2; ++a)
#pragma unroll
        for (int b = 0; b < 2; ++b)
#pragma unroll
            for (int m = 0; m < 4; ++m)
#pragma unroll
                for (int n = 0; n < 2; ++n) acc[a][b][m][n] = (f32x4){0.f, 0.f, 0.f, 0.f};
    bf16x8 At[4][2], B0[2][2], B1[2][2];
    const char* cA = (const char*)g.A + (size_t)cur.pm * tstepA; const char* cB = (const char*)g.Bt + (size_t)cur.pn * tstepB;
    S.a_ready(cur);
    if constexpr (SP2) {
        PG8_STAGE(PG8_SB(0, 0), cB, voffB); PG8_STAGE(PG8_SB(0, 1), cB + hstepB, voffB); PG8_STAGE(PG8_SA(0, 0), cA, voffA); PG8_STAGE(PG8_SA(0, 1), cA + hstepA, voffA);
        if (wr == 1) PG8_BAR;
        PG8_WAIT_V(2); PG8_BAR;
        PG8_STAGE(PG8_SB(1, 0), cB + kstep, voffB); PG8_STAGE(PG8_SA(1, 0), cA + kstep, voffA); PG8_STAGE(PG8_SB(1, 1), cB + hstepB + kstep, voffB);
        PG8_WAIT_V(6); PG8_BAR;
    } else {
        PG8_STAGE(PG8_SB(0, 0), cB, voffB); PG8_STAGE(PG8_SA(0, 0), cA, voffA); PG8_STAGE(PG8_SB(0, 1), cB + hstepB, voffB); PG8_STAGE(PG8_SA(0, 1), cA + hstepA, voffA);
        if (wr == 1) PG8_BAR;
        PG8_WAIT_V(4); PG8_BAR;
        PG8_STAGE(PG8_SB(1, 0), cB + kstep, voffB); PG8_STAGE(PG8_SA(1, 0), cA + kstep, voffA); PG8_STAGE(PG8_SB(1, 1), cB + hstepB + kstep, voffB);
        PG8_WAIT_V(6); PG8_BAR;
    }
    for (;;) {
        const bool has_next = S.next(ui + 1, nxt);
        const char* nA = has_next ? (const char*)g.A + (size_t)nxt.pm * tstepA : cA; const char* nB = has_next ? (const char*)g.Bt + (size_t)nxt.pn * tstepB : cB;
        for (int t = 0; t < nt; t += 2) {
            if constexpr (Epi::HAS_MID) { if (t == (nt >> 1)) E.mid(acc, cur, wr, wc, fr, fq); }
            const bool last = (t == nt - 2);
            const char* a1 = cA + (size_t)(t + 1) * kstep;
            const char* a2 = last ? nA : cA + (size_t)(t + 2) * kstep; const char* b2 = last ? nB : cB + (size_t)(t + 2) * kstep;
            const char* a3 = a2 + kstep; const char* b3 = b2 + kstep;
            if (last && has_next) S.a_ready(nxt);
            if constexpr (SP2) {
            PG8_LDB(B0, 0, 0); PG8_LDB(B1, 0, 1); PG8_SCHED; PG8_LDA(At, 0, 0); PG8_STAGE(PG8_SA(1, 1), a1 + hstepA, voffA);
            PG8_WAIT_V(8); PG8_WAIT_L(0); PG8_BAR; PG8_MMA(0, 0, At, B0); PG8_MMA(0, 1, At, B1); PG8_BAR; PG8_SCHED;
            PG8_LDA(At, 0, 1); PG8_STAGE(PG8_SB(0, 0), b2, voffB); PG8_STAGE(PG8_SB(0, 1), b2 + hstepB, voffB); PG8_STAGE(PG8_SA(0, 0), a2, voffA);
            PG8_WAIT_V(8); PG8_WAIT_L(0); PG8_BAR; PG8_MMA(1, 0, At, B0); PG8_MMA(1, 1, At, B1); PG8_BAR; PG8_SCHED;
            PG8_LDB(B0, 1, 0); PG8_LDB(B1, 1, 1); PG8_SCHED; PG8_LDA(At, 1, 0); PG8_STAGE(PG8_SA(0, 1), a2 + hstepA, voffA);
            PG8_WAIT_V(8); PG8_WAIT_L(0); PG8_BAR; PG8_MMA(0, 0, At, B0); PG8_MMA(0, 1, At, B1); PG8_BAR; PG8_SCHED;
            PG8_LDA(At, 1, 1); PG8_STAGE(PG8_SB(1, 0), b3, voffB); PG8_STAGE(PG8_SB(1, 1), b3 + hstepB, voffB); PG8_STAGE(PG8_SA(1, 0), a3, voffA);
            PG8_WAIT_V(8); PG8_WAIT_L(0); PG8_BAR; PG8_MMA(1, 0, At, B0); PG8_MMA(1, 1, At, B1); PG8_BAR; PG8_SCHED;
            } else {
            PG8_LDB(B0, 0, 0); PG8_SCHED; PG8_LDA(At, 0, 0); PG8_STAGE(PG8_SA(1, 1), a1 + hstepA, voffA);
            PG8_WAIT_L(8); PG8_BAR; PG8_WAIT_L(0); PG8_MMA(0, 0, At, B0); PG8_BAR; PG8_SCHED;
            PG8_LDB(B1, 0, 1); PG8_STAGE(PG8_SB(0, 0), b2, voffB);
            PG8_BAR; PG8_WAIT_L(0); PG8_MMA(0, 1, At, B1); PG8_BAR;
            PG8_LDA(At, 0, 1); PG8_STAGE(PG8_SA(0, 0), a2, voffA);
            PG8_BAR; PG8_WAIT_L(0); PG8_MMA(1, 0, At, B0); PG8_BAR; PG8_SCHED;
            PG8_STAGE(PG8_SB(0, 1), b2 + hstepB, voffB);
            PG8_WAIT_V(6); PG8_BAR; PG8_MMA(1, 1, At, B1); PG8_BAR;
            PG8_LDB(B0, 1, 0); PG8_SCHED; PG8_LDA(At, 1, 0); PG8_STAGE(PG8_SA(0, 1), a2 + hstepA, voffA);
            PG8_WAIT_L(8); PG8_BAR; PG8_WAIT_L(0); PG8_MMA(0, 0, At, B0); PG8_BAR; PG8_SCHED;
            PG8_LDB(B1, 1, 1); PG8_STAGE(PG8_SB(1, 0), b3, voffB);
            PG8_BAR; PG8_WAIT_L(0); PG8_MMA(0, 1, At, B1); PG8_BAR;
            PG8_LDA(At, 1, 1); PG8_STAGE(PG8_SA(1, 0), a3, voffA);
            PG8_BAR; PG8_WAIT_L(0); PG8_MMA(1, 0, At, B0); PG8_BAR; PG8_SCHED;
            PG8_STAGE(PG8_SB(1, 1), b3 + hstepB, voffB);
            PG8_WAIT_V(6); PG8_BAR; PG8_MMA(1, 1, At, B1); PG8_BAR;
            }
        }
        if constexpr (ALIGN_EPI) { if (wr == 0) PG8_BAR; }
        if constexpr (!Epi::AFTER_DRAIN) { E(acc, cur, wr, wc, fr, fq); S.done(cur); }
        if (!has_next) break;
#pragma unroll
        for (int a = 0; a < 2; ++a)
#pragma unroll
            for (int b = 0; b < 2; ++b)
#pragma unroll
                for (int m = 0; m < 4; ++m)
#pragma unroll
                    for (int n = 0; n < 2; ++n) acc[a][b][m][n] = (f32x4){0.f, 0.f, 0.f, 0.f};
        cur = nxt; cA = nA; cB = nB; ++ui;
        if constexpr (ALIGN_EPI) { if (wr == 1) PG8_BAR; }
    }
    PG8_WAIT_V(0);
    if constexpr (!ALIGN_EPI) { if (wr == 0) PG8_BAR; }
    PG8_BAR;
    if constexpr (Epi::AFTER_DRAIN) { E.fused(acc, cur, wr, wc, fr, fq, lds, wid, lane); S.done(cur); }
#undef PG8_SA
#undef PG8_SB
#undef PG8_STAGE
#undef PG8_LDA
#undef PG8_LDB
#undef PG8_MMA
#undef PG8_WAIT_V
#undef PG8_WAIT_L
#undef PG8_BAR
#undef PG8_SCHED
}
}

namespace att {
#define LAS3 __attribute__((address_space(3)))
typedef unsigned short bf16_t;
using bf16x8 = __attribute__((ext_vector_type(8))) short;
using s16x4 = __attribute__((ext_vector_type(4))) short;
using f32x16 = __attribute__((ext_vector_type(16))) float;
using f32x4 = __attribute__((ext_vector_type(4))) float;
using u32x4 = __attribute__((ext_vector_type(4))) unsigned;
using u32x2 = __attribute__((ext_vector_type(2))) unsigned;
constexpr int SEQ = 8192, DM = 1024, KVB = 64, SLOTB = 8192;
constexpr int NS = 4;
constexpr int L_K = 0, L_V = NS * SLOTB, L_F = 2 * NS * SLOTB, L_FB = L_F + NS * 1024, L_OST = L_FB + 1024, OSTW = 4608, L_FLAG = 126976, L_END = L_FLAG + 128;
constexpr float C2 = 0.125f * 1.4426950408889634f;

__device__ __forceinline__ void glds16(const void* gsrc, unsigned lds_dst) { unsigned keep;
    asm volatile("s_mov_b32 %0, m0\n\ts_mov_b32 m0, %2\n\ts_nop 0\n\tglobal_load_lds_dwordx4 %1, off\n\ts_mov_b32 m0, %0" : "=&s"(keep) : "v"(gsrc), "s"(lds_dst) : "memory"); }
typedef float f32x2_t __attribute__((ext_vector_type(2))); typedef __bf16 bf16x2_t __attribute__((ext_vector_type(2)));
__device__ __forceinline__ unsigned cvtpk(float lo, float hi) { f32x2_t v = {lo, hi}; bf16x2_t b = __builtin_convertvector(v, bf16x2_t); return __builtin_bit_cast(unsigned, b); }
#define ATT_WAIT_BAR() asm volatile("s_waitcnt vmcnt(0) lgkmcnt(0)\n\ts_barrier" ::: "memory")
#define ATT_WAIT_N(n) asm volatile("s_waitcnt vmcnt(" #n ") lgkmcnt(0)\n\ts_barrier" ::: "memory")
#define ATT_TILE_WAIT(jt, W0) do { if ((jt) >= 2) { if (W0) ATT_WAIT_N(6); else ATT_WAIT_N(4); } else if ((jt) == 1) { if (W0) ATT_WAIT_N(3); else ATT_WAIT_N(2); } else ATT_WAIT_N(0); } while (0)
typedef short v4i16_t __attribute__((ext_vector_type(4)));
__device__ __forceinline__ s16x4 vtr(const LAS3 unsigned char* p) { return __builtin_bit_cast(s16x4, __builtin_amdgcn_ds_read_tr16_b64_v4i16((LAS3 v4i16_t*)p)); }
__device__ __forceinline__ float other_half(float v) {
    auto rr = __builtin_amdgcn_permlane32_swap(__float_as_uint(v), __float_as_uint(v), false, false);
    const unsigned a = rr[0], b = rr[1];
    return __uint_as_float(a == __float_as_uint(v) ? b : a);
}

template <bool SB>
__device__ __forceinline__ void attn_unit(int b, int hh, int qb, const bf16_t* Q, const bf16_t* __restrict__ K, const bf16_t* __restrict__ V, bf16_t* O,
                                          const float* __restrict__ F2, float* SS, LAS3 unsigned char* shm) {
    const int tid = threadIdx.x, lane = tid & 63, r32 = lane & 31, hi = lane >> 5; const int wid = __builtin_amdgcn_readfirstlane(tid >> 6);
    const long rowbase = (long)b * SEQ; const int q0 = qb * 256, qw0 = q0 + wid * 32;
    const bf16_t* Qw = Q + (rowbase + qw0) * DM + hh * 64;
    const bf16_t* Kh = K + rowbase * DM + hh * 64; const bf16_t* Vh = V + rowbase * DM + hh * 64;
    const unsigned lds0 = (unsigned)(uintptr_t)shm;
    const bf16_t* ksrc = Kh + (long)lane * DM + wid * 8;
    const bf16_t* vsrc = Vh + (long)(16 * (wid & 3) + (lane >> 2)) * DM + (wid >> 2) * 32 + (lane & 3) * 8;
    const unsigned kdst = lds0 + L_K + wid * 1024, vdst = lds0 + L_V + wid * 1024;
#define ATT_DMA(t, slotoff) do { glds16(ksrc + (long)(t) * KVB * DM, (unsigned)__builtin_amdgcn_readfirstlane(kdst + (slotoff))); \
                                 glds16(vsrc + (long)(t) * KVB * DM, (unsigned)__builtin_amdgcn_readfirstlane(vdst + (slotoff))); } while (0)
    const int NT = 4 * qb + 4;
    ATT_DMA(NT - 1, ((NT - 1) & 3) * SLOTB); ATT_DMA(NT - 2, ((NT - 2) & 3) * SLOTB); ATT_DMA(NT - 3, ((NT - 3) & 3) * SLOTB);
    bf16x8 qr[4];
#pragma unroll
    for (int d0 = 0; d0 < 4; ++d0) qr[d0] = *reinterpret_cast<const bf16x8*>(Qw + (long)r32 * DM + d0 * 16 + hi * 8);
    LAS3 float* F2s = (LAS3 float*)(shm + L_F);
    float ft2 = 0.f;
    if (!SB) { const float* Frow = F2 + (long)(b * 8 + hh) * SEQ;
        for (int i = tid; i < (q0 + 256) / 4; i += 512) ((LAS3 f32x4*)F2s)[i] = ((const f32x4*)Frow)[i];
        ft2 = Frow[qw0 + r32]; }
    f32x16 o0, o1;
#pragma unroll
    for (int r = 0; r < 16; ++r) { o0[r] = 0.f; o1[r] = 0.f; }
    float mrun = -INFINITY, lrun = 0.f, carry = 1.f;
    volatile LAS3 unsigned* flags = (volatile LAS3 unsigned*)(shm + L_FLAG);
    const LAS3 unsigned char* kp0 = shm + L_K + hi * 1024 + r32 * 16;
    const LAS3 unsigned char* vp0 = shm + L_V + ((lane >> 4) & 1) * 32 + (lane & 3) * 8 + (4 * hi + ((lane & 15) >> 2)) * 64;
    asm volatile("" :: "v"(qr[0]), "v"(qr[1]), "v"(qr[2]), "v"(qr[3]));
    for (int jt = NT - 1; jt >= 0; --jt) {
        const int slot = jt & 3;
        ATT_TILE_WAIT(jt, false);
        if (SB && jt < NT - 1) { unsigned a = 0;
#pragma unroll
            for (int w = 0; w < 8; ++w) a |= flags[((jt + 1) & 1) * 8 + w];
            if (__builtin_amdgcn_readfirstlane(a) == 0u) break; }
        if (jt >= 3) ATT_DMA(jt - 3, ((jt - 3) & 3) * SLOTB);
        if (64 * jt <= qw0 + 31) {
            const LAS3 unsigned char* kp = kp0 + slot * SLOTB;
            f32x16 p0, p1;
#pragma unroll
            for (int r = 0; r < 16; ++r) { p0[r] = 0.f; p1[r] = 0.f; }
#pragma unroll
            for (int d0 = 0; d0 < 4; ++d0) {
                const bf16x8 k0 = *(const LAS3 bf16x8*)(kp + d0 * 2048), k1 = *(const LAS3 bf16x8*)(kp + d0 * 2048 + 512);
                p0 = __builtin_amdgcn_mfma_f32_32x32x16_bf16(k0, qr[d0], p0, 0, 0, 0);
                p1 = __builtin_amdgcn_mfma_f32_32x32x16_bf16(k1, qr[d0], p1, 0, 0, 0);
            }
            const bool diag = (64 * jt + 63 > qw0 - (SB ? 1 : 0));
            const int kb_ = 64 * jt + 4 * hi - (qw0 + r32);
            if (!SB) {
                const LAS3 float* fsp = F2s + 64 * jt + 4 * hi;
#pragma unroll
                for (int g = 0; g < 4; ++g) { const f32x4 fa = *(const LAS3 f32x4*)(fsp + 8 * g), fb = *(const LAS3 f32x4*)(fsp + 32 + 8 * g);
#pragma unroll
                    for (int i = 0; i < 4; ++i) { p0[4 * g + i] += (ft2 - fa[i]); p1[4 * g + i] += (ft2 - fb[i]); } }
                if (diag) {
#pragma unroll
                    for (int r = 0; r < 16; ++r) { const int cr = (r & 3) + 8 * (r >> 2); if (kb_ + cr > 0) p0[r] = -INFINITY; if (kb_ + cr + 32 > 0) p1[r] = -INFINITY; } }
                float mx = fmaxf(p0[0], p1[0]);
#pragma unroll
                for (int r = 1; r < 16; ++r) mx = fmaxf(mx, fmaxf(p0[r], p1[r]));
                mx = fmaxf(mx, other_half(mx));
                const float mnew = fmaxf(mrun, mx);
                if (__any(mnew > mrun)) { const float alpha = __builtin_amdgcn_exp2f(mrun - mnew); lrun *= alpha;
#pragma unroll
                    for (int r = 0; r < 16; ++r) { o0[r] *= alpha; o1[r] *= alpha; }
                    mrun = mnew; }
                float ls = 0.f;
#pragma unroll
                for (int r = 0; r < 16; ++r) { p0[r] = __builtin_amdgcn_exp2f(p0[r] - mrun); p1[r] = __builtin_amdgcn_exp2f(p1[r] - mrun); ls += p0[r] + p1[r]; }
                lrun += ls;
            } else {
#pragma unroll
                for (int r = 0; r < 16; ++r) { p0[r] = __builtin_amdgcn_rcpf(1.0f + __builtin_amdgcn_exp2f(p0[r])); p1[r] = __builtin_amdgcn_rcpf(1.0f + __builtin_amdgcn_exp2f(p1[r])); }
                if (diag) {
#pragma unroll
                    for (int r = 0; r < 16; ++r) { const int cr = (r & 3) + 8 * (r >> 2); if (kb_ + cr >= 0) p0[r] = 1.0f; if (kb_ + cr + 32 >= 0) p1[r] = 1.0f; } }
                float PP0[4], PP1[4], H0[4], H1[4];
#pragma unroll
                for (int g = 0; g < 4; ++g) { const float g0 = (p0[4 * g] * p0[4 * g + 1]) * (p0[4 * g + 2] * p0[4 * g + 3]), g1 = (p1[4 * g] * p1[4 * g + 1]) * (p1[4 * g + 2] * p1[4 * g + 3]);
                    const float t0 = other_half(g0), t1 = other_half(g1); PP0[g] = g0 * t0; PP1[g] = g1 * t1; H0[g] = hi ? 1.0f : t0; H1[g] = hi ? 1.0f : t1; }
                float T0[4], T1[4];
                T1[3] = carry; T1[2] = T1[3] * PP1[3]; T1[1] = T1[2] * PP1[2]; T1[0] = T1[1] * PP1[1]; const float tot1 = T1[0] * PP1[0];
                T0[3] = tot1; T0[2] = T0[3] * PP0[3]; T0[1] = T0[2] * PP0[2]; T0[0] = T0[1] * PP0[1]; carry = T0[0] * PP0[0];
#pragma unroll
                for (int g = 0; g < 4; ++g) {
                    { const float x3 = T0[g] * H0[g], x2 = x3 * p0[4 * g + 3], x1 = x2 * p0[4 * g + 2], x0 = x1 * p0[4 * g + 1];
                      p0[4 * g + 3] = fmaf(-p0[4 * g + 3], x3, x3); p0[4 * g + 2] = fmaf(-p0[4 * g + 2], x2, x2); p0[4 * g + 1] = fmaf(-p0[4 * g + 1], x1, x1); p0[4 * g] = fmaf(-p0[4 * g], x0, x0); }
                    { const float x3 = T1[g] * H1[g], x2 = x3 * p1[4 * g + 3], x1 = x2 * p1[4 * g + 2], x0 = x1 * p1[4 * g + 1];
                      p1[4 * g + 3] = fmaf(-p1[4 * g + 3], x3, x3); p1[4 * g + 2] = fmaf(-p1[4 * g + 2], x2, x2); p1[4 * g + 1] = fmaf(-p1[4 * g + 1], x1, x1); p1[4 * g] = fmaf(-p1[4 * g], x0, x0); }
                }
            }
            u32x4 pw[4];
#pragma unroll
            for (int i = 0; i < 4; ++i) { pw[0][i] = cvtpk(p0[2 * i], p0[2 * i + 1]); pw[1][i] = cvtpk(p0[8 + 2 * i], p0[8 + 2 * i + 1]); pw[2][i] = cvtpk(p1[2 * i], p1[2 * i + 1]); pw[3][i] = cvtpk(p1[8 + 2 * i], p1[8 + 2 * i + 1]); }
            const LAS3 unsigned char* vp = vp0 + slot * SLOTB;
#pragma unroll
            for (int ks = 0; ks < 4; ++ks) {
                const s16x4 l0 = vtr(vp + ks * 1024), h0 = vtr(vp + ks * 1024 + 512), l1 = vtr(vp + 4096 + ks * 1024), h1 = vtr(vp + 4096 + ks * 1024 + 512);
                const bf16x8 v0 = (bf16x8){l0[0], l0[1], l0[2], l0[3], h0[0], h0[1], h0[2], h0[3]}, v1 = (bf16x8){l1[0], l1[1], l1[2], l1[3], h1[0], h1[1], h1[2], h1[3]};
                const bf16x8 pf = __builtin_bit_cast(bf16x8, pw[ks]);
                o0 = __builtin_amdgcn_mfma_f32_32x32x16_bf16(v0, pf, o0, 0, 0, 0);
                o1 = __builtin_amdgcn_mfma_f32_32x32x16_bf16(v1, pf, o1, 0, 0, 0);
            }
        }
        if (SB) { const bool alive = __any(carry != 0.f) != 0; if (lane == 0) flags[(jt & 1) * 8 + wid] = alive ? 1u : 0u; }
    }
    if (!SB) { lrun += other_half(lrun); const float inv = 1.0f / lrun;
#pragma unroll
        for (int r = 0; r < 16; ++r) { o0[r] *= inv; o1[r] *= inv; } }
    float sq = 0.f;
#pragma unroll
    for (int r = 0; r < 16; ++r) sq += o0[r] * o0[r] + o1[r] * o1[r];
    sq += other_half(sq);
    if (hi == 0) SS[(size_t)(rowbase + qw0 + r32) * 16 + hh] = sq;
    LAS3 unsigned char* stg = shm + L_OST + wid * OSTW;
#pragma unroll
    for (int g = 0; g < 4; ++g) {
        u32x2 w0; w0.x = cvtpk(o0[4 * g], o0[4 * g + 1]); w0.y = cvtpk(o0[4 * g + 2], o0[4 * g + 3]);
        u32x2 w1; w1.x = cvtpk(o1[4 * g], o1[4 * g + 1]); w1.y = cvtpk(o1[4 * g + 2], o1[4 * g + 3]);
        *(LAS3 u32x2*)(stg + r32 * 144 + g * 16 + hi * 8) = w0;
        *(LAS3 u32x2*)(stg + r32 * 144 + 64 + g * 16 + hi * 8) = w1;
    }
    asm volatile("s_waitcnt lgkmcnt(0)" ::: "memory");
    bf16_t* Ow = O + (rowbase + qw0) * DM + hh * 64;
#pragma unroll
    for (int i = 0; i < 4; ++i) { const int row = i * 8 + (lane >> 3), ch = lane & 7; const u32x4 v = *(const LAS3 u32x4*)(stg + row * 144 + ch * 16); *(u32x4*)(Ow + (long)row * DM + ch * 8) = v; }
    ATT_WAIT_BAR();
#undef ATT_DMA
}
__device__ __forceinline__ float max3f(float a, float b, float c) { float r; asm("v_max3_f32 %0, %1, %2, %3" : "=v"(r) : "v"(a), "v"(b), "v"(c)); return r; }
__device__ __forceinline__ void fox_unit(int b, int hh, int qb, const bf16_t* Q, const bf16_t* __restrict__ K, const bf16_t* __restrict__ V, bf16_t* O,
                                         const float* __restrict__ F2, const bf16_t* __restrict__ FS3, const unsigned* __restrict__ KMAX, float* SS, LAS3 unsigned char* shm) {
    constexpr float THR = 8.0f;
    const int tid = threadIdx.x, lane = tid & 63, r32 = lane & 31, hi = lane >> 5; const int wid = __builtin_amdgcn_readfirstlane(tid >> 6);
    const long rowbase = (long)b * SEQ; const int q0 = qb * 256, qw0 = q0 + wid * 32;
    const bf16_t* Qw = Q + (rowbase + qw0) * DM + hh * 64;
    const bf16_t* Kh = K + rowbase * DM + hh * 64; const bf16_t* Vh = V + rowbase * DM + hh * 64;
    const unsigned lds0 = (unsigned)(uintptr_t)shm;
    const bf16_t* ksrc = Kh + (long)lane * DM + wid * 8;
    const bf16_t* vsrc = Vh + (long)(16 * (wid & 3) + (lane >> 2)) * DM + (wid >> 2) * 32 + (lane & 3) * 8;
    const bf16_t* fsrc = FS3 + ((long)(b * 8 + hh) * SEQ + lane) * 8;
    const float* Frow = F2 + (long)(b * 8 + hh) * SEQ;
    const unsigned kdst = lds0 + L_K + wid * 1024, vdst = lds0 + L_V + wid * 1024, fdst = lds0 + L_F;
#define FOX_DMA(t, s_) do { glds16(ksrc + (long)(t) * KVB * DM, (unsigned)__builtin_amdgcn_readfirstlane(kdst + (s_) * SLOTB)); \
                            glds16(vsrc + (long)(t) * KVB * DM, (unsigned)__builtin_amdgcn_readfirstlane(vdst + (s_) * SLOTB)); \
                            if (wid == 0) glds16(fsrc + (long)(t) * KVB * 8, (unsigned)__builtin_amdgcn_readfirstlane(fdst + (s_) * 1024)); } while (0)
    const int NT = 4 * qb + 4;
    FOX_DMA(NT - 1, (NT - 1) & 3); FOX_DMA(NT - 2, (NT - 2) & 3);
    LAS3 float* F2b = (LAS3 float*)(shm + L_FB);
    for (int i = 1 + tid; i < NT; i += 512) F2b[i] = F2[(long)(b * 8 + hh) * SEQ + 64 * i - 1];
    bf16x8 qr[4]; float qn2 = 0.f;
#pragma unroll
    for (int d0 = 0; d0 < 4; ++d0) { qr[d0] = *reinterpret_cast<const bf16x8*>(Qw + (long)r32 * DM + d0 * 16 + hi * 8);
#pragma unroll
        for (int j = 0; j < 8; ++j) { const float f = __builtin_bit_cast(float, (unsigned)(unsigned short)qr[d0][j] << 16); qn2 += f * f; } }
    qn2 += other_half(qn2);
    const float kn = sqrtf(2.0f * __uint_as_float(KMAX[b * 8 + hh])) * 1.01f;
    const float zq = sqrtf(qn2) * kn * 1.01f + 1.0f;
    const float ft2 = Frow[qw0 + r32];
    const float f2q0 = Frow[q0];
    const short one = (short)0x3F80;
    const bf16x8 onesA = (bf16x8){one, one, one, one, one, one, one, one};
    const bf16x8 qones = hi ? (bf16x8){0, 0, 0, 0, 0, 0, 0, 0} : (bf16x8){one, one, one, 0, 0, 0, 0, 0};
    f32x16 o0, o1, lacc, cinit;
#pragma unroll
    for (int r = 0; r < 16; ++r) { o0[r] = 0.f; o1[r] = 0.f; lacc[r] = 0.f; cinit[r] = ft2 - fminf(zq, 60.0f); }
    const float mref = fminf(zq, 60.0f);
    volatile LAS3 unsigned* flags = (volatile LAS3 unsigned*)(shm + L_FLAG);
    const LAS3 unsigned char* kp0 = shm + L_K + hi * 1024 + r32 * 16;
    const LAS3 unsigned char* vp0 = shm + L_V + ((lane >> 4) & 1) * 32 + (lane & 3) * 8 + (4 * hi + ((lane & 15) >> 2)) * 64;
    const LAS3 unsigned char* fp0 = shm + L_F + r32 * 16;
    { const bool ex = __any(zq > 60.0f) != 0; if (lane == 0) flags[wid] = ex ? 1u : 0u; }
    bool excess = false;
    for (int jp = NT / 2 - 1; jp >= 0; --jp) {
        ATT_WAIT_BAR();
        if (jp == NT / 2 - 1) { unsigned a = 0;
#pragma unroll
            for (int w = 0; w < 8; ++w) a |= flags[w];
            excess = __builtin_amdgcn_readfirstlane(a) != 0u; }
        bool last = (jp == 0);
        if (jp > 0 && !excess) { const float fb = __uint_as_float(__builtin_amdgcn_readfirstlane(__float_as_uint(F2b[2 * jp]))); last = (f2q0 - fb) < -128.0f; }
        if (!last) { FOX_DMA(2 * jp - 1, (2 * jp - 1) & 3); FOX_DMA(2 * jp - 2, (2 * jp - 2) & 3); }
#pragma unroll
      for (int sub = 1; sub >= 0; --sub) { const int jt = 2 * jp + sub; const int slot = jt & 3;
        if (64 * jt <= qw0 + 31) {
            const LAS3 unsigned char* kp = kp0 + slot * SLOTB; const LAS3 unsigned char* fp = fp0 + slot * 1024;
            asm volatile("" : "+v"(cinit));
            f32x16 p0 = __builtin_amdgcn_mfma_f32_32x32x16_bf16(*(const LAS3 bf16x8*)(fp), qones, cinit, 0, 0, 0);
            f32x16 p1 = __builtin_amdgcn_mfma_f32_32x32x16_bf16(*(const LAS3 bf16x8*)(fp + 512), qones, cinit, 0, 0, 0);
#pragma unroll
            for (int d0 = 0; d0 < 4; ++d0) {
                const bf16x8 k0 = *(const LAS3 bf16x8*)(kp + d0 * 2048), k1 = *(const LAS3 bf16x8*)(kp + d0 * 2048 + 512);
                p0 = __builtin_amdgcn_mfma_f32_32x32x16_bf16(k0, qr[d0], p0, 0, 0, 0);
                p1 = __builtin_amdgcn_mfma_f32_32x32x16_bf16(k1, qr[d0], p1, 0, 0, 0);
            }
            if (64 * jt + 63 > qw0) { const int kb_ = 64 * jt + 4 * hi - (qw0 + r32);
#pragma unroll
                for (int r = 0; r < 16; ++r) { const int cr = (r & 3) + 8 * (r >> 2); if (kb_ + cr > 0) p0[r] = -INFINITY; if (kb_ + cr + 32 > 0) p1[r] = -INFINITY; } }
#pragma unroll
            for (int r = 0; r < 16; ++r) { p0[r] = __builtin_amdgcn_exp2f(p0[r]); p1[r] = __builtin_amdgcn_exp2f(p1[r]); }
            u32x4 pw[4];
#pragma unroll
            for (int i = 0; i < 4; ++i) { pw[0][i] = cvtpk(p0[2 * i], p0[2 * i + 1]); pw[1][i] = cvtpk(p0[8 + 2 * i], p0[8 + 2 * i + 1]); pw[2][i] = cvtpk(p1[2 * i], p1[2 * i + 1]); pw[3][i] = cvtpk(p1[8 + 2 * i], p1[8 + 2 * i + 1]); }
            const LAS3 unsigned char* vp = vp0 + slot * SLOTB;
#pragma unroll
            for (int ks = 0; ks < 4; ++ks) {
                const s16x4 l0 = vtr(vp + ks * 1024), h0 = vtr(vp + ks * 1024 + 512), l1 = vtr(vp + 4096 + ks * 1024), h1 = vtr(vp + 4096 + ks * 1024 + 512);
                const bf16x8 v0 = (bf16x8){l0[0], l0[1], l0[2], l0[3], h0[0], h0[1], h0[2], h0[3]}, v1 = (bf16x8){l1[0], l1[1], l1[2], l1[3], h1[0], h1[1], h1[2], h1[3]};
                const bf16x8 pf = __builtin_bit_cast(bf16x8, pw[ks]);
                o0 = __builtin_amdgcn_mfma_f32_32x32x16_bf16(v0, pf, o0, 0, 0, 0);
                o1 = __builtin_amdgcn_mfma_f32_32x32x16_bf16(v1, pf, o1, 0, 0, 0);
                lacc = __builtin_amdgcn_mfma_f32_32x32x16_bf16(onesA, pf, lacc, 0, 0, 0);
            }
        }
      }
        if (last) break;
    }
    { const float inv = 1.0f / lacc[0];
#pragma unroll
        for (int r = 0; r < 16; ++r) { o0[r] *= inv; o1[r] *= inv; } }
    float sq = 0.f;
#pragma unroll
    for (int r = 0; r < 16; ++r) sq += o0[r] * o0[r] + o1[r] * o1[r];
    sq += other_half(sq);
    if (hi == 0) SS[(size_t)(rowbase + qw0 + r32) * 16 + hh] = sq;
    LAS3 unsigned char* stg = shm + L_OST + wid * OSTW;
#pragma unroll
    for (int g = 0; g < 4; ++g) {
        u32x2 w0; w0.x = cvtpk(o0[4 * g], o0[4 * g + 1]); w0.y = cvtpk(o0[4 * g + 2], o0[4 * g + 3]);
        u32x2 w1; w1.x = cvtpk(o1[4 * g], o1[4 * g + 1]); w1.y = cvtpk(o1[4 * g + 2], o1[4 * g + 3]);
        *(LAS3 u32x2*)(stg + r32 * 144 + g * 16 + hi * 8) = w0;
        *(LAS3 u32x2*)(stg + r32 * 144 + 64 + g * 16 + hi * 8) = w1;
    }
    asm volatile("s_waitcnt lgkmcnt(0)" ::: "memory");
    bf16_t* Ow = O + (rowbase + qw0) * DM + hh * 64;
#pragma unroll
    for (int i = 0; i < 4; ++i) { const int row = i * 8 + (lane >> 3), ch = lane & 7; const u32x4 v = *(const LAS3 u32x4*)(stg + row * 144 + ch * 16); *(u32x4*)(Ow + (long)row * DM + ch * 8) = v; }
    ATT_WAIT_BAR();
#undef FOX_DMA
}

__device__ __forceinline__ void sb_tile(const LAS3 unsigned char* kp, const LAS3 unsigned char* vp, int jt, int qw0, int r32, int hi, const bf16x8 (&qr)[4], float& carry, f32x16& o0, f32x16& o1) {
    f32x16 p0, p1;
#pragma unroll
    for (int r = 0; r < 16; ++r) { p0[r] = 0.f; p1[r] = 0.f; }
#pragma unroll
    for (int d0 = 0; d0 < 4; ++d0) {
        const bf16x8 k0 = *(const LAS3 bf16x8*)(kp + d0 * 2048), k1 = *(const LAS3 bf16x8*)(kp + d0 * 2048 + 512);
        p0 = __builtin_amdgcn_mfma_f32_32x32x16_bf16(k0, qr[d0], p0, 0, 0, 0);
        p1 = __builtin_amdgcn_mfma_f32_32x32x16_bf16(k1, qr[d0], p1, 0, 0, 0);
    }
#pragma unroll
    for (int r = 0; r < 16; ++r) { p0[r] = __builtin_amdgcn_rcpf(1.0f + __builtin_amdgcn_exp2f(p0[r])); p1[r] = __builtin_amdgcn_rcpf(1.0f + __builtin_amdgcn_exp2f(p1[r])); }
    if (64 * jt + 63 > qw0 - 1) { const int kb_ = 64 * jt + 4 * hi - (qw0 + r32);
#pragma unroll
        for (int r = 0; r < 16; ++r) { const int cr = (r & 3) + 8 * (r >> 2); if (kb_ + cr >= 0) p0[r] = 1.0f; if (kb_ + cr + 32 >= 0) p1[r] = 1.0f; } }
    float PP0[4], PP1[4], H0[4], H1[4];
#pragma unroll
    for (int g = 0; g < 4; ++g) { const float g0 = (p0[4 * g] * p0[4 * g + 1]) * (p0[4 * g + 2] * p0[4 * g + 3]), g1 = (p1[4 * g] * p1[4 * g + 1]) * (p1[4 * g + 2] * p1[4 * g + 3]);
        const float t0 = other_half(g0), t1 = other_half(g1); PP0[g] = g0 * t0; PP1[g] = g1 * t1; H0[g] = hi ? 1.0f : t0; H1[g] = hi ? 1.0f : t1; }
    float T0[4], T1[4];
    T1[3] = carry; T1[2] = T1[3] * PP1[3]; T1[1] = T1[2] * PP1[2]; T1[0] = T1[1] * PP1[1]; const float tot1 = T1[0] * PP1[0];
    T0[3] = tot1; T0[2] = T0[3] * PP0[3]; T0[1] = T0[2] * PP0[2]; T0[0] = T0[1] * PP0[1]; carry = T0[0] * PP0[0];
#pragma unroll
    for (int g = 0; g < 4; ++g) {
        { const float x3 = T0[g] * H0[g], x2 = x3 * p0[4 * g + 3], x1 = x2 * p0[4 * g + 2], x0 = x1 * p0[4 * g + 1];
          p0[4 * g + 3] = fmaf(-p0[4 * g + 3], x3, x3); p0[4 * g + 2] = fmaf(-p0[4 * g + 2], x2, x2); p0[4 * g + 1] = fmaf(-p0[4 * g + 1], x1, x1); p0[4 * g] = fmaf(-p0[4 * g], x0, x0); }
        { const float x3 = T1[g] * H1[g], x2 = x3 * p1[4 * g + 3], x1 = x2 * p1[4 * g + 2], x0 = x1 * p1[4 * g + 1];
          p1[4 * g + 3] = fmaf(-p1[4 * g + 3], x3, x3); p1[4 * g + 2] = fmaf(-p1[4 * g + 2], x2, x2); p1[4 * g + 1] = fmaf(-p1[4 * g + 1], x1, x1); p1[4 * g] = fmaf(-p1[4 * g], x0, x0); }
    }
    u32x4 pw[4];
#pragma unroll
    for (int i = 0; i < 4; ++i) { pw[0][i] = cvtpk(p0[2 * i], p0[2 * i + 1]); pw[1][i] = cvtpk(p0[8 + 2 * i], p0[8 + 2 * i + 1]); pw[2][i] = cvtpk(p1[2 * i], p1[2 * i + 1]); pw[3][i] = cvtpk(p1[8 + 2 * i], p1[8 + 2 * i + 1]); }
#pragma unroll
    for (int ks = 0; ks < 4; ++ks) {
        const s16x4 l0 = vtr(vp + ks * 1024), h0 = vtr(vp + ks * 1024 + 512), l1 = vtr(vp + 4096 + ks * 1024), h1 = vtr(vp + 4096 + ks * 1024 + 512);
        const bf16x8 v0 = (bf16x8){l0[0], l0[1], l0[2], l0[3], h0[0], h0[1], h0[2], h0[3]}, v1 = (bf16x8){l1[0], l1[1], l1[2], l1[3], h1[0], h1[1], h1[2], h1[3]};
        const bf16x8 pf = __builtin_bit_cast(bf16x8, pw[ks]);
        o0 = __builtin_amdgcn_mfma_f32_32x32x16_bf16(v0, pf, o0, 0, 0, 0);
        o1 = __builtin_amdgcn_mfma_f32_32x32x16_bf16(v1, pf, o1, 0, 0, 0);
    }
}
__device__ __forceinline__ void sb_unit(int b, int hh, int qb, const bf16_t* Q, const bf16_t* __restrict__ K, const bf16_t* __restrict__ V, bf16_t* O, float* SS, LAS3 unsigned char* shm) {
    constexpr int WV = 7 * SLOTB;
    const int tid = threadIdx.x, lane = tid & 63, r32 = lane & 31, hi = lane >> 5; const int wid = __builtin_amdgcn_readfirstlane(tid >> 6);
    const long rowbase = (long)b * SEQ; const int q0 = qb * 256, qw0 = q0 + wid * 32;
    const bf16_t* Qw = Q + (rowbase + qw0) * DM + hh * 64;
    const bf16_t* Kh = K + rowbase * DM + hh * 64; const bf16_t* Vh = V + rowbase * DM + hh * 64;
    const unsigned lds0 = (unsigned)(uintptr_t)shm;
    const bf16_t* ksrc = Kh + (long)lane * DM + wid * 8;
    const bf16_t* vsrc = Vh + (long)(16 * (wid & 3) + (lane >> 2)) * DM + (wid >> 2) * 32 + (lane & 3) * 8;
    const int T_hi = 4 * qb + 3, T_lo = (4 * qb - 3 > 0) ? 4 * qb - 3 : 0;
    for (int t = T_hi; t >= T_lo; --t) { glds16(ksrc + (long)t * KVB * DM, (unsigned)__builtin_amdgcn_readfirstlane(lds0 + (t - T_lo) * SLOTB + wid * 1024));
                                         glds16(vsrc + (long)t * KVB * DM, (unsigned)__builtin_amdgcn_readfirstlane(lds0 + WV + (t - T_lo) * SLOTB + wid * 1024)); }
    bf16x8 qr[4];
#pragma unroll
    for (int d0 = 0; d0 < 4; ++d0) qr[d0] = *reinterpret_cast<const bf16x8*>(Qw + (long)r32 * DM + d0 * 16 + hi * 8);
    f32x16 o0, o1;
#pragma unroll
    for (int r = 0; r < 16; ++r) { o0[r] = 0.f; o1[r] = 0.f; }
    float carry = 1.f;
    const int kl = hi * 1024 + r32 * 16, vl = ((lane >> 4) & 1) * 32 + (lane & 3) * 8 + (4 * hi + ((lane & 15) >> 2)) * 64;
    volatile LAS3 unsigned char* fbytes = (volatile LAS3 unsigned char*)(shm + L_FLAG);
    asm volatile("" :: "v"(qr[0]), "v"(qr[1]), "v"(qr[2]), "v"(qr[3]));
    ATT_WAIT_BAR();
    for (int jt = (qw0 + 31) >> 6; jt >= T_lo; --jt) {
        sb_tile(shm + (jt - T_lo) * SLOTB + kl, shm + WV + (jt - T_lo) * SLOTB + vl, jt, qw0, r32, hi, qr, carry, o0, o1);
        if (!__any(carry != 0.f)) break;
    }
    bool more = false;
    if (T_lo > 0) {
        const bool alive = __any(carry != 0.f) != 0; if (lane == 0) fbytes[16 + wid] = alive ? (unsigned char)1 : (unsigned char)0;
        ATT_WAIT_BAR();
        const unsigned long long a8 = *(volatile LAS3 unsigned long long*)(shm + L_FLAG + 16);
        more = __builtin_amdgcn_readfirstlane((unsigned)a8 | (unsigned)(a8 >> 32)) != 0u;
    }
    if (more) {
        const unsigned kdst = lds0 + L_K + wid * 1024, vdst = lds0 + L_V + wid * 1024;
#define SB_DMA(t) do { glds16(ksrc + (long)(t) * KVB * DM, (unsigned)__builtin_amdgcn_readfirstlane(kdst + ((t) & 3) * SLOTB)); \
                       glds16(vsrc + (long)(t) * KVB * DM, (unsigned)__builtin_amdgcn_readfirstlane(vdst + ((t) & 3) * SLOTB)); } while (0)
        SB_DMA(T_lo - 1); if (T_lo >= 2) SB_DMA(T_lo - 2); if (T_lo >= 3) SB_DMA(T_lo - 3);
        bool walive = true;
        for (int jt = T_lo - 1; jt >= 0; --jt) {
            ATT_TILE_WAIT(jt, false);
            if (jt < T_lo - 1) { const unsigned long long a8 = *(volatile LAS3 unsigned long long*)(shm + L_FLAG + ((jt + 1) & 1) * 8);
                if (__builtin_amdgcn_readfirstlane((unsigned)a8 | (unsigned)(a8 >> 32)) == 0u) break; }
            if (jt >= 3) SB_DMA(jt - 3);
            if (walive) sb_tile(shm + L_K + (jt & 3) * SLOTB + kl, shm + L_V + (jt & 3) * SLOTB + vl, jt, qw0, r32, hi, qr, carry, o0, o1);
            walive = __any(carry != 0.f) != 0; if (lane == 0) fbytes[(jt & 1) * 8 + wid] = walive ? (unsigned char)1 : (unsigned char)0;
        }
#undef SB_DMA
    }
    ATT_WAIT_BAR();
    float sq = 0.f;
#pragma unroll
    for (int r = 0; r < 16; ++r) sq += o0[r] * o0[r] + o1[r] * o1[r];
    sq += other_half(sq);
    if (hi == 0) SS[(size_t)(rowbase + qw0 + r32) * 16 + hh] = sq;
    LAS3 unsigned char* stg = shm + L_OST + wid * OSTW;
#pragma unroll
    for (int g = 0; g < 4; ++g) {
        u32x2 w0; w0.x = cvtpk(o0[4 * g], o0[4 * g + 1]); w0.y = cvtpk(o0[4 * g + 2], o0[4 * g + 3]);
        u32x2 w1; w1.x = cvtpk(o1[4 * g], o1[4 * g + 1]); w1.y = cvtpk(o1[4 * g + 2], o1[4 * g + 3]);
        *(LAS3 u32x2*)(stg + r32 * 144 + g * 16 + hi * 8) = w0;
        *(LAS3 u32x2*)(stg + r32 * 144 + 64 + g * 16 + hi * 8) = w1;
    }
    asm volatile("s_waitcnt lgkmcnt(0)" ::: "memory");
    bf16_t* Ow = O + (rowbase + qw0) * DM + hh * 64;
#pragma unroll
    for (int i = 0; i < 4; ++i) { const int row = i * 8 + (lane >> 3), ch = lane & 7; const u32x4 v = *(const LAS3 u32x4*)(stg + row * 144 + ch * 16); *(u32x4*)(Ow + (long)row * DM + ch * 8) = v; }
    ATT_WAIT_BAR();
}
}

constexpr int NWAVES = 8;
constexpr int BATCH = 4, SEQ = 8192, DMODEL = 1024, MROWS = BATCH * SEQ, DFF = 2816, NUP = 2 * DFF, INC = 3080;
constexpr float RMS_EPS = 1e-6f, LOG2E = 1.4426950408889634f;
constexpr size_t MiB = 1u << 20;
constexpr size_t WS_WIN = 1 * MiB, WS_WOUT = 7 * MiB, WS_WUP = 9 * MiB, WS_WDN = 20 * MiB;
constexpr size_t WS_LF = 26 * MiB, WS_F2 = 27 * MiB, WS_SS = 28 * MiB, WS_PS = 30 * MiB, WS_PS2 = 32 * MiB, WS_HALO = 34 * MiB;
constexpr size_t WS_XN = 48 * MiB;
constexpr size_t WS_Q = 112 * MiB, WS_K = 176 * MiB, WS_V = 240 * MiB, WS_O = 304 * MiB;
constexpr size_t WS_U = 112 * MiB;
constexpr size_t WS_FS3 = 464 * MiB;
constexpr size_t WS_CTL = 0;
constexpr size_t WS_END = 468 * MiB;
constexpr int RING_BYTES = 131072, LDS_BYTES = 147456;
static_assert(att::L_END <= RING_BYTES && att::L_OST + 8 * att::OSTW <= att::L_FLAG && 14 * att::SLOTB <= att::L_FLAG, "attention LDS map");

#define LAS __attribute__((address_space(3)))
typedef unsigned short bf16;
typedef unsigned v4u __attribute__((ext_vector_type(4)));
typedef float f32x4 __attribute__((ext_vector_type(4)));
__device__ __forceinline__ unsigned f2bf(float f) { unsigned u = __builtin_bit_cast(unsigned, f); return (u + 0x7fffu + ((u >> 16) & 1u)) >> 16; }
__device__ __forceinline__ unsigned pk2(float lo, float hi) { return f2bf(lo) | (f2bf(hi) << 16); }
__device__ __forceinline__ float bf2f(unsigned short h) { return __builtin_bit_cast(float, (unsigned)h << 16); }
__device__ __forceinline__ float wave_sum(float v) {
#pragma unroll
    for (int o = 1; o < 64; o <<= 1) v += __shfl_xor(v, o);
    return v;
}
#define LDS_WAIT() asm volatile("s_waitcnt lgkmcnt(0)" ::: "memory")

#define XB_TMO      128
#define XB_XCNT(j)  (256  + 64 * (j))
#define XB_XSUB(j)  (1280 + 64 * (j))
#define XB_XGEN(j)  (2304 + 64 * (j))
#define XB_TOP      3328
#define XB_TOPGEN   3392
#define XCD_BAR_WORDS 3456
#define XB_SPIN_CAP (1u << 18)

__device__ __forceinline__ unsigned xb_ld(unsigned* p)              { return __hip_atomic_load(p, __ATOMIC_RELAXED, __HIP_MEMORY_SCOPE_AGENT); }
__device__ __forceinline__ unsigned xb_add(unsigned* p, unsigned v) { return __hip_atomic_fetch_add(p, v, __ATOMIC_RELAXED, __HIP_MEMORY_SCOPE_AGENT); }
__device__ __forceinline__ unsigned xb_xcc_id() { return (unsigned)__builtin_amdgcn_s_getreg((3 << 11) | 20) & 0xFu; }
#define XB_SPIN(cond, bar) do { unsigned _sp = 0; while (cond) { __builtin_amdgcn_s_sleep(1); \
    if ((++_sp & 255u) == 0u) { if (xb_ld(&(bar)[XB_TMO])) break; if (_sp > XB_SPIN_CAP) { atomicAdd(&(bar)[XB_TMO], 1u); break; } } } } while (0)

struct XcdBarrier {
    unsigned* bar; unsigned x;
    volatile LAS unsigned* st;
};

__device__ __forceinline__ XcdBarrier xcd_barrier_post(unsigned* bar, volatile LAS unsigned* st) {
    XcdBarrier b; b.bar = bar; b.x = xb_xcc_id(); b.st = st;
    if (threadIdx.x == 0) (void)xb_add(&bar[XB_XCNT(b.x)], 1u);
    return b;
}
__device__ __forceinline__ void xcd_barrier_complete(unsigned* bar, unsigned x, unsigned& nloc, unsigned& nx) {
    const unsigned G = gridDim.x * gridDim.y * gridDim.z;
    unsigned sum, cnt, mine, sp = 0u;
    for (;;) {
        sum = 0u; cnt = 0u; mine = 0u;
#pragma unroll
        for (unsigned j = 0; j < 16; ++j) { const unsigned c = xb_ld(&bar[XB_XCNT(j)]); sum += c; cnt += (c > 0u) ? 1u : 0u; mine = (j == x) ? c : mine; }
        if (sum == G) break;
        __builtin_amdgcn_s_sleep(1);
        if ((++sp & 255u) == 0u) { if (xb_ld(&bar[XB_TMO])) break; if (sp > XB_SPIN_CAP) { atomicAdd(&bar[XB_TMO], 1u); break; } }
    }
    nloc = mine > 0u ? mine : 1u; nx = cnt > 0u ? cnt : 1u;
}

__device__ __forceinline__ void xcd_barrier(const XcdBarrier& b) {
    asm volatile("s_waitcnt vmcnt(0)" ::: "memory");
    __syncthreads();
    if (threadIdx.x == 0) {
        unsigned* bar = b.bar;
        __builtin_amdgcn_s_waitcnt(0);
        unsigned nloc = b.st[0], nx = b.st[1];
        if (nloc == 0u) { xcd_barrier_complete(bar, b.x, nloc, nx); b.st[0] = nloc; b.st[1] = nx; }
        const unsigned old = xb_add(&bar[XB_XSUB(b.x)], 1u);
        const unsigned gen = old / nloc;
        if (old + 1u == (gen + 1u) * nloc) {
            __builtin_amdgcn_fence(__ATOMIC_RELEASE, "agent");
            asm volatile("s_waitcnt vmcnt(0)" ::: "memory");
            const unsigned og = xb_add(&bar[XB_TOP], 1u);
            const unsigned tg = og / nx;
            if (og + 1u == (tg + 1u) * nx) xb_add(&bar[XB_TOPGEN], 1u);
            else XB_SPIN(xb_ld(&bar[XB_TOPGEN]) == tg, bar);
            __builtin_amdgcn_fence(__ATOMIC_ACQUIRE, "agent");
            xb_add(&bar[XB_XGEN(b.x)], 1u);
            asm volatile("s_waitcnt vmcnt(0)" ::: "memory");
        } else {
            XB_SPIN(xb_ld(&bar[XB_XGEN(b.x)]) == gen, bar);
            __builtin_amdgcn_fence(__ATOMIC_ACQUIRE, "agent");
            asm volatile("s_waitcnt vmcnt(0)" ::: "memory");
        }
    }
    __syncthreads();
}

struct Args { const float* in[13]; float* out; unsigned char* ws; int coop_sync; int pad; };

__device__ __forceinline__ void transpose_item(const float* W, int ldw, int K, int srccol0, bf16* WT, int dstrow0, const float* gain, LAS float* scr, int kb, int nb, int lane) {
    const int k0 = 64 * kb, n0 = 32 * nb;
#pragma unroll
    for (int i = 0; i < 32; ++i) { const int kk = 2 * i + (lane >> 5); float w = W[(size_t)(k0 + kk) * ldw + srccol0 + n0 + (lane & 31)]; if (gain) w *= gain[k0 + kk]; scr[kk * 33 + (lane & 31)] = w; }
    LDS_WAIT(); asm volatile("" ::: "memory");
    const int c = lane & 7;
#pragma unroll
    for (int j = 0; j < 4; ++j) { const int n = (lane >> 3) + 8 * j; const LAS float* s = scr + (8 * c) * 33 + n;
        v4u o; o.x = pk2(s[0 * 33], s[1 * 33]); o.y = pk2(s[2 * 33], s[3 * 33]); o.z = pk2(s[4 * 33], s[5 * 33]); o.w = pk2(s[6 * 33], s[7 * 33]);
        *(v4u*)(WT + (size_t)(dstrow0 + n0 + n) * K + k0 + 8 * c) = o; }
    LDS_WAIT(); asm volatile("" ::: "memory");
}

__device__ __forceinline__ float log_sigmoid(float y) { return fminf(y, 0.f) - log1pf(expf(-fabsf(y))); }

__global__ void __launch_bounds__(NWAVES * 64, 2) fwd_megakernel(Args args) {
    extern __shared__ __attribute__((aligned(16))) unsigned char lds_raw[];
    LAS unsigned char* lds = (LAS unsigned char*)lds_raw;
    const int tid = threadIdx.x, lane = tid & 63, wave = __builtin_amdgcn_readfirstlane(tid >> 6);
    const int G = gridDim.x; const int bx = blockIdx.x; const int vcu = (G % 8 == 0) ? (bx % 8) * (G / 8) + bx / 8 : bx;
    const float* x = args.in[0]; const float* attn_g = args.in[1]; const float* w_in = args.in[2]; const float* fbias = args.in[3];
    const float* fox_g = args.in[4]; const float* sb_g = args.in[5]; const float* w_out = args.in[6]; const float* ffn_g = args.in[7];
    const float* w_up = args.in[8]; const float* conv_w = args.in[9]; const float* conv_b = args.in[10]; const float* w_down = args.in[11]; const float* final_g = args.in[12];
    float* out = args.out; unsigned char* ws = args.ws;
    bf16* Win_t = (bf16*)(ws + WS_WIN); bf16* Wout_t = (bf16*)(ws + WS_WOUT); bf16* Wup_t = (bf16*)(ws + WS_WUP); bf16* Wdn_t = (bf16*)(ws + WS_WDN);
    float* LF = (float*)(ws + WS_LF); float* F2 = (float*)(ws + WS_F2); float* SS = (float*)(ws + WS_SS); float* PS = (float*)(ws + WS_PS); float* PS2 = (float*)(ws + WS_PS2);
    float* HALO4 = (float*)(ws + WS_HALO); bf16* XN = (bf16*)(ws + WS_XN); bf16* QB = (bf16*)(ws + WS_Q); bf16* KB = (bf16*)(ws + WS_K); bf16* VB = (bf16*)(ws + WS_V); bf16* OB = (bf16*)(ws + WS_O);
    bf16* UB = (bf16*)(ws + WS_U); bf16* FS3 = (bf16*)(ws + WS_FS3); unsigned* CTL = (unsigned*)(ws + WS_CTL);
    const int gw = vcu * NWAVES + wave, NGW = G * NWAVES;
    volatile LAS unsigned* xst = (volatile LAS unsigned*)(lds + LDS_BYTES - 16);
    if (tid == 0) { xst[0] = 0u; xst[1] = 0u; }
    unsigned* XBAR = (unsigned*)(ws + WS_CTL + 262144);
    __syncthreads();
    XcdBarrier xbar = xcd_barrier_post(XBAR, xst);

    {
        LAS float* scr = (LAS float*)(lds + wave * 16384);
        constexpr int I_IN = 16 * 96, I_OUT = 16 * 32, I_UP = 16 * 176, I_DN = 44 * 32, NITEMS = I_IN + I_OUT + I_UP + I_DN;
        for (int it = gw; it < NITEMS; it += NGW) {
            int r = it;
            if (r < I_IN) { const int kb = r / 96, nb = r % 96, seg = nb >> 4, nbs = nb & 15;
                const int srcc = (seg == 0) ? 0 : (seg == 1) ? 1544 : (seg == 2) ? 512 : (seg == 3) ? 2056 : (seg == 4) ? 1024 : 2568;
                transpose_item(w_in, INC, 1024, srcc, Win_t, seg * 512, nullptr, scr, kb, nbs, lane); continue; } r -= I_IN;
            if (r < I_OUT) { const int kb = r / 32, nb = r % 32; transpose_item(w_out, 1024, 1024, 0, Wout_t, 0, (kb < 8) ? fox_g : (sb_g - 512), scr, kb, nb, lane); continue; } r -= I_OUT;
            if (r < I_UP) { const int kb = r / 176, nb = r % 176, pn = nb >> 3, jb = nb & 7; const int srcc = (jb < 4) ? 128 * pn + 32 * jb : DFF + 128 * pn + 32 * (jb - 4);
                transpose_item(w_up, NUP, 1024, srcc - 32 * nb, Wup_t, 0, ffn_g, scr, kb, nb, lane); continue; } r -= I_UP;
            { const int kb = r / 32, nb = r % 32; transpose_item(w_down, 1024, DFF, 0, Wdn_t, 0, nullptr, scr, kb, nb, lane); }
        }
        __syncthreads();
        LAS float* Wf = (LAS float*)lds;
        for (int i = tid; i < 1024 * 8; i += NWAVES * 64) Wf[i] = w_in[(size_t)(i >> 3) * INC + 1536 + (i & 7)];
        __syncthreads();
        f32x4 gv[4];
#pragma unroll
        for (int j = 0; j < 4; ++j) gv[j] = ((const f32x4*)attn_g)[lane + 64 * j];
        f32x4 vn[4];
        if (gw < MROWS) { const f32x4* xr = (const f32x4*)(x + (size_t)gw * DMODEL) + lane;
#pragma unroll
            for (int j = 0; j < 4; ++j) vn[j] = xr[64 * j]; }
        for (int m = gw; m < MROWS; m += NGW) {
            f32x4 v[4]; float s2 = 0.f;
#pragma unroll
            for (int j = 0; j < 4; ++j) { v[j] = vn[j]; s2 += (v[j].x * v[j].x + v[j].y * v[j].y) + (v[j].z * v[j].z + v[j].w * v[j].w); }
            if (m + NGW < MROWS) { const f32x4* xr = (const f32x4*)(x + (size_t)(m + NGW) * DMODEL) + lane;
#pragma unroll
                for (int j = 0; j < 4; ++j) vn[j] = xr[64 * j]; }
            const float rstd = 1.0f / sqrtf(wave_sum(s2) * (1.0f / DMODEL) + RMS_EPS);
            unsigned long long* o8 = (unsigned long long*)(XN + (size_t)m * DMODEL) + lane;
            float fa[8];
#pragma unroll
            for (int e = 0; e < 8; ++e) fa[e] = 0.f;
#pragma unroll
            for (int j = 0; j < 4; ++j) { v[j] = v[j] * rstd * gv[j];
                o8[64 * j] = (unsigned long long)pk2(v[j].x, v[j].y) | ((unsigned long long)pk2(v[j].z, v[j].w) << 32);
#pragma unroll
                for (int i = 0; i < 4; ++i) { const int k = 256 * j + 4 * lane + i; const f32x4 wa = *(const LAS f32x4*)(Wf + k * 8), wb = *(const LAS f32x4*)(Wf + k * 8 + 4); const float hk = v[j][i];
                    fa[0] += hk * wa[0]; fa[1] += hk * wa[1]; fa[2] += hk * wa[2]; fa[3] += hk * wa[3]; fa[4] += hk * wb[0]; fa[5] += hk * wb[1]; fa[6] += hk * wb[2]; fa[7] += hk * wb[3]; } }
            float r4[4], r2[2], r1;
            { const bool h = (lane & 32) != 0;
#pragma unroll
              for (int e = 0; e < 4; ++e) { const float snd = h ? fa[e] : fa[e + 4], kp = h ? fa[e + 4] : fa[e]; r4[e] = kp + __shfl_xor(snd, 32); } }
            { const bool h = (lane & 16) != 0;
#pragma unroll
              for (int e = 0; e < 2; ++e) { const float snd = h ? r4[e] : r4[e + 2], kp = h ? r4[e + 2] : r4[e]; r2[e] = kp + __shfl_xor(snd, 16); } }
            { const bool h = (lane & 8) != 0; const float snd = h ? r2[0] : r2[1], kp = h ? r2[1] : r2[0]; r1 = kp + __shfl_xor(snd, 8); }
            r1 += __shfl_xor(r1, 4); r1 += __shfl_xor(r1, 2); r1 += __shfl_xor(r1, 1);
            if ((lane & 7) == 0) { const int e = lane >> 3; LF[(size_t)m * 8 + e] = log_sigmoid(r1 + fbias[e]); }
        }
    }
    xcd_barrier(xbar);

    {
        LAS float* wtot = (LAS float*)lds;
        for (int bh = bx; bh < 32; bh += G) {
            const int b = bh >> 3, h = bh & 7; const float* src = LF + ((size_t)b * SEQ) * 8 + h;
            float loc[16]; float s = 0.f;
#pragma unroll
            for (int i = 0; i < 16; ++i) { s += src[(size_t)(tid * 16 + i) * 8]; loc[i] = s; }
            float incl = s;
#pragma unroll
            for (int o = 1; o < 64; o <<= 1) { const float t = __shfl_up(incl, o); if (lane >= o) incl += t; }
            if (lane == 63) wtot[wave] = incl;
            __syncthreads();
            float base = incl - s;
            for (int w = 0; w < wave; ++w) base += wtot[w];
            float* dst = F2 + (size_t)bh * SEQ + tid * 16;
#pragma unroll
            for (int i = 0; i < 16; ++i) { const float f = (base + loc[i]) * LOG2E; dst[i] = f;
                const float nf = -f; const unsigned h1 = f2bf(nf); const float r1 = nf - __builtin_bit_cast(float, h1 << 16); const unsigned h2 = f2bf(r1); const float r2 = r1 - __builtin_bit_cast(float, h2 << 16); const unsigned h3 = f2bf(r2);
                v4u o; o.x = h1 | (h2 << 16); o.y = h3; o.z = 0u; o.w = 0u; *(v4u*)(FS3 + ((size_t)bh * SEQ + tid * 16 + i) * 8) = o; }
            __syncthreads();
        }
        pg8::Gemm g{XN, Win_t, MROWS, 3072, 1024, 1024}; pg8::StaticOrder S; S.init(MROWS, 3072, G, bx);
        pg8::EpiQKV E{QB, 1024, 1024, (size_t)(WS_K - WS_Q) / 2, att::C2, CTL + 64};
        pg8::gemm_phase<pg8::EpiQKV, pg8::StaticOrder, true, true>(lds, g, S, E);
    }
    xcd_barrier(xbar);

    {
        volatile LAS unsigned* qw = (volatile LAS unsigned*)(lds + att::L_FLAG + 64);
        for (;;) {
            if (tid == 0) qw[0] = atomicAdd(CTL, 1u);
            __syncthreads();
            const unsigned idx = qw[0];
            if (idx >= 2048u) break;
            if (idx < 1024u) { const int qb = 31 - (int)(idx >> 5), bh = (int)(idx & 31);
                att::fox_unit(bh >> 3, bh & 7, qb, QB, KB, VB, OB, F2, FS3, CTL + 64, SS, lds); }
            else { const int u = (int)idx - 1024, qb = 31 - (u >> 5), bh = u & 31;
                att::sb_unit(bh >> 3, 8 + (bh & 7), qb, QB, KB, VB, OB, SS, lds); }
        }
    }
    xcd_barrier(xbar);

    {
        pg8::Gemm g{OB, Wout_t, MROWS, 1024, 1024, 1024}; pg8::StaticOrder S; S.init(MROWS, 1024, G, bx);
        LAS float* tab = (LAS float*)(lds + RING_BYTES);
        { pg8::Unit u; for (int ui = 0; ui < 7 && S.next(ui, u); ++ui) if (tid < 256) {
              const float* p = SS + (size_t)(u.pm * 256 + tid) * 16;
              const f32x4 a = *(const f32x4*)p, b = *(const f32x4*)(p + 4), c = *(const f32x4*)(p + 8), d = *(const f32x4*)(p + 12);
              const float sf = ((a[0] + a[1]) + (a[2] + a[3])) + ((b[0] + b[1]) + (b[2] + b[3])), ss = ((c[0] + c[1]) + (c[2] + c[3])) + ((d[0] + d[1]) + (d[2] + d[3]));
              const float rf = 1.0f / sqrtf(sf * (1.0f / 512.0f) + RMS_EPS), rs = 1.0f / sqrtf(ss * (1.0f / 512.0f) + RMS_EPS);
              tab[(ui * 256 + tid) * 2] = rf / rs; tab[(ui * 256 + tid) * 2 + 1] = rs; }
          __syncthreads(); }
        pg8::EpiOut E{x, out, XN, tab, PS};
        pg8::gemm_phase<pg8::EpiOut, pg8::StaticOrder, true, true>(lds, g, S, E);
    }
    xcd_barrier(xbar);

    {
        pg8::Gemm g{XN, Wup_t, MROWS, NUP, 1024, 1024}; pg8::StaticOrder S; S.init(MROWS, NUP, G, bx);
        float* RSTD1 = (float*)(ws + WS_CTL + 65536);
        { pg8::Unit u; for (int ui = 0; S.next(ui, u); ++ui) if (tid < 256) { const int r = u.pm * 256 + tid; RSTD1[r] = __builtin_amdgcn_rsqf(pg8::sum16(PS + (size_t)r * 16) * (1.0f / 1024.0f) + RMS_EPS); }
          __syncthreads(); }
        pg8::EpiUpConv E{UB, RSTD1, HALO4, conv_w, conv_b, (LAS float*)(lds + RING_BYTES)};
        pg8::gemm_phase<pg8::EpiUpConv, pg8::StaticOrder, true, true>(lds, g, S, E);
    }
    xcd_barrier(xbar);

    {
        for (int idx = bx * (NWAVES * 64) + tid; idx < 128 * 2 * 704; idx += G * NWAVES * 64) {
            const int pm = idx / 1408, rem = idx % 1408, t = rem / 704, c4 = (rem % 704) * 4;
            const bool first = (pm & 31) == 0;
            const float* h0 = HALO4 + (size_t)(pm * 4) * 5632; const float* hp = HALO4 + (size_t)((first ? pm : pm - 1) * 4) * 5632;
            const f32x4 z = {0.f, 0.f, 0.f, 0.f};
            f32x4 ug[3], uv[3];
            ug[2] = *(const f32x4*)(h0 + t * 5632 + c4); uv[2] = *(const f32x4*)(h0 + t * 5632 + DFF + c4);
            if (t == 1) { ug[1] = *(const f32x4*)(h0 + c4); uv[1] = *(const f32x4*)(h0 + DFF + c4); } else { ug[1] = first ? z : *(const f32x4*)(hp + 3 * 5632 + c4); uv[1] = first ? z : *(const f32x4*)(hp + 3 * 5632 + DFF + c4); }
            { const int pr = (t == 1) ? 3 : 2; ug[0] = first ? z : *(const f32x4*)(hp + pr * 5632 + c4); uv[0] = first ? z : *(const f32x4*)(hp + pr * 5632 + DFF + c4); }
            f32x4 og = *(const f32x4*)(conv_b + c4), ov = *(const f32x4*)(conv_b + DFF + c4);
#pragma unroll
            for (int k = 0; k < 3; ++k) { og += *(const f32x4*)(conv_w + (size_t)k * NUP + c4) * ug[k]; ov += *(const f32x4*)(conv_w + (size_t)k * NUP + DFF + c4) * uv[k]; }
            float res[4];
#pragma unroll
            for (int i = 0; i < 4; ++i) res[i] = og[i] / (1.0f + __expf(-og[i])) * ov[i];
            unsigned long long o = (unsigned long long)pk2(res[0], res[1]) | ((unsigned long long)pk2(res[2], res[3]) << 32);
            *(unsigned long long*)(UB + (size_t)(pm * 256 + t) * DFF + c4) = o;
        }
    }
    xcd_barrier(xbar);

    {
        pg8::Gemm g{UB, Wdn_t, MROWS, 1024, DFF, DFF}; pg8::StaticOrder S; S.init(MROWS, 1024, G, bx);
        pg8::EpiDown E{out, out, PS2};
        pg8::gemm_phase<pg8::EpiDown, pg8::StaticOrder, true, true>(lds, g, S, E);
    }
    xcd_barrier(xbar);

    {
        int lane6 = threadIdx.x & 63; asm volatile("" : "+v"(lane6));
        f32x4 gv[4];
#pragma unroll
        for (int j = 0; j < 4; ++j) gv[j] = ((const f32x4*)final_g)[lane6 + 64 * j];
        for (int m = gw; m < MROWS; m += NGW) {
            const float rstd = 1.0f / sqrtf(pg8::sum16(PS2 + (size_t)m * 16) * (1.0f / DMODEL) + RMS_EPS);
            f32x4* xr = (f32x4*)(out + (size_t)m * DMODEL) + lane6;
#pragma unroll
            for (int j = 0; j < 4; ++j) { const f32x4 v = xr[64 * j]; xr[64 * j] = v * rstd * gv[j]; }
        }
    }
    if (args.coop_sync) cg::this_grid().sync();
}

extern "C" void kernel_launch(void* const* d_in, const int* in_sizes, int n_in, void* d_out, int out_size, void* d_ws, size_t ws_size, hipStream_t stream) {
    static int grid = 0;
    if (grid == 0) {
        if (n_in != 13 || ws_size < WS_END) { fprintf(stderr, "kernel_launch: unexpected inputs (n_in %d, ws %zu)\n", n_in, ws_size); grid = -1; return; }
        int dev = 0, cus = 0, per_cu = 0;
        hipGetDevice(&dev); hipDeviceGetAttribute(&cus, hipDeviceAttributeMultiprocessorCount, dev);
        hipFuncSetAttribute((const void*)fwd_megakernel, hipFuncAttributeMaxDynamicSharedMemorySize, LDS_BYTES);
        hipOccupancyMaxActiveBlocksPerMultiprocessor(&per_cu, (const void*)fwd_megakernel, NWAVES * 64, LDS_BYTES);
        (void)hipGetLastError();
        if (per_cu < 1) per_cu = 1;
        grid = cus * per_cu; if (grid > 256) grid = 256;
    }
    if (grid < 0) return;
    if (hipMemsetAsync((unsigned char*)d_ws + WS_CTL, 0, 262144 + 16384, stream) != hipSuccess) { fprintf(stderr, "kernel_launch: hipMemsetAsync failed\n"); return; }
    Args a{};
    for (int i = 0; i < 13; ++i) a.in[i] = (const float*)d_in[i];
    a.out = (float*)d_out; a.ws = (unsigned char*)d_ws;
    void* kargs[] = {&a};
    hipError_t e = hipLaunchCooperativeKernel((const void*)fwd_megakernel, dim3(grid), dim3(NWAVES * 64), kargs, LDS_BYTES, stream);
    if (e != hipSuccess) fprintf(stderr, "cooperative launch failed: %s (grid %d)\n", hipGetErrorString(e), grid);
}
```

```cpp
#include <hip/hip_runtime.h>
#include <hip/hip_cooperative_groups.h>
#include <cstdio>
#include <cstdint>
#include <cmath>
namespace cg = cooperative_groups;
namespace pg8 {
#define PG8_LAS __attribute__((address_space(3)))
typedef unsigned short bf16_t;
typedef short bf16x8 __attribute__((ext_vector_type(8)));
typedef float f32x4 __attribute__((ext_vector_type(4)));
typedef unsigned u32x4 __attribute__((ext_vector_type(4)));
constexpr int BM = 256, BK = 64, HALF = 128, HTB = HALF * BK * 2  , STAGE_BYTES = 8 * HTB, NXCD = 8, WGM = 8;

__host__ __device__ __forceinline__ int lds_byte(int r, int c) { const int st = (r >> 4) * 2 + (c >> 5), rr = r & 15, cc = c & 31, ob = rr * 64 + cc * 2; return st * 1024 + (ob ^ (((ob >> 9) & 1) << 5)); }
__host__ __device__ __forceinline__ void stage_rc(int b, int& R, int& C) { const int st = b / 1024, sb = b % 1024, swz = sb ^ (((sb >> 9) & 1) << 5); R = (st >> 1) * 16 + swz / 64; C = (st & 1) * 32 + (swz % 64) / 2; }
__host__ __device__ __forceinline__ int perm32(int rho) { const int n = rho >> 4, i = rho & 15; return 8 * (i >> 2) + 4 * n + (i & 3); }

struct Unit { int pm, pn, idx; };
struct Gemm { const bf16_t* A; const bf16_t* Bt; int M, N, K, lda; };

struct StaticOrder {
    int nM, nN, nwg, G, c;
    __host__ __device__ void init(int M, int N, int G_, int c_) { nM = M / BM; nN = N / BM; nwg = nM * nN; G = G_; c = c_; }
    __host__ __device__ bool next(int i, Unit& u) const {
        const long L = (long)i * G + c; if (L >= nwg) return false;
        int wgid = (int)L; { const int q = nwg / NXCD, r = nwg % NXCD, xcd = wgid % NXCD, off = wgid / NXCD; wgid = (xcd < r ? xcd * (q + 1) : r * (q + 1) + (xcd - r) * q) + off; }
        const int nig = WGM * nN, gid = wgid / nig, fm = gid * WGM, gsz = (nM - fm) < WGM ? (nM - fm) : WGM;
        u.pm = fm + ((wgid % nig) % gsz); u.pn = (wgid % nig) / gsz; u.idx = i; return true;
    }
    __device__ __forceinline__ void a_ready(const Unit&) const {}
    __device__ __forceinline__ void done(const Unit&) const {}
};

__device__ __forceinline__ unsigned cvt_pk_bf16(float lo, float hi) { unsigned r; asm volatile("v_cvt_pk_bf16_f32 %0, %1, %2" : "=v"(r) : "v"(lo), "v"(hi)); return r; }
typedef float f32x2 __attribute__((ext_vector_type(2)));

typedef unsigned u32x2 __attribute__((ext_vector_type(2)));
constexpr float RMS_EPS = 1e-6f;
__device__ __forceinline__ float sum16(const float* p) {
    const f32x4 a = *(const f32x4*)p, b = *(const f32x4*)(p + 4), c = *(const f32x4*)(p + 8), d = *(const f32x4*)(p + 12);
    return ((a[0] + a[1]) + (a[2] + a[3])) + ((b[0] + b[1]) + (b[2] + b[3])) + ((c[0] + c[1]) + (c[2] + c[3])) + ((d[0] + d[1]) + (d[2] + d[3]));
}

struct EpiQKV {
    static constexpr bool PERM = true, AFTER_DRAIN = false, HAS_MID = false;
    bf16_t* O; int ldc; int split_cols; size_t split_stride; float scale0; unsigned* kmax;
    __device__ __forceinline__ void operator()(f32x4 (&acc)[2][2][4][2], const Unit& u, int wr, int wc, int fr, int fq) const {
        const int row0 = u.pm * BM + wr * 64 + fr; int colt = u.pn * BM; bf16_t* base = O;
        float sc = 1.f; const int t = colt / split_cols; { base += (size_t)t * split_stride; colt -= t * split_cols; if (t == 0) sc = scale0; }
        const int col0 = colt + wc * 32 + 8 * fq;
        const bool knorm = (t == 1) && (colt < 512);
        float hm[2] = {0.f, 0.f};
#pragma unroll
        for (int ai = 0; ai < 2; ++ai)
#pragma unroll
            for (int m = 0; m < 4; ++m) { bf16_t* rowp = base + (size_t)(row0 + ai * HALF + m * 16) * ldc + col0;
#pragma unroll
                for (int bj = 0; bj < 2; ++bj) { f32x4 v0 = acc[ai][bj][m][0] * sc, v1 = acc[ai][bj][m][1] * sc;
                    u32x4 w; w.x = cvt_pk_bf16(v0[0], v0[1]); w.y = cvt_pk_bf16(v0[2], v0[3]); w.z = cvt_pk_bf16(v1[0], v1[1]); w.w = cvt_pk_bf16(v1[2], v1[3]);
                    *(u32x4*)(rowp + bj * HALF) = w;
                    if (knorm) { float s = ((v0[0] * v0[0] + v0[1] * v0[1]) + (v0[2] * v0[2] + v0[3] * v0[3])) + ((v1[0] * v1[0] + v1[1] * v1[1]) + (v1[2] * v1[2] + v1[3] * v1[3]));
                        s += __shfl_xor(s, 16); s += __shfl_xor(s, 32); hm[bj] = fmaxf(hm[bj], s); } } }
        if (knorm) {
#pragma unroll
            for (int o = 1; o < 16; o <<= 1) { hm[0] = fmaxf(hm[0], __shfl_xor(hm[0], o)); hm[1] = fmaxf(hm[1], __shfl_xor(hm[1], o)); }
            if (fr == 0 && fq == 0) { const int b = (u.pm * BM) >> 13;
                atomicMax(kmax + b * 8 + ((colt + wc * 32) >> 6), __float_as_uint(hm[0])); atomicMax(kmax + b * 8 + ((colt + 128 + wc * 32) >> 6), __float_as_uint(hm[1])); } }
    }
};

#define PG8_DPP(v, ctrl) __builtin_bit_cast(float, __builtin_amdgcn_update_dpp(0, __builtin_bit_cast(int, (v)), (ctrl), 0xf, 0xf, true))
struct EpiUpConv {
    static constexpr bool PERM = true, AFTER_DRAIN = false, HAS_MID = false;
    bf16_t* G; const float* PS  ; float* HALO4; const float* cw; const float* cb; PG8_LAS float* hal;
    __device__ __forceinline__ void operator()(f32x4 (&acc)[2][2][4][2], const Unit& u, int wr, int wc, int fr_, int fq_) const {
        int fr = fr_, fq = fq_; asm volatile("" : "+v"(fr), "+v"(fq));
        const int row0 = u.pm * BM + wr * 64 + fr; const int colw = wc * 32 + 8 * fq; const int c0 = u.pn * 128;
#pragma unroll
        for (int ai = 0; ai < 2; ++ai)
#pragma unroll
            for (int m = 0; m < 4; ++m) { const int r = row0 + ai * HALF + m * 16; const float rs = *(const float*)((const char*)PS + (unsigned)r * 4u);
#pragma unroll
                for (int bj = 0; bj < 2; ++bj)
#pragma unroll
                    for (int n = 0; n < 2; ++n) acc[ai][bj][m][n] = acc[ai][bj][m][n] * rs;
                asm volatile("" ::: "memory"); __builtin_amdgcn_sched_barrier(0); }
        f32x4 W[2][4];
#define PG8_LDW(BUF, N_, BJ_) do { const unsigned ch_ = (unsigned)((BJ_) * 2816 + c0 + colw + 4 * (N_)) * 4u; \
            W[BUF][0] = *(const f32x4*)((const char*)cw + ch_); W[BUF][1] = *(const f32x4*)((const char*)cw + 5632u * 4u + ch_); \
            W[BUF][2] = *(const f32x4*)((const char*)cw + 2u * 5632u * 4u + ch_); W[BUF][3] = *(const f32x4*)((const char*)cb + ch_); } while (0)
        PG8_LDW(0, 0, 0);
        if (fr >= 14) {
#pragma unroll
            for (int ai = 0; ai < 2; ++ai)
#pragma unroll
                for (int bj = 0; bj < 2; ++bj)
#pragma unroll
                    for (int n = 0; n < 2; ++n) *(PG8_LAS f32x4*)(hal + (((ai * 2 + wr) * 2 + (fr - 14)) * 256 + bj * 128 + colw + 4 * n)) = acc[ai][bj][3][n];
            if (wr == 1) {
#pragma unroll
                for (int bj = 0; bj < 2; ++bj)
#pragma unroll
                    for (int n = 0; n < 2; ++n) *(f32x4*)(HALO4 + (size_t)(u.pm * 4 + 2 + (fr - 14)) * 5632 + bj * 2816 + c0 + colw + 4 * n) = acc[1][bj][3][n]; }
        }
        if (wr == 0 && fr < 2) {
#pragma unroll
            for (int bj = 0; bj < 2; ++bj)
#pragma unroll
                for (int n = 0; n < 2; ++n) *(f32x4*)(HALO4 + (size_t)(u.pm * 4 + fr) * 5632 + bj * 2816 + c0 + colw + 4 * n) = acc[0][bj][0][n]; }
        asm volatile("s_waitcnt lgkmcnt(0)\n\ts_barrier" ::: "memory");
        const int hrow = (fr == 15) ? 1 : 0;
#pragma unroll
        for (int n = 0; n < 2; ++n) {
#pragma unroll
            for (int bj = 0; bj < 2; ++bj) {
                const int gi = n * 2 + bj;
                if (gi == 0) PG8_LDW(1, 0, 1); else if (gi == 1) PG8_LDW(0, 1, 0); else if (gi == 2) PG8_LDW(1, 1, 1);
                const f32x4 w0 = W[gi & 1][0], w1 = W[gi & 1][1], w2 = W[gi & 1][2], bb = W[gi & 1][3];
#pragma unroll
                for (int ai = 0; ai < 2; ++ai) {
                    f32x4 prev;
                    if (ai == 0 && wr == 0) prev = (f32x4){0.f, 0.f, 0.f, 0.f};
                    else prev = *(const PG8_LAS f32x4*)(hal + (((ai * 2 + wr - 1) * 2 + hrow) * 256 + bj * 128 + colw + 4 * n));
#pragma unroll
                    for (int m = 0; m < 4; ++m) { const f32x4 cur = acc[ai][bj][m][n]; f32x4 o;
#pragma unroll
                        for (int i = 0; i < 4; ++i) {
                            float s1, s2;
                            asm volatile("s_nop 1\n\tv_mov_b32_dpp %0, %2 row_ror:1 row_mask:0xf bank_mask:0xf\n\tv_mov_b32_dpp %1, %2 row_ror:2 row_mask:0xf bank_mask:0xf\n\t"
                                         "v_mov_b32_dpp %0, %3 row_shr:1 row_mask:0xf bank_mask:0xf\n\tv_mov_b32_dpp %1, %3 row_shr:2 row_mask:0xf bank_mask:0xf"
                                         : "=&v"(s1), "=&v"(s2) : "v"(prev[i]), "v"(cur[i]), "v"(w1[i]), "v"(w0[i]));
                            float t = bb[i] + w2[i] * cur[i] + w1[i] * s1 + w0[i] * s2; asm volatile("" : "+v"(t)); o[i] = t; }
                        acc[ai][bj][m][n] = o; prev = cur; __builtin_amdgcn_sched_barrier(0); }
                }
                asm volatile("" ::: "memory"); __builtin_amdgcn_sched_barrier(0);
            }
#pragma unroll
            for (int ai = 0; ai < 2; ++ai)
#pragma unroll
                for (int m = 0; m < 4; ++m) { int rowb = row0; asm volatile("" : "+v"(rowb)); const f32x4 cg = acc[ai][0][m][n], cv = acc[ai][1][m][n]; float res[4];
#pragma unroll
                    for (int i = 0; i < 4; ++i) { const float g = cg[i]; res[i] = g * __builtin_amdgcn_rcpf(1.0f + __builtin_amdgcn_exp2f(-1.4426950408889634f * g)) * cv[i]; }
                    u32x2 w; w.x = cvt_pk_bf16(res[0], res[1]); w.y = cvt_pk_bf16(res[2], res[3]);
                    const bool skip = (ai == 0) && (m == 0) && (wr == 0) && (fr < 2);
                    if (!skip) *(u32x2*)((char*)G + ((unsigned)(rowb + ai * HALF + m * 16) * 2816u + (unsigned)(c0 + colw + 4 * n)) * 2u) = w; __builtin_amdgcn_sched_barrier(0); }
            asm volatile("" ::: "memory");
        }
    }
};

struct EpiOut {
    static constexpr bool PERM = false, AFTER_DRAIN = false, HAS_MID = true;
    const float* X; float* X1; bf16_t* XB; const PG8_LAS float* tab; float* PS;
    __device__ __forceinline__ void mid(f32x4 (&acc)[2][2][4][2], const Unit& u, int wr, int wc, int fr, int fq) const {
        const PG8_LAS float* t = tab + (u.idx * 256 + wr * 64 + fr) * 2;
#pragma unroll
        for (int ai = 0; ai < 2; ++ai)
#pragma unroll
            for (int m = 0; m < 4; ++m) { const float ratio = t[(ai * HALF + m * 16) * 2];
#pragma unroll
                for (int bj = 0; bj < 2; ++bj)
#pragma unroll
                    for (int n = 0; n < 2; ++n) acc[ai][bj][m][n] = acc[ai][bj][m][n] * ratio; }
    }
    __device__ __forceinline__ void operator()(f32x4 (&acc)[2][2][4][2], const Unit& u, int wr, int wc, int fr, int fq) const {
        const int row0 = u.pm * BM + wr * 64 + fr; const int col0 = u.pn * BM + wc * 32 + 4 * fq;
        const PG8_LAS float* t = tab + (u.idx * 256 + wr * 64 + fr) * 2 + 1;
        f32x4 xn[2][2];
#pragma unroll
        for (int bj = 0; bj < 2; ++bj)
#pragma unroll
            for (int n = 0; n < 2; ++n) xn[bj][n] = *(const f32x4*)(X + (size_t)row0 * 1024 + col0 + bj * HALF + n * 16);
#pragma unroll
        for (int ai = 0; ai < 2; ++ai)
#pragma unroll
            for (int m = 0; m < 4; ++m) { const int r = row0 + ai * HALF + m * 16; const float rs = t[(ai * HALF + m * 16) * 2]; const size_t off = (size_t)r * 1024 + col0; float sq = 0.f;
                f32x4 xv[2][2];
#pragma unroll
                for (int bj = 0; bj < 2; ++bj)
#pragma unroll
                    for (int n = 0; n < 2; ++n) xv[bj][n] = xn[bj][n];
                if (ai * 4 + m < 7) { const int r2 = row0 + ((ai * 4 + m + 1) >> 2) * HALF + ((ai * 4 + m + 1) & 3) * 16;
#pragma unroll
                    for (int bj = 0; bj < 2; ++bj)
#pragma unroll
                        for (int n = 0; n < 2; ++n) xn[bj][n] = *(const f32x4*)(X + (size_t)r2 * 1024 + col0 + bj * HALF + n * 16); }
#pragma unroll
                for (int bj = 0; bj < 2; ++bj)
#pragma unroll
                    for (int n = 0; n < 2; ++n) { const size_t o2 = off + bj * HALF + n * 16; const f32x4 o = xv[bj][n] + acc[ai][bj][m][n] * rs;
                        *(f32x4*)(X1 + o2) = o; u32x2 w; w.x = cvt_pk_bf16(o[0], o[1]); w.y = cvt_pk_bf16(o[2], o[3]); *(u32x2*)(XB + o2) = w;
                        sq += (o[0] * o[0] + o[1] * o[1]) + (o[2] * o[2] + o[3] * o[3]); }
                sq += __shfl_xor(sq, 16); sq += __shfl_xor(sq, 32);
                if (fq == 0) PS[(size_t)r * 16 + u.pn * 4 + wc] = sq;
                asm volatile("" ::: "memory"); }
    }
};

struct EpiDown {
    static constexpr bool PERM = false, AFTER_DRAIN = false, HAS_MID = false;
    const float* X1; float* OUT; float* PS;
    __device__ __forceinline__ void operator()(f32x4 (&acc)[2][2][4][2], const Unit& u, int wr, int wc, int fr, int fq) const {
        const int row0 = u.pm * BM + wr * 64 + fr; const int col0 = u.pn * BM + wc * 32 + 4 * fq;
        f32x4 xn[2][2];
#pragma unroll
        for (int bj = 0; bj < 2; ++bj)
#pragma unroll
            for (int n = 0; n < 2; ++n) xn[bj][n] = *(const f32x4*)(X1 + (size_t)row0 * 1024 + col0 + bj * HALF + n * 16);
#pragma unroll
        for (int ai = 0; ai < 2; ++ai)
#pragma unroll
            for (int m = 0; m < 4; ++m) { const int r = row0 + ai * HALF + m * 16; const size_t off = (size_t)r * 1024 + col0; float sq = 0.f;
                f32x4 xv[2][2];
#pragma unroll
                for (int bj = 0; bj < 2; ++bj)
#pragma unroll
                    for (int n = 0; n < 2; ++n) xv[bj][n] = xn[bj][n];
                if (ai * 4 + m < 7) { const int r2 = row0 + ((ai * 4 + m + 1) >> 2) * HALF + ((ai * 4 + m + 1) & 3) * 16;
#pragma unroll
                    for (int bj = 0; bj < 2; ++bj)
#pragma unroll
                        for (int n = 0; n < 2; ++n) xn[bj][n] = *(const f32x4*)(X1 + (size_t)r2 * 1024 + col0 + bj * HALF + n * 16); }
#pragma unroll
                for (int bj = 0; bj < 2; ++bj)
#pragma unroll
                    for (int n = 0; n < 2; ++n) { const size_t o2 = off + bj * HALF + n * 16; const f32x4 o = xv[bj][n] + acc[ai][bj][m][n];
                        *(f32x4*)(OUT + o2) = o; sq += (o[0] * o[0] + o[1] * o[1]) + (o[2] * o[2] + o[3] * o[3]); }
                sq += __shfl_xor(sq, 16); sq += __shfl_xor(sq, 32);
                if (fq == 0) PS[(size_t)r * 16 + u.pn * 4 + wc] = sq;
                asm volatile("" ::: "memory"); }
    }
};
template <class Epi, class Sched, bool ALIGN_EPI = false, bool SP2 = false>
__device__ __forceinline__ void gemm_phase(PG8_LAS unsigned char* lds, const Gemm g, const Sched& S, const Epi& E) {
    int tid_ = threadIdx.x; asm volatile("" : "+v"(tid_));
    const int tid = tid_, wid = __builtin_amdgcn_readfirstlane(tid >> 6), lane = tid & 63, wr = wid >> 2, wc = wid & 3, fr = lane & 15, fq = lane >> 4;
    const int K = g.K, nt = K / BK;
    unsigned voffA[2], voffB[2];
#pragma unroll
    for (int i = 0; i < 2; ++i) { int R, C; stage_rc(tid * 16 + i * 8192, R, C); const int Rb = Epi::PERM ? ((R & ~31) + perm32(R & 31)) : R;
        voffA[i] = (unsigned)(R * g.lda + C) * 2u; voffB[i] = (unsigned)(Rb * K + C) * 2u; }
    const size_t kstep = (size_t)(BK * 2);
    const size_t hstepA = (size_t)HALF * g.lda * 2, hstepB = (size_t)HALF * K * 2;
    const size_t tstepA = 2 * hstepA, tstepB = 2 * hstepB;
    const unsigned ldsw = (unsigned)wid * 1024u;
    const int aoff = lds_byte(wr * 64 + fr, fq * 8), boff = lds_byte(wc * 32 + fr, fq * 8);
#define PG8_SA(b, h) (((b) * 2 + (h)) * HTB)
#define PG8_SB(b, h) ((4 + (b) * 2 + (h)) * HTB)
#define PG8_STAGE(bufoff, gbase, voff) do { _Pragma("unroll") for (int _i = 0; _i < 2; ++_i) \
        __builtin_amdgcn_global_load_lds((const unsigned*)((const char*)(gbase) + (voff)[_i]), (PG8_LAS unsigned*)(lds + (bufoff) + ldsw + _i * 8192), 16, 0, 0); } while (0)
#define PG8_LDA(dst, b, h) do { _Pragma("unroll") for (int m = 0; m < 4; ++m) _Pragma("unroll") for (int k = 0; k < 2; ++k) dst[m][k] = *(const PG8_LAS bf16x8*)(lds + PG8_SA(b, h) + aoff + m * 2048 + k * 1024); } while (0)
#define PG8_LDB(dst, b, h) do { _Pragma("unroll") for (int n = 0; n < 2; ++n) _Pragma("unroll") for (int k = 0; k < 2; ++k) dst[n][k] = *(const PG8_LAS bf16x8*)(lds + PG8_SB(b, h) + boff + n * 2048 + k * 1024); } while (0)
#define PG8_MMA(ai, bj, At, Bt) do { __builtin_amdgcn_s_setprio(1); _Pragma("unroll") for (int m = 0; m < 4; ++m) _Pragma("unroll") for (int n = 0; n < 2; ++n) _Pragma("unroll") for (int k = 0; k < 2; ++k) \
        acc[ai][bj][m][n] = __builtin_amdgcn_mfma_f32_16x16x32_bf16(Bt[n][k], At[m][k], acc[ai][bj][m][n], 0, 0, 0); __builtin_amdgcn_s_setprio(0); } while (0)
#define PG8_WAIT_V(n) asm volatile("s_waitcnt vmcnt(" #n ")" ::: "memory")
#define PG8_WAIT_L(n) asm volatile("s_waitcnt lgkmcnt(" #n ")" ::: "memory")
#define PG8_BAR __builtin_amdgcn_s_barrier()
#define PG8_SCHED __builtin_amdgcn_sched_barrier(0)
    Unit cur, nxt; int ui = 0;
    if (!S.next(0, cur)) return;
    f32x4 acc[2][2][4][2];
#pragma unroll
    for (int a = 0; a < 2; ++a)
#pragma unroll
        for (int b = 0; b < 2; ++b)
#pragma unroll
            for (int m = 0; m < 4; ++m)
#pragma unroll
                for (int n = 0; n < 2; ++n) acc[a][b][m][n] = (f32x4){0.f, 0.f, 0.f, 0.f};
    bf16x8 At[4][2], B0[2][2], B1[2][2];
    const char* cA = (const char*)g.A + (size_t)cur.pm * tstepA; const char* cB = (const char*)g.Bt + (size_t)cur.pn * tstepB;
    S.a_ready(cur);
    if constexpr (SP2) {
        PG8_STAGE(PG8_SB(0, 0), cB, voffB); PG8_STAGE(PG8_SB(0, 1), cB + hstepB, voffB); PG8_STAGE(PG8_SA(0, 0), cA, voffA); PG8_STAGE(PG8_SA(0, 1), cA + hstepA, voffA);
        if (wr == 1) PG8_BAR;
        PG8_WAIT_V(2); PG8_BAR;
        PG8_STAGE(PG8_SB(1, 0), cB + kstep, voffB); PG8_STAGE(PG8_SA(1, 0), cA + kstep, voffA); PG8_STAGE(PG8_SB(1, 1), cB + hstepB + kstep, voffB);
        PG8_WAIT_V(6); PG8_BAR;
    } else {
        PG8_STAGE(PG8_SB(0, 0), cB, voffB); PG8_STAGE(PG8_SA(0, 0), cA, voffA); PG8_STAGE(PG8_SB(0, 1), cB + hstepB, voffB); PG8_STAGE(PG8_SA(0, 1), cA + hstepA, voffA);
        if (wr == 1) PG8_BAR;
        PG8_WAIT_V(4); PG8_BAR;
        PG8_STAGE(PG8_SB(1, 0), cB + kstep, voffB); PG8_STAGE(PG8_SA(1, 0), cA + kstep, voffA); PG8_STAGE(PG8_SB(1, 1), cB + hstepB + kstep, voffB);
        PG8_WAIT_V(6); PG8_BAR;
    }
    for (;;) {
        const bool has_next = S.next(ui + 1, nxt);
        const char* nA = has_next ? (const char*)g.A + (size_t)nxt.pm * tstepA : cA; const char* nB = has_next ? (const char*)g.Bt + (size_t)nxt.pn * tstepB : cB;
        for (int t = 0; t < nt; t += 2) {
            if constexpr (Epi::HAS_MID) { if (t == (nt >> 1)) E.mid(acc, cur, wr, wc, fr, fq); }
            const bool last = (t == nt - 2);
            const char* a1 = cA + (size_t)(t + 1) * kstep;
            const char* a2 = last ? nA : cA + (size_t)(t + 2) * kstep; const char* b2 = last ? nB : cB + (size_t)(t + 2) * kstep;
            const char* a3 = a2 + kstep; const char* b3 = b2 + kstep;
            if (last && has_next) S.a_ready(nxt);
            if constexpr (SP2) {
            PG8_LDB(B0, 0, 0); PG8_LDB(B1, 0, 1); PG8_SCHED; PG8_LDA(At, 0, 0); PG8_STAGE(PG8_SA(1, 1), a1 + hstepA, voffA);
            PG8_WAIT_V(8); PG8_WAIT_L(0); PG8_BAR; PG8_MMA(0, 0, At, B0); PG8_MMA(0, 1, At, B1); PG8_BAR; PG8_SCHED;
            PG8_LDA(At, 0, 1); PG8_STAGE(PG8_SB(0, 0), b2, voffB); PG8_STAGE(PG8_SB(0, 1), b2 + hstepB, voffB); PG8_STAGE(PG8_SA(0, 0), a2, voffA);
            PG8_WAIT_V(8); PG8_WAIT_L(0); PG8_BAR; PG8_MMA(1, 0, At, B0); PG8_MMA(1, 1, At, B1); PG8_BAR; PG8_SCHED;
            PG8_LDB(B0, 1, 0); PG8_LDB(B1, 1, 1); PG8_SCHED; PG8_LDA(At, 1, 0); PG8_STAGE(PG8_SA(0, 1), a2 + hstepA, voffA);
            PG8_WAIT_V(8); PG8_WAIT_L(0); PG8_BAR; PG8_MMA(0, 0, At, B0); PG8_MMA(0, 1, At, B1); PG8_BAR; PG8_SCHED;
            PG8_LDA(At, 1, 1); PG8_STAGE(PG8_SB(1, 0), b3, voffB); PG8_STAGE(PG8_SB(1, 1), b3 + hstepB, voffB); PG8_STAGE(PG8_SA(1, 0), a3, voffA);
            PG8_WAIT_V(8); PG8_WAIT_L(0); PG8_BAR; PG8_MMA(1, 0, At, B0); PG8_MMA(1, 1, At, B1); PG8_BAR; PG8_SCHED;
            } else {
            PG8_LDB(B0, 0, 0); PG8_SCHED; PG8_LDA(At, 0, 0); PG8_STAGE(PG8_SA(1, 1), a1 + hstepA, voffA);
            PG8_WAIT_L(8); PG8_BAR; PG8_WAIT_L(0); PG8_MMA(0, 0, At, B0); PG8_BAR; PG8_SCHED;
            PG8_LDB(B1, 0, 1); PG8_STAGE(PG8_SB(0, 0), b2, voffB);
            PG8_BAR; PG8_WAIT_L(0); PG8_MMA(0, 1, At, B1); PG8_BAR;
            PG8_LDA(At, 0, 1); PG8_STAGE(PG8_SA(0, 0), a2, voffA);
            PG8_BAR; PG8_WAIT_L(0); PG8_MMA(1, 0, At, B0); PG8_BAR; PG8_SCHED;
            PG8_STAGE(PG8_SB(0, 1), b2 + hstepB, voffB);
            PG8_WAIT_V(6); PG8_BAR; PG8_MMA(1, 1, At, B1); PG8_BAR;
            PG8_LDB(B0, 1, 0); PG8_SCHED; PG8_LDA(At, 1, 0); PG8_STAGE(PG8_SA(0, 1), a2 + hstepA, voffA);
            PG8_WAIT_L(8); PG8_BAR; PG8_WAIT_L(0); PG8_MMA(0, 0, At, B0); PG8_BAR; PG8_SCHED;
            PG8_LDB(B1, 1, 1); PG8_STAGE(PG8_SB(1, 0), b3, voffB);
            PG8_BAR; PG8_WAIT_L(0); PG8_MMA(0, 1, At, B1); PG8_BAR;
            PG8_LDA(At, 1, 1); PG8_STAGE(PG8_SA(1, 0), a3, voffA);
            PG8_BAR; PG8_WAIT_L(0); PG8_MMA(1, 0, At, B0); PG8_BAR; PG8_SCHED;
            PG8_STAGE(PG8_SB(1, 1), b3 + hstepB, voffB);
            PG8_WAIT_V(6); PG8_BAR; PG8_MMA(1, 1, At, B1); PG8_BAR;
            }
        }
        if constexpr (ALIGN_EPI) { if (wr == 0) PG8_BAR; }
        if constexpr (!Epi::AFTER_DRAIN) { E(acc, cur, wr, wc, fr, fq); S.done(cur); }
        if (!has_next) break;
#pragma unroll
        for (int a = 0; a < 2; ++a)
#pragma unroll
            for (int b = 0; b < 2; ++b)
#pragma unroll
                for (int m = 0; m < 4; ++m)
#pragma unroll
                    for (int n = 0; n < 2; ++n) acc[a][b][m][n] = (f32x4){0.f, 0.f, 0.f, 0.f};
        cur = nxt; cA = nA; cB = nB; ++ui;
        if constexpr (ALIGN_EPI) { if (wr == 1) PG8_BAR; }
    }
    PG8_WAIT_V(0);
    if constexpr (!ALIGN_EPI) { if (wr == 0) PG8_BAR; }
    PG8_BAR;
    if constexpr (Epi::AFTER_DRAIN) { E.fused(acc, cur, wr, wc, fr, fq, lds, wid, lane); S.done(cur); }
#undef PG8_SA
#undef PG8_SB
#undef PG8_STAGE
#undef PG8_LDA
#undef PG8_LDB
#undef PG8_MMA
#undef PG8_WAIT_V
#undef PG8_WAIT_L
#undef PG8_BAR
#undef PG8_SCHED
}
}

namespace att {
#define LAS3 __attribute__((address_space(3)))
typedef unsigned short bf16_t;
using bf16x8 = __attribute__((ext_vector_type(8))) short;
using s16x4 = __attribute__((ext_vector_type(4))) short;
using f32x16 = __attribute__((ext_vector_type(16))) float;
using f32x4 = __attribute__((ext_vector_type(4))) float;
using u32x4 = __attribute__((ext_vector_type(4))) unsigned;
using u32x2 = __attribute__((ext_vector_type(2))) unsigned;
constexpr int SEQ = 8192, DM = 1024, KVB = 64, SLOTB = 8192;
constexpr int NS = 4;
constexpr int L_K = 0, L_V = NS * SLOTB, L_F = 2 * NS * SLOTB, L_FB = L_F + NS * 1024, L_OST = L_FB + 1024, OSTW = 4608, L_FLAG = 126976, L_END = L_FLAG + 128;
constexpr float C2 = 0.125f * 1.4426950408889634f;

__device__ __forceinline__ void glds16(const void* gsrc, unsigned lds_dst) { unsigned keep;
    asm volatile("s_mov_b32 %0, m0\n\ts_mov_b32 m0, %2\n\ts_nop 0\n\tglobal_load_lds_dwordx4 %1, off\n\ts_mov_b32 m0, %0" : "=&s"(keep) : "v"(gsrc), "s"(lds_dst) : "memory"); }
typedef float f32x2_t __attribute__((ext_vector_type(2))); typedef __bf16 bf16x2_t __attribute__((ext_vector_type(2)));
__device__ __forceinline__ unsigned cvtpk(float lo, float hi) { f32x2_t v = {lo, hi}; bf16x2_t b = __builtin_convertvector(v, bf16x2_t); return __builtin_bit_cast(unsigned, b); }
#define ATT_WAIT_BAR() asm volatile("s_waitcnt vmcnt(0) lgkmcnt(0)\n\ts_barrier" ::: "memory")
#define ATT_WAIT_N(n) asm volatile("s_waitcnt vmcnt(" #n ") lgkmcnt(0)\n\ts_barrier" ::: "memory")
#define ATT_TILE_WAIT(jt, W0) do { if ((jt) >= 2) { if (W0) ATT_WAIT_N(6); else ATT_WAIT_N(4); } else if ((jt) == 1) { if (W0) ATT_WAIT_N(3); else ATT_WAIT_N(2); } else ATT_WAIT_N(0); } while (0)
typedef short v4i16_t __attribute__((ext_vector_type(4)));
__device__ __forceinline__ s16x4 vtr(const LAS3 unsigned char* p) { return __builtin_bit_cast(s16x4, __builtin_amdgcn_ds_read_tr16_b64_v4i16((LAS3 v4i16_t*)p)); }
__device__ __forceinline__ float other_half(float v) {
    auto rr = __builtin_amdgcn_permlane32_swap(__float_as_uint(v), __float_as_uint(v), false, false);
    const unsigned a = rr[0], b = rr[1];
    return __uint_as_float(a == __float_as_uint(v) ? b : a);
}

template <bool SB>
__device__ __forceinline__ void attn_unit(int b, int hh, int qb, const bf16_t* Q, const bf16_t* __restrict__ K, const bf16_t* __restrict__ V, bf16_t* O,
                                          const float* __restrict__ F2, float* SS, LAS3 unsigned char* shm) {
    const int tid = threadIdx.x, lane = tid & 63, r32 = lane & 31, hi = lane >> 5; const int wid = __builtin_amdgcn_readfirstlane(tid >> 6);
    const long rowbase = (long)b * SEQ; const int q0 = qb * 256, qw0 = q0 + wid * 32;
    const bf16_t* Qw = Q + (rowbase + qw0) * DM + hh * 64;
    const bf16_t* Kh = K + rowbase * DM + hh * 64; const bf16_t* Vh = V + rowbase * DM + hh * 64;
    const unsigned lds0 = (unsigned)(uintptr_t)shm;
    const bf16_t* ksrc = Kh + (long)lane * DM + wid * 8;
    const bf16_t* vsrc = Vh + (long)(16 * (wid & 3) + (lane >> 2)) * DM + (wid >> 2) * 32 + (lane & 3) * 8;
    const unsigned kdst = lds0 + L_K + wid * 1024, vdst = lds0 + L_V + wid * 1024;
#define ATT_DMA(t, slotoff) do { glds16(ksrc + (long)(t) * KVB * DM, (unsigned)__builtin_amdgcn_readfirstlane(kdst + (slotoff))); \
                                 glds16(vsrc + (long)(t) * KVB * DM, (unsigned)__builtin_amdgcn_readfirstlane(vdst + (slotoff))); } while (0)
    const int NT = 4 * qb + 4;
    ATT_DMA(NT - 1, ((NT - 1) & 3) * SLOTB); ATT_DMA(NT - 2, ((NT - 2) & 3) * SLOTB); ATT_DMA(NT - 3, ((NT - 3) & 3) * SLOTB);
    bf16x8 qr[4];
#pragma unroll
    for (int d0 = 0; d0 < 4; ++d0) qr[d0] = *reinterpret_cast<const bf16x8*>(Qw + (long)r32 * DM + d0 * 16 + hi * 8);
    LAS3 float* F2s = (LAS3 float*)(shm + L_F);
    float ft2 = 0.f;
    if (!SB) { const float* Frow = F2 + (long)(b * 8 + hh) * SEQ;
        for (int i = tid; i < (q0 + 256) / 4; i += 512) ((LAS3 f32x4*)F2s)[i] = ((const f32x4*)Frow)[i];
        ft2 = Frow[qw0 + r32]; }
    f32x16 o0, o1;
#pragma unroll
    for (int r = 0; r < 16; ++r) { o0[r] = 0.f; o1[r] = 0.f; }
    float mrun = -INFINITY, lrun = 0.f, carry = 1.f;
    volatile LAS3 unsigned* flags = (volatile LAS3 unsigned*)(shm + L_FLAG);
    const LAS3 unsigned char* kp0 = shm + L_K + hi * 1024 + r32 * 16;
    const LAS3 unsigned char* vp0 = shm + L_V + ((lane >> 4) & 1) * 32 + (lane & 3) * 8 + (4 * hi + ((lane & 15) >> 2)) * 64;
    asm volatile("" :: "v"(qr[0]), "v"(qr[1]), "v"(qr[2]), "v"(qr[3]));
    for (int jt = NT - 1; jt >= 0; --jt) {
        const int slot = jt & 3;
        ATT_TILE_WAIT(jt, false);
        if (SB && jt < NT - 1) { unsigned a = 0;
#pragma unroll
            for (int w = 0; w < 8; ++w) a |= flags[((jt + 1) & 1) * 8 + w];
            if (__builtin_amdgcn_readfirstlane(a) == 0u) break; }
        if (jt >= 3) ATT_DMA(jt - 3, ((jt - 3) & 3) * SLOTB);
        if (64 * jt <= qw0 + 31) {
            const LAS3 unsigned char* kp = kp0 + slot * SLOTB;
            f32x16 p0, p1;
#pragma unroll
            for (int r = 0; r < 16; ++r) { p0[r] = 0.f; p1[r] = 0.f; }
#pragma unroll
            for (int d0 = 0; d0 < 4; ++d0) {
                const bf16x8 k0 = *(const LAS3 bf16x8*)(kp + d0 * 2048), k1 = *(const LAS3 bf16x8*)(kp + d0 * 2048 + 512);
                p0 = __builtin_amdgcn_mfma_f32_32x32x16_bf16(k0, qr[d0], p0, 0, 0, 0);
                p1 = __builtin_amdgcn_mfma_f32_32x32x16_bf16(k1, qr[d0], p1, 0, 0, 0);
            }
            const bool diag = (64 * jt + 63 > qw0 - (SB ? 1 : 0));
            const int kb_ = 64 * jt + 4 * hi - (qw0 + r32);
            if (!SB) {
                const LAS3 float* fsp = F2s + 64 * jt + 4 * hi;
#pragma unroll
                for (int g = 0; g < 4; ++g) { const f32x4 fa = *(const LAS3 f32x4*)(fsp + 8 * g), fb = *(const LAS3 f32x4*)(fsp + 32 + 8 * g);
#pragma unroll
                    for (int i = 0; i < 4; ++i) { p0[4 * g + i] += (ft2 - fa[i]); p1[4 * g + i] += (ft2 - fb[i]); } }
                if (diag) {
#pragma unroll
                    for (int r = 0; r < 16; ++r) { const int cr = (r & 3) + 8 * (r >> 2); if (kb_ + cr > 0) p0[r] = -INFINITY; if (kb_ + cr + 32 > 0) p1[r] = -INFINITY; } }
                float mx = fmaxf(p0[0], p1[0]);
#pragma unroll
                for (int r = 1; r < 16; ++r) mx = fmaxf(mx, fmaxf(p0[r], p1[r]));
                mx = fmaxf(mx, other_half(mx));
                const float mnew = fmaxf(mrun, mx);
                if (__any(mnew > mrun)) { const float alpha = __builtin_amdgcn_exp2f(mrun - mnew); lrun *= alpha;
#pragma unroll
                    for (int r = 0; r < 16; ++r) { o0[r] *= alpha; o1[r] *= alpha; }
                    mrun = mnew; }
                float ls = 0.f;
#pragma unroll
                for (int r = 0; r < 16; ++r) { p0[r] = __builtin_amdgcn_exp2f(p0[r] - mrun); p1[r] = __builtin_amdgcn_exp2f(p1[r] - mrun); ls += p0[r] + p1[r]; }
                lrun += ls;
            } else {
#pragma unroll
                for (int r = 0; r < 16; ++r) { p0[r] = __builtin_amdgcn_rcpf(1.0f + __builtin_amdgcn_exp2f(p0[r])); p1[r] = __builtin_amdgcn_rcpf(1.0f + __builtin_amdgcn_exp2f(p1[r])); }
                if (diag) {
#pragma unroll
                    for (int r = 0; r < 16; ++r) { const int cr = (r & 3) + 8 * (r >> 2); if (kb_ + cr >= 0) p0[r] = 1.0f; if (kb_ + cr + 32 >= 0) p1[r] = 1.0f; } }
                float PP0[4], PP1[4], H0[4], H1[4];
#pragma unroll
                for (int g = 0; g < 4; ++g) { const float g0 = (p0[4 * g] * p0[4 * g + 1]) * (p0[4 * g + 2] * p0[4 * g + 3]), g1 = (p1[4 * g] * p1[4 * g + 1]) * (p1[4 * g + 2] * p1[4 * g + 3]);
                    const float t0 = other_half(g0), t1 = other_half(g1); PP0[g] = g0 * t0; PP1[g] = g1 * t1; H0[g] = hi ? 1.0f : t0; H1[g] = hi ? 1.0f : t1; }
                float T0[4], T1[4];
                T1[3] = carry; T1[2] = T1[3] * PP1[3]; T1[1] = T1[2] * PP1[2]; T1[0] = T1[1] * PP1[1]; const float tot1 = T1[0] * PP1[0];
                T0[3] = tot1; T0[2] = T0[3] * PP0[3]; T0[1] = T0[2] * PP0[2]; T0[0] = T0[1] * PP0[1]; carry = T0[0] * PP0[0];
#pragma unroll
                for (int g = 0; g < 4; ++g) {
                    { const float x3 = T0[g] * H0[g], x2 = x3 * p0[4 * g + 3], x1 = x2 * p0[4 * g + 2], x0 = x1 * p0[4 * g + 1];
                      p0[4 * g + 3] = fmaf(-p0[4 * g + 3], x3, x3); p0[4 * g + 2] = fmaf(-p0[4 * g + 2], x2, x2); p0[4 * g + 1] = fmaf(-p0[4 * g + 1], x1, x1); p0[4 * g] = fmaf(-p0[4 * g], x0, x0); }
                    { const float x3 = T1[g] * H1[g], x2 = x3 * p1[4 * g + 3], x1 = x2 * p1[4 * g + 2], x0 = x1 * p1[4 * g + 1];
                      p1[4 * g + 3] = fmaf(-p1[4 * g + 3], x3, x3); p1[4 * g + 2] = fmaf(-p1[4 * g + 2], x2, x2); p1[4 * g + 1] = fmaf(-p1[4 * g + 1], x1, x1); p1[4 * g] = fmaf(-p1[4 * g], x0, x0); }
                }
            }
            u32x4 pw[4];
#pragma unroll
            for (int i = 0; i < 4; ++i) { pw[0][i] = cvtpk(p0[2 * i], p0[2 * i + 1]); pw[1][i] = cvtpk(p0[8 + 2 * i], p0[8 + 2 * i + 1]); pw[2][i] = cvtpk(p1[2 * i], p1[2 * i + 1]); pw[3][i] = cvtpk(p1[8 + 2 * i], p1[8 + 2 * i + 1]); }
            const LAS3 unsigned char* vp = vp0 + slot * SLOTB;
#pragma unroll
            for (int ks = 0; ks < 4; ++ks) {
                const s16x4 l0 = vtr(vp + ks * 1024), h0 = vtr(vp + ks * 1024 + 512), l1 = vtr(vp + 4096 + ks * 1024), h1 = vtr(vp + 4096 + ks * 1024 + 512);
                const bf16x8 v0 = (bf16x8){l0[0], l0[1], l0[2], l0[3], h0[0], h0[1], h0[2], h0[3]}, v1 = (bf16x8){l1[0], l1[1], l1[2], l1[3], h1[0], h1[1], h1[2], h1[3]};
                const bf16x8 pf = __builtin_bit_cast(bf16x8, pw[ks]);
                o0 = __builtin_amdgcn_mfma_f32_32x32x16_bf16(v0, pf, o0, 0, 0, 0);
                o1 = __builtin_amdgcn_mfma_f32_32x32x16_bf16(v1, pf, o1, 0, 0, 0);
            }
        }
        if (SB) { const bool alive = __any(carry != 0.f) != 0; if (lane == 0) flags[(jt & 1) * 8 + wid] = alive ? 1u : 0u; }
    }
    if (!SB) { lrun += other_half(lrun); const float inv = 1.0f / lrun;
#pragma unroll
        for (int r = 0; r < 16; ++r) { o0[r] *= inv; o1[r] *= inv; } }
    float sq = 0.f;
#pragma unroll
    for (int r = 0; r < 16; ++r) sq += o0[r] * o0[r] + o1[r] * o1[r];
    sq += other_half(sq);
    if (hi == 0) SS[(size_t)(rowbase + qw0 + r32) * 16 + hh] = sq;
    LAS3 unsigned char* stg = shm + L_OST + wid * OSTW;
#pragma unroll
    for (int g = 0; g < 4; ++g) {
        u32x2 w0; w0.x = cvtpk(o0[4 * g], o0[4 * g + 1]); w0.y = cvtpk(o0[4 * g + 2], o0[4 * g + 3]);
        u32x2 w1; w1.x = cvtpk(o1[4 * g], o1[4 * g + 1]); w1.y = cvtpk(o1[4 * g + 2], o1[4 * g + 3]);
        *(LAS3 u32x2*)(stg + r32 * 144 + g * 16 + hi * 8) = w0;
        *(LAS3 u32x2*)(stg + r32 * 144 + 64 + g * 16 + hi * 8) = w1;
    }
    asm volatile("s_waitcnt lgkmcnt(0)" ::: "memory");
    bf16_t* Ow = O + (rowbase + qw0) * DM + hh * 64;
#pragma unroll
    for (int i = 0; i < 4; ++i) { const int row = i * 8 + (lane >> 3), ch = lane & 7; const u32x4 v = *(const LAS3 u32x4*)(stg + row * 144 + ch * 16); *(u32x4*)(Ow + (long)row * DM + ch * 8) = v; }
    ATT_WAIT_BAR();
#undef ATT_DMA
}
__device__ __forceinline__ float max3f(float a, float b, float c) { float r; asm("v_max3_f32 %0, %1, %2, %3" : "=v"(r) : "v"(a), "v"(b), "v"(c)); return r; }
__device__ __forceinline__ void fox_unit(int b, int hh, int qb, const bf16_t* Q, const bf16_t* __restrict__ K, const bf16_t* __restrict__ V, bf16_t* O,
                                         const float* __restrict__ F2, const bf16_t* __restrict__ FS3, const unsigned* __restrict__ KMAX, float* SS, LAS3 unsigned char* shm) {
    constexpr float THR = 8.0f;
    const int tid = threadIdx.x, lane = tid & 63, r32 = lane & 31, hi = lane >> 5; const int wid = __builtin_amdgcn_readfirstlane(tid >> 6);
    const long rowbase = (long)b * SEQ; const int q0 = qb * 256, qw0 = q0 + wid * 32;
    const bf16_t* Qw = Q + (rowbase + qw0) * DM + hh * 64;
    const bf16_t* Kh = K + rowbase * DM + hh * 64; const bf16_t* Vh = V + rowbase * DM + hh * 64;
    const unsigned lds0 = (unsigned)(uintptr_t)shm;
    const bf16_t* ksrc = Kh + (long)lane * DM + wid * 8;
    const bf16_t* vsrc = Vh + (long)(16 * (wid & 3) + (lane >> 2)) * DM + (wid >> 2) * 32 + (lane & 3) * 8;
    const bf16_t* fsrc = FS3 + ((long)(b * 8 + hh) * SEQ + lane) * 8;
    const float* Frow = F2 + (long)(b * 8 + hh) * SEQ;
    const unsigned kdst = lds0 + L_K + wid * 1024, vdst = lds0 + L_V + wid * 1024, fdst = lds0 + L_F;
#define FOX_DMA(t, s_) do { glds16(ksrc + (long)(t) * KVB * DM, (unsigned)__builtin_amdgcn_readfirstlane(kdst + (s_) * SLOTB)); \
                            glds16(vsrc + (long)(t) * KVB * DM, (unsigned)__builtin_amdgcn_readfirstlane(vdst + (s_) * SLOTB)); \
                            if (wid == 0) glds16(fsrc + (long)(t) * KVB * 8, (unsigned)__builtin_amdgcn_readfirstlane(fdst + (s_) * 1024)); } while (0)
    const int NT = 4 * qb + 4;
    FOX_DMA(NT - 1, (NT - 1) & 3); FOX_DMA(NT - 2, (NT - 2) & 3);
    bf16x8 qr[4]; float qn2 = 0.f;
#pragma unroll
    for (int d0 = 0; d0 < 4; ++d0) { qr[d0] = *reinterpret_cast<const bf16x8*>(Qw + (long)r32 * DM + d0 * 16 + hi * 8);
#pragma unroll
        for (int j = 0; j < 8; ++j) { const float f = __builtin_bit_cast(float, (unsigned)(unsigned short)qr[d0][j] << 16); qn2 += f * f; } }
    qn2 += other_half(qn2);
    const float kn = sqrtf(2.0f * __uint_as_float(KMAX[b * 8 + hh])) * 1.01f;
    const float zq = sqrtf(qn2) * kn * 1.01f + 1.0f;
    const float ft2 = Frow[qw0 + r32];
    const float f2q0 = Frow[q0];
    int jp_last0;
    { bool c = false; if (lane >= 1 && lane < NT / 2) c = (f2q0 - Frow[128 * lane - 1]) < -128.0f;
      const unsigned long long mk = __ballot(c); jp_last0 = mk ? 63 - __builtin_clzll(mk) : 0; }
    int jp_lastw;
    { const float f2w0 = Frow[qw0]; bool c = false; if (lane >= 1 && lane < NT / 2) c = (f2w0 - Frow[128 * lane - 1]) < -128.0f;
      const unsigned long long mk = __ballot(c); jp_lastw = mk ? 63 - __builtin_clzll(mk) : 0; }
    const short one = (short)0x3F80;
    const bf16x8 onesA = (bf16x8){one, one, one, one, one, one, one, one};
    const bf16x8 qones = hi ? (bf16x8){0, 0, 0, 0, 0, 0, 0, 0} : (bf16x8){one, one, one, 0, 0, 0, 0, 0};
    f32x16 o0, o1, lacc, cinit;
#pragma unroll
    for (int r = 0; r < 16; ++r) { o0[r] = 0.f; o1[r] = 0.f; lacc[r] = 0.f; cinit[r] = ft2 - fminf(zq, 60.0f); }
    const float mref = fminf(zq, 60.0f);
    volatile LAS3 unsigned* flags = (volatile LAS3 unsigned*)(shm + L_FLAG);
    const LAS3 unsigned char* kp0 = shm + L_K + hi * 1024 + r32 * 16;
    const LAS3 unsigned char* vp0 = shm + L_V + ((lane >> 4) & 1) * 32 + (lane & 3) * 8 + (4 * hi + ((lane & 15) >> 2)) * 64;
    const LAS3 unsigned char* fp0 = shm + L_F + r32 * 16;
    { const bool ex = __any(zq > 60.0f) != 0; if (lane == 0) flags[wid] = ex ? 1u : 0u; }
    bool excess = false;
    for (int jp = NT / 2 - 1; jp >= 0; --jp) {
        ATT_WAIT_BAR();
        if (jp == NT / 2 - 1) { unsigned a = 0;
#pragma unroll
            for (int w = 0; w < 8; ++w) a |= flags[w];
            excess = __builtin_amdgcn_readfirstlane(a) != 0u; }
        const bool last = (jp == (excess ? 0 : jp_last0));
        if (!last) { FOX_DMA(2 * jp - 1, (2 * jp - 1) & 3); FOX_DMA(2 * jp - 2, (2 * jp - 2) & 3); }
#pragma unroll
      for (int sub = 1; sub >= 0; --sub) { const int jt = 2 * jp + sub; const int slot = jt & 3;
        if (64 * jt <= qw0 + 31 && (excess || jp >= jp_lastw)) {
            const LAS3 unsigned char* kp = kp0 + slot * SLOTB; const LAS3 unsigned char* fp = fp0 + slot * 1024;
            asm volatile("" : "+v"(cinit));
            f32x16 p0 = __builtin_amdgcn_mfma_f32_32x32x16_bf16(*(const LAS3 bf16x8*)(fp), qones, cinit, 0, 0, 0);
            f32x16 p1 = __builtin_amdgcn_mfma_f32_32x32x16_bf16(*(const LAS3 bf16x8*)(fp + 512), qones, cinit, 0, 0, 0);
#pragma unroll
            for (int d0 = 0; d0 < 4; ++d0) {
                const bf16x8 k0 = *(const LAS3 bf16x8*)(kp + d0 * 2048), k1 = *(const LAS3 bf16x8*)(kp + d0 * 2048 + 512);
                p0 = __builtin_amdgcn_mfma_f32_32x32x16_bf16(k0, qr[d0], p0, 0, 0, 0);
                p1 = __builtin_amdgcn_mfma_f32_32x32x16_bf16(k1, qr[d0], p1, 0, 0, 0);
            }
            if (64 * jt + 63 > qw0) { const int kb_ = 64 * jt + 4 * hi - (qw0 + r32);
#pragma unroll
                for (int r = 0; r < 16; ++r) { const int cr = (r & 3) + 8 * (r >> 2); if (kb_ + cr > 0) p0[r] = -INFINITY; if (kb_ + cr + 32 > 0) p1[r] = -INFINITY; } }
#pragma unroll
            for (int r = 0; r < 16; ++r) { p0[r] = __builtin_amdgcn_exp2f(p0[r]); p1[r] = __builtin_amdgcn_exp2f(p1[r]); }
            u32x4 pw[4];
#pragma unroll
            for (int i = 0; i < 4; ++i) { pw[0][i] = cvtpk(p0[2 * i], p0[2 * i + 1]); pw[1][i] = cvtpk(p0[8 + 2 * i], p0[8 + 2 * i + 1]); pw[2][i] = cvtpk(p1[2 * i], p1[2 * i + 1]); pw[3][i] = cvtpk(p1[8 + 2 * i], p1[8 + 2 * i + 1]); }
            const LAS3 unsigned char* vp = vp0 + slot * SLOTB;
#pragma unroll
            for (int ks = 0; ks < 4; ++ks) {
                const s16x4 l0 = vtr(vp + ks * 1024), h0 = vtr(vp + ks * 1024 + 512), l1 = vtr(vp + 4096 + ks * 1024), h1 = vtr(vp + 4096 + ks * 1024 + 512);
                const bf16x8 v0 = (bf16x8){l0[0], l0[1], l0[2], l0[3], h0[0], h0[1], h0[2], h0[3]}, v1 = (bf16x8){l1[0], l1[1], l1[2], l1[3], h1[0], h1[1], h1[2], h1[3]};
                const bf16x8 pf = __builtin_bit_cast(bf16x8, pw[ks]);
                o0 = __builtin_amdgcn_mfma_f32_32x32x16_bf16(v0, pf, o0, 0, 0, 0);
                o1 = __builtin_amdgcn_mfma_f32_32x32x16_bf16(v1, pf, o1, 0, 0, 0);
                lacc = __builtin_amdgcn_mfma_f32_32x32x16_bf16(onesA, pf, lacc, 0, 0, 0);
            }
        }
      }
        if (last) break;
    }
    { const float inv = 1.0f / lacc[0];
#pragma unroll
        for (int r = 0; r < 16; ++r) { o0[r] *= inv; o1[r] *= inv; } }
    float sq = 0.f;
#pragma unroll
    for (int r = 0; r < 16; ++r) sq += o0[r] * o0[r] + o1[r] * o1[r];
    sq += other_half(sq);
    if (hi == 0) SS[(size_t)(rowbase + qw0 + r32) * 16 + hh] = sq;
    LAS3 unsigned char* stg = shm + L_OST + wid * OSTW;
#pragma unroll
    for (int g = 0; g < 4; ++g) {
        u32x2 w0; w0.x = cvtpk(o0[4 * g], o0[4 * g + 1]); w0.y = cvtpk(o0[4 * g + 2], o0[4 * g + 3]);
        u32x2 w1; w1.x = cvtpk(o1[4 * g], o1[4 * g + 1]); w1.y = cvtpk(o1[4 * g + 2], o1[4 * g + 3]);
        *(LAS3 u32x2*)(stg + r32 * 144 + g * 16 + hi * 8) = w0;
        *(LAS3 u32x2*)(stg + r32 * 144 + 64 + g * 16 + hi * 8) = w1;
    }
    asm volatile("s_waitcnt lgkmcnt(0)" ::: "memory");
    bf16_t* Ow = O + (rowbase + qw0) * DM + hh * 64;
#pragma unroll
    for (int i = 0; i < 4; ++i) { const int row = i * 8 + (lane >> 3), ch = lane & 7; const u32x4 v = *(const LAS3 u32x4*)(stg + row * 144 + ch * 16); *(u32x4*)(Ow + (long)row * DM + ch * 8) = v; }
    ATT_WAIT_BAR();
#undef FOX_DMA
}

__device__ __forceinline__ void sb_tile(const LAS3 unsigned char* kp, const LAS3 unsigned char* vp, int jt, int qw0, int r32, int hi, const bf16x8 (&qr)[4], float& carry, f32x16& o0, f32x16& o1) {
    f32x16 p0, p1;
#pragma unroll
    for (int r = 0; r < 16; ++r) { p0[r] = 0.f; p1[r] = 0.f; }
#pragma unroll
    for (int d0 = 0; d0 < 4; ++d0) {
        const bf16x8 k0 = *(const LAS3 bf16x8*)(kp + d0 * 2048), k1 = *(const LAS3 bf16x8*)(kp + d0 * 2048 + 512);
        p0 = __builtin_amdgcn_mfma_f32_32x32x16_bf16(k0, qr[d0], p0, 0, 0, 0);
        p1 = __builtin_amdgcn_mfma_f32_32x32x16_bf16(k1, qr[d0], p1, 0, 0, 0);
    }
#pragma unroll
    for (int r = 0; r < 16; ++r) { p0[r] = __builtin_amdgcn_rcpf(1.0f + __builtin_amdgcn_exp2f(p0[r])); p1[r] = __builtin_amdgcn_rcpf(1.0f + __builtin_amdgcn_exp2f(p1[r])); }
    if (64 * jt + 63 > qw0 - 1) { const int kb_ = 64 * jt + 4 * hi - (qw0 + r32);
#pragma unroll
        for (int r = 0; r < 16; ++r) { const int cr = (r & 3) + 8 * (r >> 2); if (kb_ + cr >= 0) p0[r] = 1.0f; if (kb_ + cr + 32 >= 0) p1[r] = 1.0f; } }
    float PP0[4], PP1[4], H0[4], H1[4];
#pragma unroll
    for (int g = 0; g < 4; ++g) { const float g0 = (p0[4 * g] * p0[4 * g + 1]) * (p0[4 * g + 2] * p0[4 * g + 3]), g1 = (p1[4 * g] * p1[4 * g + 1]) * (p1[4 * g + 2] * p1[4 * g + 3]);
        const float t0 = other_half(g0), t1 = other_half(g1); PP0[g] = g0 * t0; PP1[g] = g1 * t1; H0[g] = hi ? 1.0f : t0; H1[g] = hi ? 1.0f : t1; }
    float T0[4], T1[4];
    T1[3] = carry; T1[2] = T1[3] * PP1[3]; T1[1] = T1[2] * PP1[2]; T1[0] = T1[1] * PP1[1]; const float tot1 = T1[0] * PP1[0];
    T0[3] = tot1; T0[2] = T0[3] * PP0[3]; T0[1] = T0[2] * PP0[2]; T0[0] = T0[1] * PP0[1]; carry = T0[0] * PP0[0];
#pragma unroll
    for (int g = 0; g < 4; ++g) {
        { const float x3 = T0[g] * H0[g], x2 = x3 * p0[4 * g + 3], x1 = x2 * p0[4 * g + 2], x0 = x1 * p0[4 * g + 1];
          p0[4 * g + 3] = fmaf(-p0[4 * g + 3], x3, x3); p0[4 * g + 2] = fmaf(-p0[4 * g + 2], x2, x2); p0[4 * g + 1] = fmaf(-p0[4 * g + 1], x1, x1); p0[4 * g] = fmaf(-p0[4 * g], x0, x0); }
        { const float x3 = T1[g] * H1[g], x2 = x3 * p1[4 * g + 3], x1 = x2 * p1[4 * g + 2], x0 = x1 * p1[4 * g + 1];
          p1[4 * g + 3] = fmaf(-p1[4 * g + 3], x3, x3); p1[4 * g + 2] = fmaf(-p1[4 * g + 2], x2, x2); p1[4 * g + 1] = fmaf(-p1[4 * g + 1], x1, x1); p1[4 * g] = fmaf(-p1[4 * g], x0, x0); }
    }
    u32x4 pw[4];
#pragma unroll
    for (int i = 0; i < 4; ++i) { pw[0][i] = cvtpk(p0[2 * i], p0[2 * i + 1]); pw[1][i] = cvtpk(p0[8 + 2 * i], p0[8 + 2 * i + 1]); pw[2][i] = cvtpk(p1[2 * i], p1[2 * i + 1]); pw[3][i] = cvtpk(p1[8 + 2 * i], p1[8 + 2 * i + 1]); }
#pragma unroll
    for (int ks = 0; ks < 4; ++ks) {
        const s16x4 l0 = vtr(vp + ks * 1024), h0 = vtr(vp + ks * 1024 + 512), l1 = vtr(vp + 4096 + ks * 1024), h1 = vtr(vp + 4096 + ks * 1024 + 512);
        const bf16x8 v0 = (bf16x8){l0[0], l0[1], l0[2], l0[3], h0[0], h0[1], h0[2], h0[3]}, v1 = (bf16x8){l1[0], l1[1], l1[2], l1[3], h1[0], h1[1], h1[2], h1[3]};
        const bf16x8 pf = __builtin_bit_cast(bf16x8, pw[ks]);
        o0 = __builtin_amdgcn_mfma_f32_32x32x16_bf16(v0, pf, o0, 0, 0, 0);
        o1 = __builtin_amdgcn_mfma_f32_32x32x16_bf16(v1, pf, o1, 0, 0, 0);
    }
}
__device__ __forceinline__ void sb_unit(int b, int hh, int qb, const bf16_t* Q, const bf16_t* __restrict__ K, const bf16_t* __restrict__ V, bf16_t* O, float* SS, LAS3 unsigned char* shm) {
    constexpr int WV = 7 * SLOTB;
    const int tid = threadIdx.x, lane = tid & 63, r32 = lane & 31, hi = lane >> 5; const int wid = __builtin_amdgcn_readfirstlane(tid >> 6);
    const long rowbase = (long)b * SEQ; const int q0 = qb * 256, qw0 = q0 + wid * 32;
    const bf16_t* Qw = Q + (rowbase + qw0) * DM + hh * 64;
    const bf16_t* Kh = K + rowbase * DM + hh * 64; const bf16_t* Vh = V + rowbase * DM + hh * 64;
    const unsigned lds0 = (unsigned)(uintptr_t)shm;
    const bf16_t* ksrc = Kh + (long)lane * DM + wid * 8;
    const bf16_t* vsrc = Vh + (long)(16 * (wid & 3) + (lane >> 2)) * DM + (wid >> 2) * 32 + (lane & 3) * 8;
    const int T_hi = 4 * qb + 3, T_lo = (4 * qb - 3 > 0) ? 4 * qb - 3 : 0;
    for (int t = T_hi; t >= T_lo; --t) { glds16(ksrc + (long)t * KVB * DM, (unsigned)__builtin_amdgcn_readfirstlane(lds0 + (t - T_lo) * SLOTB + wid * 1024));
                                         glds16(vsrc + (long)t * KVB * DM, (unsigned)__builtin_amdgcn_readfirstlane(lds0 + WV + (t - T_lo) * SLOTB + wid * 1024)); }
    bf16x8 qr[4];
#pragma unroll
    for (int d0 = 0; d0 < 4; ++d0) qr[d0] = *reinterpret_cast<const bf16x8*>(Qw + (long)r32 * DM + d0 * 16 + hi * 8);
    f32x16 o0, o1;
#pragma unroll
    for (int r = 0; r < 16; ++r) { o0[r] = 0.f; o1[r] = 0.f; }
    float carry = 1.f;
    const int kl = hi * 1024 + r32 * 16, vl = ((lane >> 4) & 1) * 32 + (lane & 3) * 8 + (4 * hi + ((lane & 15) >> 2)) * 64;
    volatile LAS3 unsigned char* fbytes = (volatile LAS3 unsigned char*)(shm + L_FLAG);
    asm volatile("" :: "v"(qr[0]), "v"(qr[1]), "v"(qr[2]), "v"(qr[3]));
    ATT_WAIT_BAR();
    for (int jt = (qw0 + 31) >> 6; jt >= T_lo; --jt) {
        sb_tile(shm + (jt - T_lo) * SLOTB + kl, shm + WV + (jt - T_lo) * SLOTB + vl, jt, qw0, r32, hi, qr, carry, o0, o1);
        if (!__any(carry != 0.f)) break;
    }
    bool more = false;
    if (T_lo > 0) {
        const bool alive = __any(carry != 0.f) != 0; if (lane == 0) fbytes[16 + wid] = alive ? (unsigned char)1 : (unsigned char)0;
        ATT_WAIT_BAR();
        const unsigned long long a8 = *(volatile LAS3 unsigned long long*)(shm + L_FLAG + 16);
        more = __builtin_amdgcn_readfirstlane((unsigned)a8 | (unsigned)(a8 >> 32)) != 0u;
    }
    if (more) {
        const unsigned kdst = lds0 + L_K + wid * 1024, vdst = lds0 + L_V + wid * 1024;
#define SB_DMA(t) do { glds16(ksrc + (long)(t) * KVB * DM, (unsigned)__builtin_amdgcn_readfirstlane(kdst + ((t) & 3) * SLOTB)); \
                       glds16(vsrc + (long)(t) * KVB * DM, (unsigned)__builtin_amdgcn_readfirstlane(vdst + ((t) & 3) * SLOTB)); } while (0)
        SB_DMA(T_lo - 1); if (T_lo >= 2) SB_DMA(T_lo - 2); if (T_lo >= 3) SB_DMA(T_lo - 3);
        bool walive = true;
        for (int jt = T_lo - 1; jt >= 0; --jt) {
            ATT_TILE_WAIT(jt, false);
            if (jt < T_lo - 1) { const unsigned long long a8 = *(volatile LAS3 unsigned long long*)(shm + L_FLAG + ((jt + 1) & 1) * 8);
                if (__builtin_amdgcn_readfirstlane((unsigned)a8 | (unsigned)(a8 >> 32)) == 0u) break; }
            if (jt >= 3) SB_DMA(jt - 3);
            if (walive) sb_tile(shm + L_K + (jt & 3) * SLOTB + kl, shm + L_V + (jt & 3) * SLOTB + vl, jt, qw0, r32, hi, qr, carry, o0, o1);
            walive = __any(carry != 0.f) != 0; if (lane == 0) fbytes[(jt & 1) * 8 + wid] = walive ? (unsigned char)1 : (unsigned char)0;
        }
#undef SB_DMA
    }
    ATT_WAIT_BAR();
    float sq = 0.f;
#pragma unroll
    for (int r = 0; r < 16; ++r) sq += o0[r] * o0[r] + o1[r] * o1[r];
    sq += other_half(sq);
    if (hi == 0) SS[(size_t)(rowbase + qw0 + r32) * 16 + hh] = sq;
    LAS3 unsigned char* stg = shm + L_OST + wid * OSTW;
#pragma unroll
    for (int g = 0; g < 4; ++g) {
        u32x2 w0; w0.x = cvtpk(o0[4 * g], o0[4 * g + 1]); w0.y = cvtpk(o0[4 * g + 2], o0[4 * g + 3]);
        u32x2 w1; w1.x = cvtpk(o1[4 * g], o1[4 * g + 1]); w1.y = cvtpk(o1[4 * g + 2], o1[4 * g + 3]);
        *(LAS3 u32x2*)(stg + r32 * 144 + g * 16 + hi * 8) = w0;
        *(LAS3 u32x2*)(stg + r32 * 144 + 64 + g * 16 + hi * 8) = w1;
    }
    asm volatile("s_waitcnt lgkmcnt(0)" ::: "memory");
    bf16_t* Ow = O + (rowbase + qw0) * DM + hh * 64;
#pragma unroll
    for (int i = 0; i < 4; ++i) { const int row = i * 8 + (lane >> 3), ch = lane & 7; const u32x4 v = *(const LAS3 u32x4*)(stg + row * 144 + ch * 16); *(u32x4*)(Ow + (long)row * DM + ch * 8) = v; }
    ATT_WAIT_BAR();
}
}

constexpr int NWAVES = 8;
constexpr int BATCH = 4, SEQ = 8192, DMODEL = 1024, MROWS = BATCH * SEQ, DFF = 2816, NUP = 2 * DFF, INC = 3080;
constexpr float RMS_EPS = 1e-6f, LOG2E = 1.4426950408889634f;
constexpr size_t MiB = 1u << 20;
constexpr size_t WS_WIN = 1 * MiB, WS_WOUT = 7 * MiB, WS_WUP = 9 * MiB, WS_WDN = 20 * MiB;
constexpr size_t WS_LF = 26 * MiB, WS_F2 = 27 * MiB, WS_SS = 28 * MiB, WS_PS = 30 * MiB, WS_PS2 = 32 * MiB, WS_HALO = 34 * MiB;
constexpr size_t WS_XN = 48 * MiB;
constexpr size_t WS_Q = 112 * MiB, WS_K = 176 * MiB, WS_V = 240 * MiB, WS_O = 304 * MiB;
constexpr size_t WS_U = 112 * MiB;
constexpr size_t WS_FS3 = 464 * MiB;
constexpr size_t WS_CTL = 0;
constexpr size_t WS_END = 468 * MiB;
constexpr int RING_BYTES = 131072, LDS_BYTES = 147456;
static_assert(att::L_END <= RING_BYTES && att::L_OST + 8 * att::OSTW <= att::L_FLAG && 14 * att::SLOTB <= att::L_FLAG, "attention LDS map");

#define LAS __attribute__((address_space(3)))
typedef unsigned short bf16;
typedef unsigned v4u __attribute__((ext_vector_type(4)));
typedef float f32x4 __attribute__((ext_vector_type(4)));
__device__ __forceinline__ unsigned f2bf(float f) { unsigned u = __builtin_bit_cast(unsigned, f); return (u + 0x7fffu + ((u >> 16) & 1u)) >> 16; }
__device__ __forceinline__ unsigned pk2(float lo, float hi) { return f2bf(lo) | (f2bf(hi) << 16); }
__device__ __forceinline__ float bf2f(unsigned short h) { return __builtin_bit_cast(float, (unsigned)h << 16); }
__device__ __forceinline__ float wave_sum(float v) {
#pragma unroll
    for (int o = 1; o < 64; o <<= 1) v += __shfl_xor(v, o);
    return v;
}
#define LDS_WAIT() asm volatile("s_waitcnt lgkmcnt(0)" ::: "memory")

#define XB_TMO      128
#define XB_XCNT(j)  (256  + 64 * (j))
#define XB_XSUB(j)  (1280 + 64 * (j))
#define XB_XGEN(j)  (2304 + 64 * (j))
#define XB_TOP      3328
#define XB_TOPGEN   3392
#define XCD_BAR_WORDS 3456
#define XB_SPIN_CAP (1u << 18)

__device__ __forceinline__ unsigned xb_ld(unsigned* p)              { return __hip_atomic_load(p, __ATOMIC_RELAXED, __HIP_MEMORY_SCOPE_AGENT); }
__device__ __forceinline__ unsigned xb_add(unsigned* p, unsigned v) { return __hip_atomic_fetch_add(p, v, __ATOMIC_RELAXED, __HIP_MEMORY_SCOPE_AGENT); }
__device__ __forceinline__ unsigned xb_xcc_id() { return (unsigned)__builtin_amdgcn_s_getreg((3 << 11) | 20) & 0xFu; }
#define XB_SPIN(cond, bar) do { unsigned _sp = 0; while (cond) { __builtin_amdgcn_s_sleep(1); \
    if ((++_sp & 255u) == 0u) { if (xb_ld(&(bar)[XB_TMO])) break; if (_sp > XB_SPIN_CAP) { atomicAdd(&(bar)[XB_TMO], 1u); break; } } } } while (0)

struct XcdBarrier {
    unsigned* bar; unsigned x;
    volatile LAS unsigned* st;
};

__device__ __forceinline__ XcdBarrier xcd_barrier_post(unsigned* bar, volatile LAS unsigned* st) {
    XcdBarrier b; b.bar = bar; b.x = xb_xcc_id(); b.st = st;
    if (threadIdx.x == 0) (void)xb_add(&bar[XB_XCNT(b.x)], 1u);
    return b;
}
__device__ __forceinline__ void xcd_barrier_complete(unsigned* bar, unsigned x, unsigned& nloc, unsigned& nx) {
    const unsigned G = gridDim.x * gridDim.y * gridDim.z;
    unsigned sum, cnt, mine, sp = 0u;
    for (;;) {
        sum = 0u; cnt = 0u; mine = 0u;
#pragma unroll
        for (unsigned j = 0; j < 16; ++j) { const unsigned c = xb_ld(&bar[XB_XCNT(j)]); sum += c; cnt += (c > 0u) ? 1u : 0u; mine = (j == x) ? c : mine; }
        if (sum == G) break;
        __builtin_amdgcn_s_sleep(1);
        if ((++sp & 255u) == 0u) { if (xb_ld(&bar[XB_TMO])) break; if (sp > XB_SPIN_CAP) { atomicAdd(&bar[XB_TMO], 1u); break; } }
    }
    nloc = mine > 0u ? mine : 1u; nx = cnt > 0u ? cnt : 1u;
}

__device__ __forceinline__ void xcd_barrier(const XcdBarrier& b) {
    asm volatile("s_waitcnt vmcnt(0)" ::: "memory");
    __syncthreads();
    if (threadIdx.x == 0) {
        unsigned* bar = b.bar;
        __builtin_amdgcn_s_waitcnt(0);
        unsigned nloc = b.st[0], nx = b.st[1];
        if (nloc == 0u) { xcd_barrier_complete(bar, b.x, nloc, nx); b.st[0] = nloc; b.st[1] = nx; }
        const unsigned old = xb_add(&bar[XB_XSUB(b.x)], 1u);
        const unsigned gen = old / nloc;
        if (old + 1u == (gen + 1u) * nloc) {
            __builtin_amdgcn_fence(__ATOMIC_RELEASE, "agent");
            asm volatile("s_waitcnt vmcnt(0)" ::: "memory");
            const unsigned og = xb_add(&bar[XB_TOP], 1u);
            const unsigned tg = og / nx;
            if (og + 1u == (tg + 1u) * nx) xb_add(&bar[XB_TOPGEN], 1u);
            else XB_SPIN(xb_ld(&bar[XB_TOPGEN]) == tg, bar);
            __builtin_amdgcn_fence(__ATOMIC_ACQUIRE, "agent");
            xb_add(&bar[XB_XGEN(b.x)], 1u);
            asm volatile("s_waitcnt vmcnt(0)" ::: "memory");
        } else {
            XB_SPIN(xb_ld(&bar[XB_XGEN(b.x)]) == gen, bar);
            __builtin_amdgcn_fence(__ATOMIC_ACQUIRE, "agent");
            asm volatile("s_waitcnt vmcnt(0)" ::: "memory");
        }
    }
    __syncthreads();
}

struct Args { const float* in[13]; float* out; unsigned char* ws; int coop_sync; int pad; };

__device__ __forceinline__ void transpose_item(const float* W, int ldw, int K, int srccol0, bf16* WT, int dstrow0, const float* gain, LAS float* scr, int kb, int nb, int lane) {
    const int k0 = 64 * kb, n0 = 32 * nb;
#pragma unroll
    for (int i = 0; i < 32; ++i) { const int kk = 2 * i + (lane >> 5); float w = W[(size_t)(k0 + kk) * ldw + srccol0 + n0 + (lane & 31)]; if (gain) w *= gain[k0 + kk]; scr[kk * 33 + (lane & 31)] = w; }
    LDS_WAIT(); asm volatile("" ::: "memory");
    const int c = lane & 7;
#pragma unroll
    for (int j = 0; j < 4; ++j) { const int n = (lane >> 3) + 8 * j; const LAS float* s = scr + (8 * c) * 33 + n;
        v4u o; o.x = pk2(s[0 * 33], s[1 * 33]); o.y = pk2(s[2 * 33], s[3 * 33]); o.z = pk2(s[4 * 33], s[5 * 33]); o.w = pk2(s[6 * 33], s[7 * 33]);
        *(v4u*)(WT + (size_t)(dstrow0 + n0 + n) * K + k0 + 8 * c) = o; }
    LDS_WAIT(); asm volatile("" ::: "memory");
}

__device__ __forceinline__ float log_sigmoid(float y) { return fminf(y, 0.f) - log1pf(expf(-fabsf(y))); }

__global__ void __launch_bounds__(NWAVES * 64, 2) fwd_megakernel(Args args) {
    extern __shared__ __attribute__((aligned(16))) unsigned char lds_raw[];
    LAS unsigned char* lds = (LAS unsigned char*)lds_raw;
    const int tid = threadIdx.x, lane = tid & 63, wave = __builtin_amdgcn_readfirstlane(tid >> 6);
    const int G = gridDim.x; const int bx = blockIdx.x; const int vcu = (G % 8 == 0) ? (bx % 8) * (G / 8) + bx / 8 : bx;
    const float* x = args.in[0]; const float* attn_g = args.in[1]; const float* w_in = args.in[2]; const float* fbias = args.in[3];
    const float* fox_g = args.in[4]; const float* sb_g = args.in[5]; const float* w_out = args.in[6]; const float* ffn_g = args.in[7];
    const float* w_up = args.in[8]; const float* conv_w = args.in[9]; const float* conv_b = args.in[10]; const float* w_down = args.in[11]; const float* final_g = args.in[12];
    float* out = args.out; unsigned char* ws = args.ws;
    bf16* Win_t = (bf16*)(ws + WS_WIN); bf16* Wout_t = (bf16*)(ws + WS_WOUT); bf16* Wup_t = (bf16*)(ws + WS_WUP); bf16* Wdn_t = (bf16*)(ws + WS_WDN);
    float* LF = (float*)(ws + WS_LF); float* F2 = (float*)(ws + WS_F2); float* SS = (float*)(ws + WS_SS); float* PS = (float*)(ws + WS_PS); float* PS2 = (float*)(ws + WS_PS2);
    float* HALO4 = (float*)(ws + WS_HALO); bf16* XN = (bf16*)(ws + WS_XN); bf16* QB = (bf16*)(ws + WS_Q); bf16* KB = (bf16*)(ws + WS_K); bf16* VB = (bf16*)(ws + WS_V); bf16* OB = (bf16*)(ws + WS_O);
    bf16* UB = (bf16*)(ws + WS_U); bf16* FS3 = (bf16*)(ws + WS_FS3); unsigned* CTL = (unsigned*)(ws + WS_CTL);
    const int gw = vcu * NWAVES + wave, NGW = G * NWAVES;
    volatile LAS unsigned* xst = (volatile LAS unsigned*)(lds + LDS_BYTES - 16);
    if (tid == 0) { xst[0] = 0u; xst[1] = 0u; }
    unsigned* XBAR = (unsigned*)(ws + WS_CTL + 262144);
    __syncthreads();
    XcdBarrier xbar = xcd_barrier_post(XBAR, xst);

    {
        LAS float* scr = (LAS float*)(lds + wave * 16384);
        constexpr int I_IN = 16 * 96, I_OUT = 16 * 32, I_UP = 16 * 176, I_DN = 44 * 32, NITEMS = I_IN + I_OUT + I_UP + I_DN;
        for (int it = gw; it < NITEMS; it += NGW) {
            int r = it;
            if (r < I_IN) { const int kb = r / 96, nb = r % 96, seg = nb >> 4, nbs = nb & 15;
                const int srcc = (seg == 0) ? 0 : (seg == 1) ? 1544 : (seg == 2) ? 512 : (seg == 3) ? 2056 : (seg == 4) ? 1024 : 2568;
                transpose_item(w_in, INC, 1024, srcc, Win_t, seg * 512, nullptr, scr, kb, nbs, lane); continue; } r -= I_IN;
            if (r < I_OUT) { const int kb = r / 32, nb = r % 32; transpose_item(w_out, 1024, 1024, 0, Wout_t, 0, (kb < 8) ? fox_g : (sb_g - 512), scr, kb, nb, lane); continue; } r -= I_OUT;
            if (r < I_UP) { const int kb = r / 176, nb = r % 176, pn = nb >> 3, jb = nb & 7; const int srcc = (jb < 4) ? 128 * pn + 32 * jb : DFF + 128 * pn + 32 * (jb - 4);
                transpose_item(w_up, NUP, 1024, srcc - 32 * nb, Wup_t, 0, ffn_g, scr, kb, nb, lane); continue; } r -= I_UP;
            { const int kb = r / 32, nb = r % 32; transpose_item(w_down, 1024, DFF, 0, Wdn_t, 0, nullptr, scr, kb, nb, lane); }
        }
        __syncthreads();
        LAS float* Wf = (LAS float*)lds;
        for (int i = tid; i < 1024 * 8; i += NWAVES * 64) Wf[i] = w_in[(size_t)(i >> 3) * INC + 1536 + (i & 7)];
        __syncthreads();
        f32x4 gv[4];
#pragma unroll
        for (int j = 0; j < 4; ++j) gv[j] = ((const f32x4*)attn_g)[lane + 64 * j];
        f32x4 vn[4];
        if (gw < MROWS) { const f32x4* xr = (const f32x4*)(x + (size_t)gw * DMODEL) + lane;
#pragma unroll
            for (int j = 0; j < 4; ++j) vn[j] = xr[64 * j]; }
        for (int m = gw; m < MROWS; m += NGW) {
            f32x4 v[4]; float s2 = 0.f;
#pragma unroll
            for (int j = 0; j < 4; ++j) { v[j] = vn[j]; s2 += (v[j].x * v[j].x + v[j].y * v[j].y) + (v[j].z * v[j].z + v[j].w * v[j].w); }
            if (m + NGW < MROWS) { const f32x4* xr = (const f32x4*)(x + (size_t)(m + NGW) * DMODEL) + lane;
#pragma unroll
                for (int j = 0; j < 4; ++j) vn[j] = xr[64 * j]; }
            const float rstd = 1.0f / sqrtf(wave_sum(s2) * (1.0f / DMODEL) + RMS_EPS);
            unsigned long long* o8 = (unsigned long long*)(XN + (size_t)m * DMODEL) + lane;
            float fa[8];
#pragma unroll
            for (int e = 0; e < 8; ++e) fa[e] = 0.f;
#pragma unroll
            for (int j = 0; j < 4; ++j) { v[j] = v[j] * rstd * gv[j];
                o8[64 * j] = (unsigned long long)pk2(v[j].x, v[j].y) | ((unsigned long long)pk2(v[j].z, v[j].w) << 32);
#pragma unroll
                for (int i = 0; i < 4; ++i) { const int k = 256 * j + 4 * lane + i; const f32x4 wa = *(const LAS f32x4*)(Wf + k * 8), wb = *(const LAS f32x4*)(Wf + k * 8 + 4); const float hk = v[j][i];
                    fa[0] += hk * wa[0]; fa[1] += hk * wa[1]; fa[2] += hk * wa[2]; fa[3] += hk * wa[3]; fa[4] += hk * wb[0]; fa[5] += hk * wb[1]; fa[6] += hk * wb[2]; fa[7] += hk * wb[3]; } }
            float r4[4], r2[2], r1;
            { const bool h = (lane & 32) != 0;
#pragma unroll
              for (int e = 0; e < 4; ++e) { const float snd = h ? fa[e] : fa[e + 4], kp = h ? fa[e + 4] : fa[e]; r4[e] = kp + __shfl_xor(snd, 32); } }
            { const bool h = (lane & 16) != 0;
#pragma unroll
              for (int e = 0; e < 2; ++e) { const float snd = h ? r4[e] : r4[e + 2], kp = h ? r4[e + 2] : r4[e]; r2[e] = kp + __shfl_xor(snd, 16); } }
            { const bool h = (lane & 8) != 0; const float snd = h ? r2[0] : r2[1], kp = h ? r2[1] : r2[0]; r1 = kp + __shfl_xor(snd, 8); }
            r1 += __shfl_xor(r1, 4); r1 += __shfl_xor(r1, 2); r1 += __shfl_xor(r1, 1);
            if ((lane & 7) == 0) { const int e = lane >> 3; LF[(size_t)m * 8 + e] = log_sigmoid(r1 + fbias[e]); }
        }
    }
    xcd_barrier(xbar);

    {
        LAS float* wtot = (LAS float*)lds;
        for (int bh = bx; bh < 32; bh += G) {
            const int b = bh >> 3, h = bh & 7; const float* src = LF + ((size_t)b * SEQ) * 8 + h;
            float loc[16]; float s = 0.f;
#pragma unroll
            for (int i = 0; i < 16; ++i) { s += src[(size_t)(tid * 16 + i) * 8]; loc[i] = s; }
            float incl = s;
#pragma unroll
            for (int o = 1; o < 64; o <<= 1) { const float t = __shfl_up(incl, o); if (lane >= o) incl += t; }
            if (lane == 63) wtot[wave] = incl;
            __syncthreads();
            float base = incl - s;
            for (int w = 0; w < wave; ++w) base += wtot[w];
            float* dst = F2 + (size_t)bh * SEQ + tid * 16;
#pragma unroll
            for (int i = 0; i < 16; ++i) { const float f = (base + loc[i]) * LOG2E; dst[i] = f;
                const float nf = -f; const unsigned h1 = f2bf(nf); const float r1 = nf - __builtin_bit_cast(float, h1 << 16); const unsigned h2 = f2bf(r1); const float r2 = r1 - __builtin_bit_cast(float, h2 << 16); const unsigned h3 = f2bf(r2);
                v4u o; o.x = h1 | (h2 << 16); o.y = h3; o.z = 0u; o.w = 0u; *(v4u*)(FS3 + ((size_t)bh * SEQ + tid * 16 + i) * 8) = o; }
            __syncthreads();
        }
        pg8::Gemm g{XN, Win_t, MROWS, 3072, 1024, 1024}; pg8::StaticOrder S; S.init(MROWS, 3072, G, bx);
        pg8::EpiQKV E{QB, 1024, 1024, (size_t)(WS_K - WS_Q) / 2, att::C2, CTL + 64};
        pg8::gemm_phase<pg8::EpiQKV, pg8::StaticOrder, true, true>(lds, g, S, E);
    }
    xcd_barrier(xbar);

    {
        volatile LAS unsigned* qw = (volatile LAS unsigned*)(lds + att::L_FLAG + 64);
        for (;;) {
            if (tid == 0) qw[0] = atomicAdd(CTL, 1u);
            __syncthreads();
            const unsigned idx = qw[0];
            if (idx >= 2048u) break;
            if (idx < 1024u) { const int qb = 31 - (int)(idx >> 5), bh = (int)(idx & 31);
                att::fox_unit(bh >> 3, bh & 7, qb, QB, KB, VB, OB, F2, FS3, CTL + 64, SS, lds); }
            else { const int u = (int)idx - 1024, qb = 31 - (u >> 5), bh = u & 31;
                att::sb_unit(bh >> 3, 8 + (bh & 7), qb, QB, KB, VB, OB, SS, lds); }
        }
    }
    xcd_barrier(xbar);

    {
        pg8::Gemm g{OB, Wout_t, MROWS, 1024, 1024, 1024}; pg8::StaticOrder S; S.init(MROWS, 1024, G, bx);
        LAS float* tab = (LAS float*)(lds + RING_BYTES);
        { pg8::Unit u; for (int ui = 0; ui < 7 && S.next(ui, u); ++ui) if (tid < 256) {
              const float* p = SS + (size_t)(u.pm * 256 + tid) * 16;
              const f32x4 a = *(const f32x4*)p, b = *(const f32x4*)(p + 4), c = *(const f32x4*)(p + 8), d = *(const f32x4*)(p + 12);
              const float sf = ((a[0] + a[1]) + (a[2] + a[3])) + ((b[0] + b[1]) + (b[2] + b[3])), ss = ((c[0] + c[1]) + (c[2] + c[3])) + ((d[0] + d[1]) + (d[2] + d[3]));
              const float rf = 1.0f / sqrtf(sf * (1.0f / 512.0f) + RMS_EPS), rs = 1.0f / sqrtf(ss * (1.0f / 512.0f) + RMS_EPS);
              tab[(ui * 256 + tid) * 2] = rf / rs; tab[(ui * 256 + tid) * 2 + 1] = rs; }
          __syncthreads(); }
        pg8::EpiOut E{x, out, XN, tab, PS};
        pg8::gemm_phase<pg8::EpiOut, pg8::StaticOrder, true, true>(lds, g, S, E);
    }
    xcd_barrier(xbar);

    {
        pg8::Gemm g{XN, Wup_t, MROWS, NUP, 1024, 1024}; pg8::StaticOrder S; S.init(MROWS, NUP, G, bx);
        float* RSTD1 = (float*)(ws + WS_CTL + 65536);
        { pg8::Unit u; for (int ui = 0; S.next(ui, u); ++ui) if (tid < 256) { const int r = u.pm * 256 + tid; RSTD1[r] = __builtin_amdgcn_rsqf(pg8::sum16(PS + (size_t)r * 16) * (1.0f / 1024.0f) + RMS_EPS); }
          __syncthreads(); }
        pg8::EpiUpConv E{UB, RSTD1, HALO4, conv_w, conv_b, (LAS float*)(lds + RING_BYTES)};
        pg8::gemm_phase<pg8::EpiUpConv, pg8::StaticOrder, true, true>(lds, g, S, E);
    }
    xcd_barrier(xbar);

    {
        for (int idx = bx * (NWAVES * 64) + tid; idx < 128 * 2 * 704; idx += G * NWAVES * 64) {
            const int pm = idx / 1408, rem = idx % 1408, t = rem / 704, c4 = (rem % 704) * 4;
            const bool first = (pm & 31) == 0;
            const float* h0 = HALO4 + (size_t)(pm * 4) * 5632; const float* hp = HALO4 + (size_t)((first ? pm : pm - 1) * 4) * 5632;
            const f32x4 z = {0.f, 0.f, 0.f, 0.f};
            f32x4 ug[3], uv[3];
            ug[2] = *(const f32x4*)(h0 + t * 5632 + c4); uv[2] = *(const f32x4*)(h0 + t * 5632 + DFF + c4);
            if (t == 1) { ug[1] = *(const f32x4*)(h0 + c4); uv[1] = *(const f32x4*)(h0 + DFF + c4); } else { ug[1] = first ? z : *(const f32x4*)(hp + 3 * 5632 + c4); uv[1] = first ? z : *(const f32x4*)(hp + 3 * 5632 + DFF + c4); }
            { const int pr = (t == 1) ? 3 : 2; ug[0] = first ? z : *(const f32x4*)(hp + pr * 5632 + c4); uv[0] = first ? z : *(const f32x4*)(hp + pr * 5632 + DFF + c4); }
            f32x4 og = *(const f32x4*)(conv_b + c4), ov = *(const f32x4*)(conv_b + DFF + c4);
#pragma unroll
            for (int k = 0; k < 3; ++k) { og += *(const f32x4*)(conv_w + (size_t)k * NUP + c4) * ug[k]; ov += *(const f32x4*)(conv_w + (size_t)k * NUP + DFF + c4) * uv[k]; }
            float res[4];
#pragma unroll
            for (int i = 0; i < 4; ++i) res[i] = og[i] / (1.0f + __expf(-og[i])) * ov[i];
            unsigned long long o = (unsigned long long)pk2(res[0], res[1]) | ((unsigned long long)pk2(res[2], res[3]) << 32);
            *(unsigned long long*)(UB + (size_t)(pm * 256 + t) * DFF + c4) = o;
        }
    }
    xcd_barrier(xbar);

    {
        pg8::Gemm g{UB, Wdn_t, MROWS, 1024, DFF, DFF}; pg8::StaticOrder S; S.init(MROWS, 1024, G, bx);
        pg8::EpiDown E{out, out, PS2};
        pg8::gemm_phase<pg8::EpiDown, pg8::StaticOrder, true, true>(lds, g, S, E);
    }
    xcd_barrier(xbar);

    {
        int lane6 = threadIdx.x & 63; asm volatile("" : "+v"(lane6));
        f32x4 gv[4];
#pragma unroll
        for (int j = 0; j < 4; ++j) gv[j] = ((const f32x4*)final_g)[lane6 + 64 * j];
        for (int m = gw; m < MROWS; m += NGW) {
            const float rstd = 1.0f / sqrtf(pg8::sum16(PS2 + (size_t)m * 16) * (1.0f / DMODEL) + RMS_EPS);
            f32x4* xr = (f32x4*)(out + (size_t)m * DMODEL) + lane6;
#pragma unroll
            for (int j = 0; j < 4; ++j) { const f32x4 v = xr[64 * j]; xr[64 * j] = v * rstd * gv[j]; }
        }
    }
    if (args.coop_sync) cg::this_grid().sync();
}

extern "C" void kernel_launch(void* const* d_in, const int* in_sizes, int n_in, void* d_out, int out_size, void* d_ws, size_t ws_size, hipStream_t stream) {
    static int grid = 0;
    if (grid == 0) {
        if (n_in != 13 || ws_size < WS_END) { fprintf(stderr, "kernel_launch: unexpected inputs (n_in %d, ws %zu)\n", n_in, ws_size); grid = -1; return; }
        int dev = 0, cus = 0, per_cu = 0;
        hipGetDevice(&dev); hipDeviceGetAttribute(&cus, hipDeviceAttributeMultiprocessorCount, dev);
        hipFuncSetAttribute((const void*)fwd_megakernel, hipFuncAttributeMaxDynamicSharedMemorySize, LDS_BYTES);
        hipOccupancyMaxActiveBlocksPerMultiprocessor(&per_cu, (const void*)fwd_megakernel, NWAVES * 64, LDS_BYTES);
        (void)hipGetLastError();
        if (per_cu < 1) per_cu = 1;
        grid = cus * per_cu; if (grid > 256) grid = 256;
    }
    if (grid < 0) return;
    if (hipMemsetAsync((unsigned char*)d_ws + WS_CTL, 0, 262144 + 16384, stream) != hipSuccess) { fprintf(stderr, "kernel_launch: hipMemsetAsync failed\n"); return; }
    Args a{};
    for (int i = 0; i < 13; ++i) a.in[i] = (const float*)d_in[i];
    a.out = (float*)d_out; a.ws = (unsigned char*)d_ws;
    void* kargs[] = {&a};
    hipError_t e = hipLaunchCooperativeKernel((const void*)fwd_megakernel, dim3(grid), dim3(NWAVES * 64), kargs, LDS_BYTES, stream);
    if (e != hipSuccess) fprintf(stderr, "cooperative launch failed: %s (grid %d)\n", hipGetErrorString(e), grid);
}
```
